# Optimizing an MI355X kernel written in HIP

```python
import math
import jax, jax.numpy as jnp
from jax import lax
import numpy as np

D_MODEL = 1024
BATCH = 8
SEQ = 2048
DEPTH = 1
DEC_BATCH = 128
DEC_SEQ = 8
PAST_LEN = 16384
PAGE_SIZE = 128

N_META = 16
DN_DK = 128
DN_DV = 128
DN_HEADS = D_MODEL // DN_DV
DN_CONV = 4
DN_CHUNK = 64
DN_QKV = DN_HEADS * (2 * DN_DK + DN_DV)
DN_Z = DN_HEADS * DN_DV
RW_HD = 64
RW_HEADS = D_MODEL // RW_HD
RW_W = RW_HEADS * RW_HD
RW_DECAY_LORA = 64
RW_A_LORA = 64
RW_G_LORA = 128
RW_SHIFT_W = 3 * RW_W + RW_DECAY_LORA + RW_A_LORA + RW_G_LORA
RW_GN_EPS = 64e-5
PROJ_W = DN_QKV + DN_Z + 2 * DN_HEADS + RW_SHIFT_W + 2 * D_MODEL
D_FF = 4 * D_MODEL
NORM_EPS = 1e-6

kernel_name = 'gdn_rwkv7_parallel_hybrid_step'


def split_points(sizes):
    pts, acc = [], 0
    for s in sizes[:-1]:
        acc += s
        pts.append(acc)
    return pts


def rmsnorm(x, g):
    xf = x.astype(jnp.float32)
    y = xf * lax.rsqrt(jnp.mean(xf * xf, axis=-1, keepdims=True) + NORM_EPS)
    return (y * g.astype(jnp.float32)).astype(x.dtype)


def l2norm(x):
    return x * lax.rsqrt(jnp.sum(x * x, axis=-1, keepdims=True) + 1e-6)


def causal_depthwise_conv(x, buf, w):
    t_len = x.shape[1]
    width = w.shape[0]
    w = w.astype(x.dtype)
    xp = jnp.concatenate([buf.astype(x.dtype), x], axis=1)
    out = xp[:, 0:t_len] * w[0]
    for j in range(1, width):
        out = out + xp[:, j:j + t_len] * w[j]
    return out, xp[:, -(width - 1):]


def gated_delta_chunked(q, k, v, g, beta, S0, chunk):
    nb, t_len, nh, dk = q.shape
    dv = v.shape[-1]
    n = t_len // chunk

    def blocks(t):
        t = t.reshape((nb, n, chunk) + t.shape[2:])
        return jnp.swapaxes(jnp.moveaxis(t, 1, 0), 2, 3)

    qc, kc, vc, gc, bc = blocks(q), blocks(k), blocks(v), blocks(g), blocks(beta)
    G = jnp.cumsum(gc, axis=-1)
    idx = jnp.arange(chunk)
    incl = idx[:, None] >= idx[None, :]
    strict = idx[:, None] > idx[None, :]
    decay = jnp.exp(jnp.where(incl, G[..., :, None] - G[..., None, :], -jnp.inf))
    kb = kc * bc[..., None]
    A = jnp.where(strict, jnp.einsum('nbhid,nbhjd->nbhij', kb, kc) * decay, 0.0)
    Tm = A + jnp.eye(chunk, dtype=A.dtype)
    rhs = jnp.concatenate([vc * bc[..., None], kb * jnp.exp(G)[..., None]], axis=-1)
    sol = lax.linalg.triangular_solve(Tm, rhs, left_side=True, lower=True, unit_diagonal=True)
    U, W = sol[..., :dv], sol[..., dv:]
    Aqk = jnp.einsum('nbhid,nbhjd->nbhij', qc, kc) * decay
    qg = qc * jnp.exp(G)[..., None]
    kd = kc * jnp.exp(G[..., -1:] - G)[..., None]
    gl = jnp.exp(G[..., -1])

    def step(S, inp):
        qg_i, kd_i, U_i, W_i, Aqk_i, gl_i = inp
        u = U_i - jnp.einsum('bhck,bhkv->bhcv', W_i, S)
        o = jnp.einsum('bhck,bhkv->bhcv', qg_i, S) + jnp.einsum('bhij,bhjv->bhiv', Aqk_i, u)
        S = S * gl_i[..., None, None] + jnp.einsum('bhck,bhcv->bhkv', kd_i, u)
        return S, o

    S, o = lax.scan(step, S0, (qg, kd, U, W, Aqk, gl))
    o = jnp.moveaxis(jnp.swapaxes(o, 2, 3), 0, 1).reshape(nb, t_len, nh, dv)
    return o, S


def rwkv7_step(S, inp):
    r, w, k, v, kk, a = inp
    sa = jnp.einsum('bhvk,bhk->bhv', S, -kk)
    S = S * w[:, :, None, :] + sa[..., None] * (kk * a)[:, :, None, :] + v[..., None] * k[:, :, None, :]
    return S, jnp.einsum('bhvk,bhk->bhv', S, r)


def hybrid_layer(x, segments, conv_buf, dn_S, rw_prev, rw_S, weights):
    (g_mix_norm, w_in, dn_conv_w, dn_a_log, dn_dt_bias, dn_norm_w,
     rw_mu, rw_w0, rw_w2, rw_a0, rw_a2, rw_g2, rw_k_k, rw_k_a, rw_r_k,
     rw_gn_w, rw_gn_b, w_out, g_ffn_norm, w_ff1, w_ff2) = weights
    f32 = jnp.float32
    nb, t_len, _ = x.shape
    h = rmsnorm(x, g_mix_norm)
    proj = h @ w_in.astype(x.dtype)
    p_qkv, p_z, p_a, p_b, p_rw, gate_a, gate_b = jnp.split(
        proj, split_points((DN_QKV, DN_Z, DN_HEADS, DN_HEADS, RW_SHIFT_W, D_MODEL, D_MODEL)), axis=-1)

    qkv, conv_new = causal_depthwise_conv(p_qkv, conv_buf, dn_conv_w)
    qkv = jax.nn.silu(qkv.astype(f32))
    q, k, v = jnp.split(qkv, split_points((DN_HEADS * DN_DK, DN_HEADS * DN_DK, DN_HEADS * DN_DV)), axis=-1)
    q = l2norm(q.reshape(nb, t_len, DN_HEADS, DN_DK)) * (DN_DK ** -0.5)
    k = l2norm(k.reshape(nb, t_len, DN_HEADS, DN_DK))
    v = v.reshape(nb, t_len, DN_HEADS, DN_DV)
    beta = jax.nn.sigmoid(p_b.astype(f32))
    g = -jnp.exp(dn_a_log.astype(f32)) * jax.nn.softplus(p_a.astype(f32) + dn_dt_bias.astype(f32))
    S = dn_S.astype(f32)
    outs = []
    start = 0
    for seg_len, chunk in segments:
        sl = slice(start, start + seg_len)
        o_seg, S = gated_delta_chunked(q[:, sl], k[:, sl], v[:, sl], g[:, sl], beta[:, sl], S, chunk)
        outs.append(o_seg)
        start += seg_len
    o_dn = jnp.concatenate(outs, axis=1)
    z = p_z.astype(f32).reshape(nb, t_len, DN_HEADS, DN_DV)
    o_dn = (o_dn * lax.rsqrt(jnp.mean(o_dn * o_dn, axis=-1, keepdims=True) + NORM_EPS)
            * dn_norm_w.astype(f32) * jax.nn.silu(z)).reshape(nb, t_len, DN_HEADS * DN_DV)

    prev = jnp.concatenate([rw_prev[:, None].astype(p_rw.dtype), p_rw[:, :-1]], axis=1)
    xm = (p_rw + (prev - p_rw) * rw_mu.astype(p_rw.dtype)).astype(f32)
    rw_prev_new = p_rw[:, -1]
    r, kr, vr, wl, al, gl = jnp.split(
        xm, split_points((RW_W, RW_W, RW_W, RW_DECAY_LORA, RW_A_LORA, RW_G_LORA)), axis=-1)
    w_log = -jax.nn.softplus(-(rw_w0.astype(f32) + jnp.tanh(wl) @ rw_w2.astype(f32))) - 0.5
    decay = jnp.exp(-jnp.exp(w_log))
    a = jax.nn.sigmoid(rw_a0.astype(f32) + al @ rw_a2.astype(f32))
    gate = jax.nn.sigmoid(gl) @ rw_g2.astype(f32)

    def heads(t):
        return t.reshape(nb, t_len, RW_HEADS, RW_HD)

    kk = l2norm(heads(kr * rw_k_k.astype(f32)))
    kr = kr * (1.0 + (a - 1.0) * rw_k_a.astype(f32))
    r, decay, kr, vr, a = heads(r), heads(decay), heads(kr), heads(vr), heads(a)
    S_rw, o_rw = lax.scan(rwkv7_step, rw_S.astype(f32),
                          (jnp.swapaxes(r, 0, 1), jnp.swapaxes(decay, 0, 1), jnp.swapaxes(kr, 0, 1),
                           jnp.swapaxes(vr, 0, 1), jnp.swapaxes(kk, 0, 1), jnp.swapaxes(a, 0, 1)))
    o_rw = jnp.swapaxes(o_rw, 0, 1)
    mu = jnp.mean(o_rw, axis=-1, keepdims=True)
    var = jnp.mean(jnp.square(o_rw - mu), axis=-1, keepdims=True)
    o_rw = ((o_rw - mu) * lax.rsqrt(var + RW_GN_EPS) * rw_gn_w.astype(f32).reshape(RW_HEADS, RW_HD)
            + rw_gn_b.astype(f32).reshape(RW_HEADS, RW_HD))
    o_rw = o_rw + jnp.sum(r * kr * rw_r_k.astype(f32), axis=-1, keepdims=True) * vr
    o_rw = o_rw.reshape(nb, t_len, RW_W) * gate

    mix = jax.nn.sigmoid(gate_a.astype(f32)) * o_dn + jax.nn.sigmoid(gate_b.astype(f32)) * o_rw
    x = x + mix.astype(x.dtype) @ w_out.astype(x.dtype)

    h2 = rmsnorm(x, g_ffn_norm)
    x = x + jnp.square(jax.nn.relu(h2 @ w_ff1.astype(x.dtype))) @ w_ff2.astype(x.dtype)
    return x, (conv_new, S, rw_prev_new, S_rw)


def run_stack(x, segments, conv_bufs, dn_states, rw_prevs, rw_states, layer_weights, g_final):
    new_conv, new_dn, new_prev, new_rw = [], [], [], []
    for layer in range(DEPTH):
        x, (c, s, p, r) = hybrid_layer(x, segments, conv_bufs[layer], dn_states[layer], rw_prevs[layer],
                                       rw_states[layer], tuple(w[layer] for w in layer_weights))
        new_conv.append(c)
        new_dn.append(s)
        new_prev.append(p)
        new_rw.append(r)
    return (rmsnorm(x, g_final), jnp.stack(new_conv), jnp.stack(new_dn),
            jnp.stack(new_prev), jnp.stack(new_rw))


def setup_inputs(seed: int = 0) -> dict:
    key = jax.random.key(seed)
    ks = jax.random.split(key, 32)
    f32 = jnp.float32
    L = DEPTH

    def nrm(k, shape, scale):
        return jax.random.normal(k, shape, f32) * scale

    dt = jnp.exp(jax.random.uniform(ks[11], (L, DN_HEADS), f32, math.log(1e-3), math.log(1e-1)))
    return {
        'x_prompt': nrm(ks[0], (BATCH, SEQ, D_MODEL), 1.0),
        'x_sample': nrm(ks[1], (DEC_BATCH, DEC_SEQ, D_MODEL), 1.0),
        'state_dn_conv': nrm(ks[2], (L, DEC_BATCH, DN_CONV - 1, DN_QKV), 1.0),
        'state_dn': nrm(ks[3], (L, DEC_BATCH, DN_HEADS, DN_DK, DN_DV), 0.1),
        'state_rw_shift': nrm(ks[4], (L, DEC_BATCH, RW_SHIFT_W), 1.0),
        'state_rw': nrm(ks[5], (L, DEC_BATCH, RW_HEADS, RW_HD, RW_HD), 0.1),
        'meta_tokens': nrm(ks[6], (N_META, D_MODEL), 1.0),
        'g_mix_norm': 1.0 + nrm(ks[7], (L, D_MODEL), 0.02),
        'w_in': nrm(ks[8], (L, D_MODEL, PROJ_W), D_MODEL ** -0.5),
        'dn_conv_w': nrm(ks[9], (L, DN_CONV, DN_QKV), DN_CONV ** -0.5),
        'dn_a_log': jnp.log(jax.random.uniform(ks[10], (L, DN_HEADS), f32, 1.0, 16.0)),
        'dn_dt_bias': dt + jnp.log(-jnp.expm1(-dt)),
        'dn_norm_w': 1.0 + nrm(ks[12], (L, DN_DV), 0.02),
        'rw_mu': jax.random.uniform(ks[13], (L, RW_SHIFT_W), f32),
        'rw_w0': jax.random.uniform(ks[14], (L, RW_W), f32, -4.0, 1.0),
        'rw_w2': nrm(ks[15], (L, RW_DECAY_LORA, RW_W), 0.1 * RW_DECAY_LORA ** -0.5),
        'rw_a0': nrm(ks[16], (L, RW_W), 0.1),
        'rw_a2': nrm(ks[17], (L, RW_A_LORA, RW_W), 0.1 * RW_A_LORA ** -0.5),
        'rw_g2': nrm(ks[18], (L, RW_G_LORA, RW_W), RW_G_LORA ** -0.5),
        'rw_k_k': 0.85 + nrm(ks[19], (L, RW_W), 0.02),
        'rw_k_a': 1.0 + nrm(ks[20], (L, RW_W), 0.02),
        'rw_r_k': nrm(ks[21], (L, RW_HEADS, RW_HD), 0.1),
        'rw_gn_w': 1.0 + nrm(ks[22], (L, RW_W), 0.02),
        'rw_gn_b': nrm(ks[23], (L, RW_W), 0.02),
        'w_out': nrm(ks[24], (L, D_MODEL, D_MODEL), D_MODEL ** -0.5),
        'g_ffn_norm': 1.0 + nrm(ks[25], (L, D_MODEL), 0.02),
        'w_ff1': nrm(ks[26], (L, D_MODEL, D_FF), D_MODEL ** -0.5),
        'w_ff2': nrm(ks[27], (L, D_FF, D_MODEL), D_FF ** -0.5),
        'g_final': 1.0 + nrm(ks[28], (D_MODEL,), 0.02),
    }


def reference(x_prompt, x_sample, state_dn_conv, state_dn, state_rw_shift, state_rw, meta_tokens,
              g_mix_norm, w_in, dn_conv_w, dn_a_log, dn_dt_bias, dn_norm_w,
              rw_mu, rw_w0, rw_w2, rw_a0, rw_a2, rw_g2, rw_k_k, rw_k_a, rw_r_k, rw_gn_w, rw_gn_b,
              w_out, g_ffn_norm, w_ff1, w_ff2, g_final):
    layer_weights = (g_mix_norm, w_in, dn_conv_w, dn_a_log, dn_dt_bias, dn_norm_w,
                     rw_mu, rw_w0, rw_w2, rw_a0, rw_a2, rw_g2, rw_k_k, rw_k_a, rw_r_k,
                     rw_gn_w, rw_gn_b, w_out, g_ffn_norm, w_ff1, w_ff2)
    f32 = jnp.float32

    nbp, seq_len, _ = x_prompt.shape
    meta = jnp.broadcast_to(meta_tokens.astype(x_prompt.dtype)[None], (nbp, N_META, D_MODEL))
    xp = jnp.concatenate([meta, x_prompt], axis=1)
    seg_p = ((N_META, N_META), (seq_len, math.gcd(seq_len, DN_CHUNK)))
    yp, conv_p, dn_p, shift_p, rw_p = run_stack(
        xp, seg_p,
        jnp.zeros((DEPTH, nbp, DN_CONV - 1, DN_QKV), x_prompt.dtype),
        jnp.zeros((DEPTH, nbp, DN_HEADS, DN_DK, DN_DV), f32),
        jnp.zeros((DEPTH, nbp, RW_SHIFT_W), x_prompt.dtype),
        jnp.zeros((DEPTH, nbp, RW_HEADS, RW_HD, RW_HD), f32),
        layer_weights, g_final)
    y_prompt = yp[:, N_META:]

    dec_len = x_sample.shape[1]
    seg_s = ((dec_len, math.gcd(dec_len, DN_CHUNK)),)
    y_sample, conv_s, dn_s, shift_s, rw_s = run_stack(
        x_sample, seg_s, state_dn_conv, state_dn, state_rw_shift, state_rw, layer_weights, g_final)

    return (y_prompt, y_sample, conv_p, dn_p, shift_p, rw_p, conv_s, dn_s, shift_s, rw_s)
```

```cpp
#include <hip/hip_runtime.h>
#include <hip/hip_cooperative_groups.h>
#include <cstdio>
#include <cstdint>
namespace cg = cooperative_groups;

#define DI __device__ __forceinline__
#define LAS __attribute__((address_space(3)))
typedef unsigned short bf16_t;
typedef short bf16x8 __attribute__((ext_vector_type(8)));
typedef float f32x4 __attribute__((ext_vector_type(4)));
typedef unsigned u32x4 __attribute__((ext_vector_type(4)));

constexpr int D = 1024, TP = 2064, NBP = 8, NBS = 128, TS = 8;
constexpr int MPR = NBP * TP;
constexpr int M = MPR + NBS * TS;
constexpr int MP = 17664;
constexpr int QKVW = 3072, RWW = 3328, PROJW = 9488, FF = 4096;
constexpr int N1A = 6400, N1B = 3072;
constexpr size_t MiB = 1u << 20;
constexpr size_t WS_CTL = 0;
constexpr size_t WS_WOUT = 1 * MiB, WS_WFF1 = 3 * MiB, WS_WFF2 = 11 * MiB, WS_WG2 = 19 * MiB;
constexpr size_t WS_GDN = 19 * MiB + 512 * 1024, WS_BETA = 20 * MiB + 512 * 1024;
constexpr size_t WS_QKV = 22 * MiB, WS_RW = 126 * MiB;
constexpr size_t WS_X1 = WS_QKV, WS_ACT = 92 * MiB;
constexpr size_t DO_H = 0, DO_WIN = 35 * MiB;
constexpr size_t O_YP = 0, O_YS = 16777216, O_CONVP = 17825792, O_DNP = 17899520, O_SHIFTP = 18948096, O_RWP = 18974720,
                 O_CONVS = 19499008, O_DNS = 20678656, O_SHIFTS = 37455872, O_RWS = 37881856;
constexpr int LDS_BYTES = 147456;

struct Params { const float* in[29]; float* out; unsigned char* ws; };

DI unsigned f2bf(float f) { unsigned u = __builtin_bit_cast(unsigned, f); return (u + 0x7fffu + ((u >> 16) & 1u)) >> 16; }
DI unsigned pk2(float lo, float hi) { return f2bf(lo) | (f2bf(hi) << 16); }
DI float bflo(unsigned u) { return __builtin_bit_cast(float, u << 16); }
DI float bfhi(unsigned u) { return __builtin_bit_cast(float, u & 0xffff0000u); }
DI void unpack8(const u32x4 v, float* o) { o[0] = bflo(v.x); o[1] = bfhi(v.x); o[2] = bflo(v.y); o[3] = bfhi(v.y); o[4] = bflo(v.z); o[5] = bfhi(v.z); o[6] = bflo(v.w); o[7] = bfhi(v.w); }
DI u32x4 pack8(const float* o) { u32x4 v; v.x = pk2(o[0], o[1]); v.y = pk2(o[2], o[3]); v.z = pk2(o[4], o[5]); v.w = pk2(o[6], o[7]); return v; }
DI void load8bf(const bf16_t* p, float* o) { unpack8(*(const u32x4*)p, o); }
DI float wave_sum(float v) {
#pragma unroll
    for (int o = 1; o < 64; o <<= 1) v += __shfl_xor(v, o);
    return v;
}
DI float sigmoidf_(float x) { return 1.f / (1.f + __expf(-x)); }
DI float softplusf_(float x) { return fmaxf(x, 0.f) + log1pf(__expf(-fabsf(x))); }
DI float siluf_(float x) { return x * sigmoidf_(x); }
DI int otid() { int t = threadIdx.x; asm volatile("" : "+v"(t)); return t; }
#define LDS_WAIT() asm volatile("s_waitcnt lgkmcnt(0)" ::: "memory")

DI const float* xrow3(const float* xp, const float* xs, const float* xm, int r) {
    if (r < MPR) { const int b = r / TP, t = r - b * TP; return t < 16 ? xm + (size_t)t * D : xp + ((size_t)b * 2048 + (t - 16)) * D; }
    return xs + (size_t)(r - MPR) * D;
}
DI const float* xrow(const Params& p, int r) {
    if (r < MPR) { const int b = r / TP, t = r - b * TP; return t < 16 ? p.in[6] + (size_t)t * D : p.in[0] + ((size_t)b * 2048 + (t - 16)) * D; }
    return p.in[1] + (size_t)(r - MPR) * D;
}

namespace pg8 {
constexpr int BM = 256, BK = 64, HALF = 128, HTB = HALF * BK * 2, STAGE_BYTES = 8 * HTB, NXCD = 8, WGM = 8;
DI int lds_byte(int r, int c) { const int st = (r >> 4) * 2 + (c >> 5), rr = r & 15, cc = c & 31, ob = rr * 64 + cc * 2; return st * 1024 + (ob ^ (((ob >> 9) & 1) << 5)); }
DI void stage_rc(int b, int& R, int& C) { const int st = b / 1024, sb = b % 1024, swz = sb ^ (((sb >> 9) & 1) << 5); R = (st >> 1) * 16 + swz / 64; C = (st & 1) * 32 + (swz % 64) / 2; }
DI int perm32(int rho) { const int n = rho >> 4, i = rho & 15; return 8 * (i >> 2) + 4 * n + (i & 3); }
struct Unit { int pm, pn; };
struct Gemm { const bf16_t* A; int lda; const bf16_t* Bt; int M, N, K; };
struct StaticOrder {
    int nM, nN, nwg, G, c;
    DI void init(int M_, int N_, int G_, int c_) { nM = M_ / BM; nN = N_ / BM; nwg = nM * nN; G = G_; c = c_; }
    DI bool next(int i, Unit& u) const {
        const long L = (long)i * G + c; if (L >= nwg) return false;
        int wgid = (int)L; { const int q = nwg / NXCD, r = nwg % NXCD, xcd = wgid % NXCD, off = wgid / NXCD; wgid = (xcd < r ? xcd * (q + 1) : r * (q + 1) + (xcd - r) * q) + off; }
        const int nig = WGM * nN, gid = wgid / nig, fm = gid * WGM, gsz = (nM - fm) < WGM ? (nM - fm) : WGM;
        u.pm = fm + ((wgid % nig) % gsz); u.pn = (wgid % nig) / gsz; return true;
    }
};
DI unsigned cvt_pk_bf16(float lo, float hi) { unsigned r; asm volatile("v_cvt_pk_bf16_f32 %0, %1, %2" : "=v"(r) : "v"(lo), "v"(hi)); return r; }

template <int ACT> struct EpiSeg {
    bf16_t* d0; int ld0; int split; bf16_t* d1; int ld1;
    DI void operator()(const f32x4 (&acc)[2][2][4][2], const Unit& u, int wr, int wc, int fr, int fq) const {
        const int row0 = u.pm * BM + wr * 64 + fr; int colt = u.pn * BM; bf16_t* base = d0; int ld = ld0;
        if (colt >= split) { base = d1; ld = ld1; colt -= split; }
        const int col0 = colt + wc * 32 + 8 * fq;
#pragma unroll
        for (int ai = 0; ai < 2; ++ai)
#pragma unroll
            for (int m = 0; m < 4; ++m) { bf16_t* rowp = base + (size_t)(row0 + ai * HALF + m * 16) * ld + col0;
#pragma unroll
                for (int bj = 0; bj < 2; ++bj) { f32x4 v0 = acc[ai][bj][m][0], v1 = acc[ai][bj][m][1];
                    if (ACT == 1) {
#pragma unroll
                        for (int e = 0; e < 4; ++e) { float a = fmaxf(v0[e], 0.f), b = fmaxf(v1[e], 0.f); v0[e] = a * a; v1[e] = b * b; } }
                    u32x4 w; w.x = cvt_pk_bf16(v0[0], v0[1]); w.y = cvt_pk_bf16(v0[2], v0[3]); w.z = cvt_pk_bf16(v1[0], v1[1]); w.w = cvt_pk_bf16(v1[2], v1[3]);
                    *(u32x4*)(rowp + bj * HALF) = w; } }
    }
};
template <int MODE> struct EpiRes {
    float* X1; const float* xp; const float* xs; const float* xm;
    DI void operator()(const f32x4 (&acc)[2][2][4][2], const Unit& u, int wr, int wc, int fr, int fq) const {
        const int row0 = u.pm * BM + wr * 64 + fr; const int col0 = u.pn * BM + wc * 32 + 8 * fq;
#pragma unroll
        for (int ai = 0; ai < 2; ++ai)
#pragma unroll
            for (int m = 0; m < 4; ++m) { const int row = row0 + ai * HALF + m * 16; float* op = X1 + (size_t)row * D + col0;
                const float* bp = (MODE == 1) ? op : (row < M ? xrow3(xp, xs, xm, row) + col0 : nullptr);
#pragma unroll
                for (int bj = 0; bj < 2; ++bj) { f32x4 b0 = (f32x4){0.f, 0.f, 0.f, 0.f}, b1 = b0;
                    if (bp) { b0 = *(const f32x4*)(bp + bj * HALF); b1 = *(const f32x4*)(bp + bj * HALF + 4); }
                    *(f32x4*)(op + bj * HALF) = acc[ai][bj][m][0] + b0; *(f32x4*)(op + bj * HALF + 4) = acc[ai][bj][m][1] + b1; } }
    }
};

template <int K, int lda, class Epi>
DI void gemm_phase(LAS unsigned char* lds, const Gemm g, const StaticOrder& S, const Epi& E) {
    const int tid = otid(), wid = __builtin_amdgcn_readfirstlane(tid >> 6), lane = tid & 63, wr = wid >> 2, wc = wid & 3, fr = lane & 15, fq = lane >> 4;
    constexpr int nt = K / BK;
    unsigned voffA[2], voffB[2];
#pragma unroll
    for (int i = 0; i < 2; ++i) { int R, C; stage_rc(tid * 16 + i * 8192, R, C); const int Rb = (R & ~31) + perm32(R & 31);
        voffA[i] = (unsigned)(R * lda + C) * 2u; voffB[i] = (unsigned)(Rb * K + C) * 2u; }
    const size_t kstep = (size_t)(BK * 2);
    const size_t hA = (size_t)HALF * lda * 2, hB = (size_t)HALF * K * 2;
    const size_t tA = 2 * hA, tB = 2 * hB;
    const unsigned ldsw = (unsigned)wid * 1024u;
    const int aoff = lds_byte(wr * 64 + fr, fq * 8), boff = lds_byte(wc * 32 + fr, fq * 8);
#define PG8_SA(b, h) (((b) * 2 + (h)) * HTB)
#define PG8_SB(b, h) ((4 + (b) * 2 + (h)) * HTB)
#define PG8_STAGE(bufoff, gbase, voff) do { _Pragma("unroll") for (int _i = 0; _i < 2; ++_i) \
        __builtin_amdgcn_global_load_lds((const unsigned*)((const char*)(gbase) + (voff)[_i]), (LAS unsigned*)(lds + (bufoff) + ldsw + _i * 8192), 16, 0, 0); } while (0)
#define PG8_LDA(dst, b, h) do { _Pragma("unroll") for (int m = 0; m < 4; ++m) _Pragma("unroll") for (int k = 0; k < 2; ++k) dst[m][k] = *(const LAS bf16x8*)(lds + PG8_SA(b, h) + aoff + m * 2048 + k * 1024); } while (0)
#define PG8_LDB(dst, b, h) do { _Pragma("unroll") for (int n = 0; n < 2; ++n) _Pragma("unroll") for (int k = 0; k < 2; ++k) dst[n][k] = *(const LAS bf16x8*)(lds + PG8_SB(b, h) + boff + n * 2048 + k * 1024); } while (0)
#define PG8_MMA(ai, bj, At, Bt) do { __builtin_amdgcn_s_setprio(1); _Pragma("unroll") for (int m = 0; m < 4; ++m) _Pragma("unroll") for (int n = 0; n < 2; ++n) _Pragma("unroll") for (int k = 0; k < 2; ++k) \
        acc[ai][bj][m][n] = __builtin_amdgcn_mfma_f32_16x16x32_bf16(Bt[n][k], At[m][k], acc[ai][bj][m][n], 0, 0, 0); __builtin_amdgcn_s_setprio(0); } while (0)
#define PG8_WAIT_V(n) asm volatile("s_waitcnt vmcnt(" #n ")" ::: "memory")
#define PG8_WAIT_L(n) asm volatile("s_waitcnt lgkmcnt(" #n ")" ::: "memory")
#define PG8_BAR __builtin_amdgcn_s_barrier()
#define PG8_SCHED __builtin_amdgcn_sched_barrier(0)
    Unit cur, nxt; int ui = 0;
    if (!S.next(0, cur)) return;
    f32x4 acc[2][2][4][2];
#pragma unroll
    for (int a = 0; a < 2; ++a)
#pragma unroll
        for (int b = 0; b < 2; ++b)
#pragma unroll
            for (int m = 0; m < 4; ++m)
#pragma unroll
                for (int n = 0; n < 2; ++n) acc[a][b][m][n] = (f32x4){0.f, 0.f, 0.f, 0.f};
    bf16x8 At[4][2], B0[2][2], B1[2][2];
    const char* cA = (const char*)g.A + (size_t)cur.pm * tA; const char* cB = (const char*)g.Bt + (size_t)cur.pn * tB;
    PG8_STAGE(PG8_SB(0, 0), cB, voffB); PG8_STAGE(PG8_SA(0, 0), cA, voffA); PG8_STAGE(PG8_SB(0, 1), cB + hB, voffB); PG8_STAGE(PG8_SA(0, 1), cA + hA, voffA);
    if (wr == 1) PG8_BAR;
    PG8_WAIT_V(4); PG8_BAR;
    PG8_STAGE(PG8_SB(1, 0), cB + kstep, voffB); PG8_STAGE(PG8_SA(1, 0), cA + kstep, voffA); PG8_STAGE(PG8_SB(1, 1), cB + hB + kstep, voffB);
    PG8_WAIT_V(6); PG8_BAR;
    for (;;) {
        const bool has_next = S.next(ui + 1, nxt);
        const char* nA = has_next ? (const char*)g.A + (size_t)nxt.pm * tA : cA; const char* nB = has_next ? (const char*)g.Bt + (size_t)nxt.pn * tB : cB;
        for (int t = 0; t < nt; t += 2) {
            const bool last = (t == nt - 2);
            const char* a1 = cA + (size_t)(t + 1) * kstep;
            const char* a2 = last ? nA : cA + (size_t)(t + 2) * kstep; const char* b2 = last ? nB : cB + (size_t)(t + 2) * kstep;
            const char* a3 = a2 + kstep; const char* b3 = b2 + kstep;
            PG8_LDB(B0, 0, 0); PG8_SCHED; PG8_LDA(At, 0, 0); PG8_STAGE(PG8_SA(1, 1), a1 + hA, voffA);
            PG8_WAIT_L(8); PG8_BAR; PG8_WAIT_L(0); PG8_MMA(0, 0, At, B0); PG8_BAR; PG8_SCHED;
            PG8_LDB(B1, 0, 1); PG8_STAGE(PG8_SB(0, 0), b2, voffB);
            PG8_BAR; PG8_WAIT_L(0); PG8_MMA(0, 1, At, B1); PG8_BAR;
            PG8_LDA(At, 0, 1); PG8_STAGE(PG8_SA(0, 0), a2, voffA);
            PG8_BAR; PG8_WAIT_L(0); PG8_MMA(1, 0, At, B0); PG8_BAR; PG8_SCHED;
            PG8_STAGE(PG8_SB(0, 1), b2 + hB, voffB);
            PG8_WAIT_V(6); PG8_BAR; PG8_MMA(1, 1, At, B1); PG8_BAR;
            PG8_LDB(B0, 1, 0); PG8_SCHED; PG8_LDA(At, 1, 0); PG8_STAGE(PG8_SA(0, 1), a2 + hA, voffA);
            PG8_WAIT_L(8); PG8_BAR; PG8_WAIT_L(0); PG8_MMA(0, 0, At, B0); PG8_BAR; PG8_SCHED;
            PG8_LDB(B1, 1, 1); PG8_STAGE(PG8_SB(1, 0), b3, voffB);
            PG8_BAR; PG8_WAIT_L(0); PG8_MMA(0, 1, At, B1); PG8_BAR;
            PG8_LDA(At, 1, 1); PG8_STAGE(PG8_SA(1, 0), a3, voffA);
            PG8_BAR; PG8_WAIT_L(0); PG8_MMA(1, 0, At, B0); PG8_BAR; PG8_SCHED;
            PG8_STAGE(PG8_SB(1, 1), b3 + hB, voffB);
            PG8_WAIT_V(6); PG8_BAR; PG8_MMA(1, 1, At, B1); PG8_BAR;
        }
        E(acc, cur, wr, wc, fr, fq);
        if (!has_next) break;
#pragma unroll
        for (int a = 0; a < 2; ++a)
#pragma unroll
            for (int b = 0; b < 2; ++b)
#pragma unroll
                for (int m = 0; m < 4; ++m)
#pragma unroll
                    for (int n = 0; n < 2; ++n) acc[a][b][m][n] = (f32x4){0.f, 0.f, 0.f, 0.f};
        cur = nxt; cA = nA; cB = nB; ++ui;
    }
    PG8_WAIT_V(0);
    if (wr == 0) PG8_BAR;
    PG8_BAR;
#undef PG8_SA
#undef PG8_SB
#undef PG8_STAGE
#undef PG8_LDA
#undef PG8_LDB
#undef PG8_MMA
#undef PG8_WAIT_V
#undef PG8_WAIT_L
#undef PG8_BAR
#undef PG8_SCHED
}
}

DI void transpose_item(const float* W, int ldw, int nblk, bf16_t* WT, int K, int row_off, LAS float* scr, int item, int lane) {
    const int kb = item / nblk, nb = item - kb * nblk, k0 = 64 * kb, n0 = 32 * nb;
#pragma unroll 8
    for (int i = 0; i < 32; ++i) { const int kk = 2 * i + (lane >> 5); scr[kk * 33 + (lane & 31)] = W[(size_t)(k0 + kk) * ldw + n0 + (lane & 31)]; }
    LDS_WAIT();
    const int c = lane & 7;
#pragma unroll
    for (int j = 0; j < 4; ++j) { const int n = (lane >> 3) + 8 * j; const LAS float* s = scr + (8 * c) * 33 + n;
        u32x4 o; o.x = pk2(s[0 * 33], s[1 * 33]); o.y = pk2(s[2 * 33], s[3 * 33]); o.z = pk2(s[4 * 33], s[5 * 33]); o.w = pk2(s[6 * 33], s[7 * 33]);
        *(u32x4*)(WT + (size_t)(row_off + n0 + n) * K + k0 + 8 * c) = o; }
    LDS_WAIT();
}

DI void rms_row(const float* xr, const float* g, bf16_t* orow, int lane, f32x4 (&v)[4]) {
    float s = 0.f;
#pragma unroll
    for (int j = 0; j < 4; ++j) { v[j] = *(const f32x4*)(xr + 4 * lane + 256 * j); s += (v[j].x * v[j].x + v[j].y * v[j].y) + (v[j].z * v[j].z + v[j].w * v[j].w); }
    const float rstd = 1.f / sqrtf(wave_sum(s) * (1.f / D) + 1e-6f);
#pragma unroll
    for (int j = 0; j < 4; ++j) { const f32x4 gg = *(const f32x4*)(g + 4 * lane + 256 * j); v[j] = v[j] * rstd * gg;
        if (orow) { unsigned long long o = (unsigned long long)pk2(v[j].x, v[j].y) | ((unsigned long long)pk2(v[j].z, v[j].w) << 32); *(unsigned long long*)(orow + 4 * lane + 256 * j) = o; } }
}

DI void phase0(const Params& p, LAS unsigned char* lds) {
    const int tid = otid(), lane = tid & 63, wave = __builtin_amdgcn_readfirstlane(tid >> 6);
    LAS float* scr = (LAS float*)(lds + wave * 16384);
    const int gw = blockIdx.x * 8 + wave, NGW = gridDim.x * 8;
    bf16_t* WIN = (bf16_t*)((unsigned char*)p.out + DO_WIN);
    bf16_t* WOUT = (bf16_t*)(p.ws + WS_WOUT); bf16_t* WF1 = (bf16_t*)(p.ws + WS_WFF1); bf16_t* WF2 = (bf16_t*)(p.ws + WS_WFF2); bf16_t* WG2 = (bf16_t*)(p.ws + WS_WG2);
    const float* w_in = p.in[8];
    constexpr int I0 = 16 * 96, I1 = 16 * 104, I2 = 16 * 32, I3 = 16 * 64, I4 = 16 * 32, I5 = 16 * 128, I6 = 64 * 32, I7 = 2 * 32;
    constexpr int NIT = I0 + I1 + I2 + I3 + I4 + I5 + I6 + I7;
    for (int it = gw; it < NIT; it += NGW) {
        int r = it;
        if (r < I0) { transpose_item(w_in, PROJW, 96, WIN, 1024, 0, scr, r, lane); continue; } r -= I0;
        if (r < I1) { transpose_item(w_in + 4112, PROJW, 104, WIN, 1024, 3072, scr, r, lane); continue; } r -= I1;
        if (r < I2) { transpose_item(w_in + 3072, PROJW, 32, WIN, 1024, 6400, scr, r, lane); continue; } r -= I2;
        if (r < I3) { transpose_item(w_in + 7440, PROJW, 64, WIN, 1024, 7424, scr, r, lane); continue; } r -= I3;
        if (r < I4) { transpose_item(p.in[24], 1024, 32, WOUT, 1024, 0, scr, r, lane); continue; } r -= I4;
        if (r < I5) { transpose_item(p.in[26], 4096, 128, WF1, 1024, 0, scr, r, lane); continue; } r -= I5;
        if (r < I6) { transpose_item(p.in[27], 1024, 32, WF2, 4096, 0, scr, r, lane); continue; } r -= I6;
        transpose_item(p.in[18], 1024, 32, WG2, 128, 0, scr, r, lane);
    }
    bf16_t* H = (bf16_t*)((unsigned char*)p.out + DO_H);
    float* GDN = (float*)(p.ws + WS_GDN); float* BETA = (float*)(p.ws + WS_BETA);
    for (int m = gw; m < MP; m += NGW) {
        bf16_t* hr = H + (size_t)m * D;
        if (m >= M) {
#pragma unroll
            for (int j = 0; j < 4; ++j) *(unsigned long long*)(hr + 4 * lane + 256 * j) = 0ull;
            continue;
        }
        f32x4 v[4];
        rms_row(xrow(p, m), p.in[7], hr, lane, v);
        float s[16];
#pragma unroll
        for (int i = 0; i < 16; ++i) s[i] = 0.f;
#pragma unroll
        for (int j = 0; j < 4; ++j)
#pragma unroll
            for (int e = 0; e < 4; ++e) { const int k = 4 * lane + 256 * j + e; const float hv = v[j][e]; const float* wr_ = w_in + (size_t)k * PROJW + 4096;
#pragma unroll
                for (int q = 0; q < 4; ++q) { const f32x4 w4 = *(const f32x4*)(wr_ + 4 * q); s[4 * q] += hv * w4.x; s[4 * q + 1] += hv * w4.y; s[4 * q + 2] += hv * w4.z; s[4 * q + 3] += hv * w4.w; } }
        float mine = 0.f;
#pragma unroll
        for (int i = 0; i < 16; ++i) { const float t = wave_sum(s[i]); if (lane == i) mine = t; }
        if (lane < 8) GDN[(size_t)m * 8 + lane] = -__expf(p.in[10][lane]) * softplusf_(mine + p.in[11][lane]);
        else if (lane < 16) BETA[(size_t)m * 8 + lane - 8] = sigmoidf_(mine);
    }
}

DI void dn_item(const Params& p, LAS unsigned char* lds, int b, int h, int dvh, bool prompt) {
    const int tid = otid(), lane = tid & 63, w = __builtin_amdgcn_readfirstlane(tid >> 6);
    LAS float* sQ = (LAS float*)(lds);
    LAS float* sK = (LAS float*)(lds + 32768);
    LAS float* sV = (LAS float*)(lds + 65536);
    LAS float* sO = (LAS float*)(lds + 81920);
    LAS float* sPart = (LAS float*)(lds + 98304);
    LAS float* sHalo = (LAS float*)(lds + 106496);
    LAS float* sBeta = (LAS float*)(lds + 114176);
    LAS float* sEg = (LAS float*)(lds + 114432);
    const int T = prompt ? TP : TS, row0 = prompt ? b * TP : MPR + b * TS;
    const bf16_t* QKV = (const bf16_t*)(p.ws + WS_QKV);
    bf16_t* QKVo = (bf16_t*)(p.ws + WS_QKV);
    const float* GDN = (const float*)(p.ws + WS_GDN); const float* BETA = (const float*)(p.ws + WS_BETA);
    float S[16];
    const int vcol = dvh * 64 + lane;
    if (prompt) {
#pragma unroll
        for (int j = 0; j < 16; ++j) S[j] = 0.f;
    } else {
        const float* st = p.in[3] + ((size_t)(b * 8 + h) * 128) * 128;
#pragma unroll
        for (int j = 0; j < 16; ++j) S[j] = st[(size_t)(16 * w + j) * 128 + vcol];
    }
    const int cg_ = lane, run = w;
    const bool act = cg_ < 40;
    int ch = 0;
    if (cg_ < 16) ch = h * 128 + cg_ * 8; else if (cg_ < 32) ch = 1024 + h * 128 + (cg_ - 16) * 8; else ch = 2048 + h * 128 + dvh * 64 + (cg_ - 32) * 8;
    if (tid < 320 * 3) {
        for (int idx = tid; idx < 960; idx += 512) {
            const int j = idx / 320, c = idx - j * 320; const int cgi = c >> 3, e = c & 7;
            int chh; if (cgi < 16) chh = h * 128 + cgi * 8; else if (cgi < 32) chh = 1024 + h * 128 + (cgi - 16) * 8; else chh = 2048 + h * 128 + dvh * 64 + (cgi - 32) * 8;
            sHalo[idx] = prompt ? 0.f : p.in[2][((size_t)b * 3 + j) * QKVW + chh + e];
        }
    }
    __syncthreads();
    int hb = 0;
    const float* cw = p.in[9];
    for (int t0 = 0; t0 < T; t0 += 64) {
        const int C = (T - t0) < 64 ? (T - t0) : 64;
        float val[8][8];
        const bool mine = act && (run * 8 < C);
        if (mine) {
            float cwv[4][8];
#pragma unroll
            for (int j = 0; j < 4; ++j) { const f32x4 a = *(const f32x4*)(cw + j * QKVW + ch), bq = *(const f32x4*)(cw + j * QKVW + ch + 4);
                cwv[j][0] = a.x; cwv[j][1] = a.y; cwv[j][2] = a.z; cwv[j][3] = a.w; cwv[j][4] = bq.x; cwv[j][5] = bq.y; cwv[j][6] = bq.z; cwv[j][7] = bq.w; }
            float r0[8], r1[8], r2[8], r3[8];
            if (run == 0) {
#pragma unroll
                for (int e = 0; e < 8; ++e) { r0[e] = sHalo[hb * 960 + 0 * 320 + cg_ * 8 + e]; r1[e] = sHalo[hb * 960 + 320 + cg_ * 8 + e]; r2[e] = sHalo[hb * 960 + 640 + cg_ * 8 + e]; }
            } else {
                const bf16_t* bp = QKV + (size_t)(row0 + t0 + run * 8 - 3) * QKVW + ch;
                load8bf(bp, r0); load8bf(bp + QKVW, r1); load8bf(bp + 2 * QKVW, r2);
            }
            const bf16_t* bp = QKV + (size_t)(row0 + t0 + run * 8) * QKVW + ch;
#pragma unroll
            for (int tt = 0; tt < 8; ++tt) {
                load8bf(bp + (size_t)tt * QKVW, r3);
#pragma unroll
                for (int e = 0; e < 8; ++e) { const float x = cwv[0][e] * r0[e] + cwv[1][e] * r1[e] + cwv[2][e] * r2[e] + cwv[3][e] * r3[e]; val[tt][e] = siluf_(x); }
#pragma unroll
                for (int e = 0; e < 8; ++e) { r0[e] = r1[e]; r1[e] = r2[e]; r2[e] = r3[e]; }
            }
            if (run * 8 + 8 == C) {
#pragma unroll
                for (int e = 0; e < 8; ++e) { sHalo[(hb ^ 1) * 960 + cg_ * 8 + e] = r0[e]; sHalo[(hb ^ 1) * 960 + 320 + cg_ * 8 + e] = r1[e]; sHalo[(hb ^ 1) * 960 + 640 + cg_ * 8 + e] = r2[e]; }
            }
        } else {
#pragma unroll
            for (int tt = 0; tt < 8; ++tt)
#pragma unroll
                for (int e = 0; e < 8; ++e) val[tt][e] = 0.f;
        }
        if (tid < 64) { const int t = tid; float be = 0.f, eg = 1.f; if (t < C) { be = BETA[(size_t)(row0 + t0 + t) * 8 + h]; eg = __expf(GDN[(size_t)(row0 + t0 + t) * 8 + h]); } sBeta[t] = be; sEg[t] = eg; }
        __syncthreads();
#pragma unroll
        for (int tt = 0; tt < 8; ++tt) {
            float ss = 0.f;
#pragma unroll
            for (int e = 0; e < 8; ++e) ss += val[tt][e] * val[tt][e];
            ss += __shfl_xor(ss, 1); ss += __shfl_xor(ss, 2); ss += __shfl_xor(ss, 4); ss += __shfl_xor(ss, 8);
            const int t = run * 8 + tt;
            if (mine) {
                if (cg_ < 32) { float sc = 1.f / sqrtf(ss + 1e-6f); if (cg_ < 16) sc *= 0.08838834764831845f;
                    LAS float* dst = (cg_ < 16 ? sQ : sK) + t * 128 + (cg_ & 15) * 8;
#pragma unroll
                    for (int e = 0; e < 8; ++e) dst[e] = val[tt][e] * sc;
                } else { const float be = sBeta[t]; LAS float* dst = sV + t * 64 + (cg_ - 32) * 8;
#pragma unroll
                    for (int e = 0; e < 8; ++e) dst[e] = val[tt][e] * be; }
            }
        }
        hb ^= 1;
        __syncthreads();
        for (int tt = 0; tt < C; ++tt) {
            f32x4 k4[4], q4[4];
#pragma unroll
            for (int i = 0; i < 4; ++i) { k4[i] = *(const LAS f32x4*)(sK + tt * 128 + 16 * w + 4 * i); q4[i] = *(const LAS f32x4*)(sQ + tt * 128 + 16 * w + 4 * i); }
            float part = 0.f;
#pragma unroll
            for (int i = 0; i < 4; ++i)
#pragma unroll
                for (int e = 0; e < 4; ++e) part += S[4 * i + e] * k4[i][e];
            LAS float* pp = sPart + (tt & 1) * 512;
            LAS float* po = sPart + 1024 + (tt & 1) * 512;
            pp[w * 64 + lane] = part;
            __syncthreads();
            if (tt > 0 && w == ((tt - 1) & 7)) { LAS float* pq = sPart + 1024 + ((tt - 1) & 1) * 512; float o = 0.f;
#pragma unroll
                for (int w2 = 0; w2 < 8; ++w2) o += pq[w2 * 64 + lane];
                sO[(tt - 1) * 64 + lane] = o; }
            float sa = 0.f;
#pragma unroll
            for (int w2 = 0; w2 < 8; ++w2) sa += pp[w2 * 64 + lane];
            const float eg = sEg[tt], be = sBeta[tt];
            const float c = sV[tt * 64 + lane] - be * eg * sa;
            float op = 0.f;
#pragma unroll
            for (int i = 0; i < 4; ++i)
#pragma unroll
                for (int e = 0; e < 4; ++e) { const float s = S[4 * i + e] * eg + c * k4[i][e]; S[4 * i + e] = s; op += s * q4[i][e]; }
            po[w * 64 + lane] = op;
        }
        __syncthreads();
        if (w == ((C - 1) & 7)) { LAS float* pq = sPart + 1024 + ((C - 1) & 1) * 512; float o = 0.f;
#pragma unroll
            for (int w2 = 0; w2 < 8; ++w2) o += pq[w2 * 64 + lane];
            sO[(C - 1) * 64 + lane] = o; }
        __syncthreads();
        { const int t = tid >> 3, part = tid & 7;
          if (t < C) { float o[8];
#pragma unroll
              for (int e = 0; e < 8; ++e) o[e] = sO[t * 64 + part * 8 + e];
              *(u32x4*)(QKVo + (size_t)(row0 + t0 + t) * QKVW + 2048 + h * 128 + dvh * 64 + part * 8) = pack8(o); } }
        __syncthreads();
    }
    float* so = p.out + (prompt ? O_DNP : O_DNS) + ((size_t)(b * 8 + h) * 128) * 128;
#pragma unroll
    for (int j = 0; j < 16; ++j) so[(size_t)(16 * w + j) * 128 + vcol] = S[j];
    float* co = p.out + (prompt ? O_CONVP : O_CONVS) + (size_t)b * 3 * QKVW;
    for (int idx = tid; idx < 960; idx += 512) {
        const int j = idx / 320, c = idx - j * 320; const int cgi = c >> 3, e = c & 7;
        if (cgi < 32 && dvh != 0) continue;
        int chh; if (cgi < 16) chh = h * 128 + cgi * 8; else if (cgi < 32) chh = 1024 + h * 128 + (cgi - 16) * 8; else chh = 2048 + h * 128 + dvh * 64 + (cgi - 32) * 8;
        co[(size_t)j * QKVW + chh + e] = sHalo[hb * 960 + idx];
    }
    __syncthreads();
}

DI void rw_item(const Params& p, LAS unsigned char* lds, int b, int h, bool prompt) {
    const int tid = otid(), lane = tid & 63, w = __builtin_amdgcn_readfirstlane(tid >> 6);
    LAS float* sR = (LAS float*)(lds);
    LAS float* sV = (LAS float*)(lds + 16384);
    LAS float* sNKK = (LAS float*)(lds + 32768);
    LAS float* sW = (LAS float*)(lds + 49152);
    LAS float* sB = (LAS float*)(lds + 65536);    LAS float* sAL = sB;
    LAS float* sKn = (LAS float*)(lds + 81920);
    LAS float* sO = (LAS float*)(lds + 98304);    LAS float* sTW = sO;
    LAS float* sPart = (LAS float*)(lds + 114688);
    LAS float* sPrev = (LAS float*)(lds + 122880);
    LAS float* sBonus = (LAS float*)(lds + 126464);
    const int T = prompt ? TP : TS, row0 = prompt ? b * TP : MPR + b * TS;
    bf16_t* RW = (bf16_t*)(p.ws + WS_RW);
    const float* mu = p.in[13];
    float S[8];
    if (prompt) {
#pragma unroll
        for (int j = 0; j < 8; ++j) S[j] = 0.f;
    } else {
        const float* st = p.in[5] + ((size_t)(b * 16 + h) * 64 + lane) * 64 + 8 * w;
        const f32x4 a = *(const f32x4*)st, c = *(const f32x4*)(st + 4);
        S[0] = a.x; S[1] = a.y; S[2] = a.z; S[3] = a.w; S[4] = c.x; S[5] = c.y; S[6] = c.z; S[7] = c.w;
    }
    for (int i = tid; i < 448; i += 512) {
        int col; if (i < 64) col = h * 64 + i; else if (i < 128) col = 1024 + h * 64 + (i - 64); else if (i < 192) col = 2048 + h * 64 + (i - 128); else col = 3072 + (i - 192);
        sPrev[i] = prompt ? 0.f : p.in[4][(size_t)b * RWW + col];
    }
    __syncthreads();
    int pb = 0;
    const int t = tid >> 3, part = tid & 7;
    const int cb[5] = {h * 64 + 8 * part, 1024 + h * 64 + 8 * part, 2048 + h * 64 + 8 * part, 3072 + 8 * part, 3136 + 8 * part};
    for (int t0 = 0; t0 < T; t0 += 64) {
        const int C = (T - t0) < 64 ? (T - t0) : 64;
        const bool actv = t < C;
        const size_t row = (size_t)(row0 + t0 + t);
        float xr[8], kr[8];
        float gsig[16];
        if (actv) {
#pragma unroll
            for (int s = 0; s < 5; ++s) {
                float cur[8], prv[8];
                load8bf(RW + row * RWW + cb[s], cur);
                if (t > 0) load8bf(RW + (row - 1) * RWW + cb[s], prv);
                else {
#pragma unroll
                    for (int e = 0; e < 8; ++e) prv[e] = sPrev[pb * 448 + s * 64 + 8 * part + e];
                }
                if (t == C - 1) {
#pragma unroll
                    for (int e = 0; e < 8; ++e) sPrev[(pb ^ 1) * 448 + s * 64 + 8 * part + e] = cur[e];
                }
                const f32x4 m0 = *(const f32x4*)(mu + cb[s]), m1 = *(const f32x4*)(mu + cb[s] + 4);
                const float mm[8] = {m0.x, m0.y, m0.z, m0.w, m1.x, m1.y, m1.z, m1.w};
                float xm[8];
#pragma unroll
                for (int e = 0; e < 8; ++e) xm[e] = cur[e] + (prv[e] - cur[e]) * mm[e];
                if (s == 0) {
#pragma unroll
                    for (int e = 0; e < 8; ++e) { xr[e] = xm[e]; sR[t * 64 + 8 * part + e] = xm[e]; }
                } else if (s == 1) {
#pragma unroll
                    for (int e = 0; e < 8; ++e) kr[e] = xm[e];
                } else if (s == 2) {
#pragma unroll
                    for (int e = 0; e < 8; ++e) sV[t * 64 + 8 * part + e] = xm[e];
                } else if (s == 3) {
#pragma unroll
                    for (int e = 0; e < 8; ++e) sTW[t * 64 + 8 * part + e] = tanhf(xm[e]);
                } else {
#pragma unroll
                    for (int e = 0; e < 8; ++e) sAL[t * 64 + 8 * part + e] = xm[e];
                }
            }
            if (h == 0) {
#pragma unroll
                for (int q = 0; q < 2; ++q) {
                    const int c0 = 3200 + 16 * part + 8 * q;
                    float cur[8], prv[8];
                    load8bf(RW + row * RWW + c0, cur);
                    if (t > 0) load8bf(RW + (row - 1) * RWW + c0, prv);
                    else {
#pragma unroll
                        for (int e = 0; e < 8; ++e) prv[e] = sPrev[pb * 448 + 320 + 16 * part + 8 * q + e];
                    }
                    if (t == C - 1) {
#pragma unroll
                        for (int e = 0; e < 8; ++e) sPrev[(pb ^ 1) * 448 + 320 + 16 * part + 8 * q + e] = cur[e];
                    }
                    const f32x4 m0 = *(const f32x4*)(mu + c0), m1 = *(const f32x4*)(mu + c0 + 4);
                    const float mm[8] = {m0.x, m0.y, m0.z, m0.w, m1.x, m1.y, m1.z, m1.w};
#pragma unroll
                    for (int e = 0; e < 8; ++e) gsig[8 * q + e] = sigmoidf_(cur[e] + (prv[e] - cur[e]) * mm[e]);
                }
            }
        }
        __syncthreads();
        if (actv && h == 0) {
            *(u32x4*)(RW + row * RWW + 3200 + 16 * part) = pack8(gsig);
            *(u32x4*)(RW + row * RWW + 3200 + 16 * part + 8) = pack8(gsig + 8);
        }
        float nkk[8], wd[8], bb[8], kn[8]; float bonus = 0.f;
        if (actv) {
            float ws_[8], as_[8];
#pragma unroll
            for (int e = 0; e < 8; ++e) { ws_[e] = 0.f; as_[e] = 0.f; }
            const float* w2 = p.in[15] + h * 64 + 8 * part; const float* a2 = p.in[17] + h * 64 + 8 * part;
#pragma unroll 4
            for (int j = 0; j < 64; ++j) {
                const float tw = sTW[t * 64 + j], al = sAL[t * 64 + j];
                const f32x4 wa = *(const f32x4*)(w2 + (size_t)j * 1024), wb = *(const f32x4*)(w2 + (size_t)j * 1024 + 4);
                const f32x4 aa = *(const f32x4*)(a2 + (size_t)j * 1024), ab = *(const f32x4*)(a2 + (size_t)j * 1024 + 4);
                ws_[0] += tw * wa.x; ws_[1] += tw * wa.y; ws_[2] += tw * wa.z; ws_[3] += tw * wa.w; ws_[4] += tw * wb.x; ws_[5] += tw * wb.y; ws_[6] += tw * wb.z; ws_[7] += tw * wb.w;
                as_[0] += al * aa.x; as_[1] += al * aa.y; as_[2] += al * aa.z; as_[3] += al * aa.w; as_[4] += al * ab.x; as_[5] += al * ab.y; as_[6] += al * ab.z; as_[7] += al * ab.w;
            }
            const int c0 = h * 64 + 8 * part;
            float n2 = 0.f, a_[8], kkr[8];
#pragma unroll
            for (int e = 0; e < 8; ++e) {
                const float wl = -softplusf_(-(p.in[14][c0 + e] + ws_[e])) - 0.5f;
                wd[e] = __expf(-__expf(wl));
                a_[e] = sigmoidf_(p.in[16][c0 + e] + as_[e]);
                kkr[e] = kr[e] * p.in[19][c0 + e]; n2 += kkr[e] * kkr[e];
                kn[e] = kr[e] * (1.f + (a_[e] - 1.f) * p.in[20][c0 + e]);
                bonus += xr[e] * kn[e] * p.in[21][c0 + e];
            }
            n2 += __shfl_xor(n2, 1); n2 += __shfl_xor(n2, 2); n2 += __shfl_xor(n2, 4);
            bonus += __shfl_xor(bonus, 1); bonus += __shfl_xor(bonus, 2); bonus += __shfl_xor(bonus, 4);
            const float rn = 1.f / sqrtf(n2 + 1e-6f);
#pragma unroll
            for (int e = 0; e < 8; ++e) { const float kk = kkr[e] * rn; nkk[e] = -kk; bb[e] = kk * a_[e]; }
        } else {
            float n2 = 0.f; n2 += __shfl_xor(n2, 1); n2 += __shfl_xor(n2, 2); n2 += __shfl_xor(n2, 4);
            bonus += __shfl_xor(bonus, 1); bonus += __shfl_xor(bonus, 2); bonus += __shfl_xor(bonus, 4);
#pragma unroll
            for (int e = 0; e < 8; ++e) { nkk[e] = 0.f; wd[e] = 1.f; bb[e] = 0.f; kn[e] = 0.f; }
        }
        __syncthreads();
        if (actv) {
#pragma unroll
            for (int e = 0; e < 8; ++e) { sNKK[t * 64 + 8 * part + e] = nkk[e]; sW[t * 64 + 8 * part + e] = wd[e]; sB[t * 64 + 8 * part + e] = bb[e]; sKn[t * 64 + 8 * part + e] = kn[e]; }
            if (part == 0) sBonus[t] = bonus;
        }
        pb ^= 1;
        __syncthreads();
        for (int tt = 0; tt < C; ++tt) {
            const f32x4 n0 = *(const LAS f32x4*)(sNKK + tt * 64 + 8 * w), n1 = *(const LAS f32x4*)(sNKK + tt * 64 + 8 * w + 4);
            const f32x4 w0 = *(const LAS f32x4*)(sW + tt * 64 + 8 * w), w1 = *(const LAS f32x4*)(sW + tt * 64 + 8 * w + 4);
            const f32x4 b0 = *(const LAS f32x4*)(sB + tt * 64 + 8 * w), b1 = *(const LAS f32x4*)(sB + tt * 64 + 8 * w + 4);
            const f32x4 k0 = *(const LAS f32x4*)(sKn + tt * 64 + 8 * w), k1 = *(const LAS f32x4*)(sKn + tt * 64 + 8 * w + 4);
            const f32x4 r0 = *(const LAS f32x4*)(sR + tt * 64 + 8 * w), r1 = *(const LAS f32x4*)(sR + tt * 64 + 8 * w + 4);
            float part_ = 0.f;
#pragma unroll
            for (int e = 0; e < 4; ++e) part_ += S[e] * n0[e] + S[4 + e] * n1[e];
            LAS float* pp = sPart + (tt & 1) * 512;
            LAS float* po = sPart + 1024 + (tt & 1) * 512;
            pp[w * 64 + lane] = part_;
            __syncthreads();
            if (tt > 0 && w == ((tt - 1) & 7)) { LAS float* pq = sPart + 1024 + ((tt - 1) & 1) * 512; float o = 0.f;
#pragma unroll
                for (int w2 = 0; w2 < 8; ++w2) o += pq[w2 * 64 + lane];
                sO[(tt - 1) * 64 + lane] = o; }
            float sa = 0.f;
#pragma unroll
            for (int w2 = 0; w2 < 8; ++w2) sa += pp[w2 * 64 + lane];
            const float v = sV[tt * 64 + lane];
            float op = 0.f;
#pragma unroll
            for (int e = 0; e < 4; ++e) {
                float s0 = S[e] * w0[e] + sa * b0[e] + v * k0[e]; S[e] = s0; op += s0 * r0[e];
                float s1 = S[4 + e] * w1[e] + sa * b1[e] + v * k1[e]; S[4 + e] = s1; op += s1 * r1[e];
            }
            po[w * 64 + lane] = op;
        }
        __syncthreads();
        if (w == ((C - 1) & 7)) { LAS float* pq = sPart + 1024 + ((C - 1) & 1) * 512; float o = 0.f;
#pragma unroll
            for (int w2 = 0; w2 < 8; ++w2) o += pq[w2 * 64 + lane];
            sO[(C - 1) * 64 + lane] = o; }
        __syncthreads();
        {
            float o[8]; float sm = 0.f;
#pragma unroll
            for (int e = 0; e < 8; ++e) { o[e] = actv ? sO[t * 64 + 8 * part + e] : 0.f; sm += o[e]; }
            sm += __shfl_xor(sm, 1); sm += __shfl_xor(sm, 2); sm += __shfl_xor(sm, 4);
            const float mean = sm * (1.f / 64.f); float vs = 0.f;
#pragma unroll
            for (int e = 0; e < 8; ++e) { o[e] -= mean; vs += o[e] * o[e]; }
            vs += __shfl_xor(vs, 1); vs += __shfl_xor(vs, 2); vs += __shfl_xor(vs, 4);
            const float rs = 1.f / sqrtf(vs * (1.f / 64.f) + 64e-5f);
            if (actv) { const int c0 = h * 64 + 8 * part; const float bo = sBonus[t]; float y[8];
#pragma unroll
                for (int e = 0; e < 8; ++e) y[e] = o[e] * rs * p.in[22][c0 + e] + p.in[23][c0 + e] + bo * sV[t * 64 + 8 * part + e];
                *(u32x4*)(RW + row * RWW + 2048 + c0) = pack8(y); }
        }
        __syncthreads();
    }
    float* so = p.out + (prompt ? O_RWP : O_RWS) + ((size_t)(b * 16 + h) * 64 + lane) * 64 + 8 * w;
    *(f32x4*)so = (f32x4){S[0], S[1], S[2], S[3]}; *(f32x4*)(so + 4) = (f32x4){S[4], S[5], S[6], S[7]};
    float* sh = p.out + (prompt ? O_SHIFTP : O_SHIFTS) + (size_t)b * RWW;
    for (int i = tid; i < 448; i += 512) {
        if (i >= 192 && h != 0) continue;
        int col; if (i < 64) col = h * 64 + i; else if (i < 128) col = 1024 + h * 64 + (i - 64); else if (i < 192) col = 2048 + h * 64 + (i - 128); else col = 3072 + (i - 192);
        sh[col] = sPrev[pb * 448 + i];
    }
    __syncthreads();
}

DI void phase_scan(const Params& p, LAS unsigned char* lds) {
    unsigned* ctr = (unsigned*)(p.ws + WS_CTL);
    LAS int* sItem = (LAS int*)(lds + 131072);
    for (;;) {
        if (threadIdx.x == 0) *sItem = (int)atomicAdd(ctr, 1u);
        __syncthreads();
        const int item = __builtin_amdgcn_readfirstlane(*sItem);
        __syncthreads();
        if (item >= 4352) break;
        if (item < 128) dn_item(p, lds, item >> 4, (item >> 1) & 7, item & 1, true);
        else if (item < 256) { const int j = item - 128; rw_item(p, lds, j >> 4, j & 15, true); }
        else if (item < 2304) { const int j = item - 256; dn_item(p, lds, j >> 4, (j >> 1) & 7, j & 1, false); }
        else { const int j = item - 2304; rw_item(p, lds, j >> 4, j & 15, false); }
    }
}

DI void phase_merge(const Params& p) {
    const bf16_t* QKV = (const bf16_t*)(p.ws + WS_QKV); const bf16_t* RW = (const bf16_t*)(p.ws + WS_RW);
    bf16_t* MIX = (bf16_t*)((unsigned char*)p.out + DO_H);
    const int gt = blockIdx.x * 512 + otid(), NT = gridDim.x * 512;
    for (int u = gt; u < M * 128; u += NT) {
        const int row = u >> 7, c = (u & 127) * 8;
        float o[8], z[8], ga[8], gb[8], orw[8], gate[8];
        load8bf(QKV + (size_t)row * QKVW + 2048 + c, o); load8bf(QKV + (size_t)row * QKVW + c, z); load8bf(QKV + (size_t)row * QKVW + 1024 + c, ga);
        load8bf(RW + (size_t)row * RWW + c, gb); load8bf(RW + (size_t)row * RWW + 2048 + c, orw); load8bf(RW + (size_t)row * RWW + 1024 + c, gate);
        float ss = 0.f;
#pragma unroll
        for (int e = 0; e < 8; ++e) ss += o[e] * o[e];
        ss += __shfl_xor(ss, 1); ss += __shfl_xor(ss, 2); ss += __shfl_xor(ss, 4); ss += __shfl_xor(ss, 8);
        const float rs = 1.f / sqrtf(ss * (1.f / 128.f) + 1e-6f);
        float mix[8];
#pragma unroll
        for (int e = 0; e < 8; ++e) { const float odn = o[e] * rs * p.in[12][(c & 127) + e] * siluf_(z[e]); mix[e] = sigmoidf_(ga[e]) * odn + sigmoidf_(gb[e]) * (orw[e] * gate[e]); }
        *(u32x4*)(MIX + (size_t)row * D + c) = pack8(mix);
    }
}
DI void phase_norm2(const Params& p) {
    const int tid_ = otid(); const int lane = tid_ & 63, gw = blockIdx.x * 8 + (tid_ >> 6), NGW = gridDim.x * 8;
    const float* X1 = (const float*)(p.ws + WS_X1); bf16_t* H = (bf16_t*)((unsigned char*)p.out + DO_H);
    for (int m = gw; m < M; m += NGW) { f32x4 v[4]; rms_row(X1 + (size_t)m * D, p.in[25], H + (size_t)m * D, lane, v); }
}
DI void phase_final(const Params& p) {
    const int tid_ = otid(); const int lane = tid_ & 63, gw = blockIdx.x * 8 + (tid_ >> 6), NGW = gridDim.x * 8;
    const float* X1 = (const float*)(p.ws + WS_X1);
    for (int m = gw; m < M; m += NGW) {
        float* orow;
        if (m < MPR) { const int b = m / TP, t = m - b * TP; if (t < 16) continue; orow = p.out + O_YP + ((size_t)b * 2048 + (t - 16)) * D; }
        else orow = p.out + O_YS + (size_t)(m - MPR) * D;
        f32x4 v[4]; rms_row(X1 + (size_t)m * D, p.in[28], nullptr, lane, v);
#pragma unroll
        for (int j = 0; j < 4; ++j) *(f32x4*)(orow + 4 * lane + 256 * j) = v[j];
    }
}


DI void grid_bar(unsigned* ctr, unsigned target) {
    asm volatile("s_waitcnt vmcnt(0)" ::: "memory");
    __syncthreads();
    if (threadIdx.x == 0) {
        __builtin_amdgcn_fence(__ATOMIC_RELEASE, "agent");
        asm volatile("s_waitcnt vmcnt(0)" ::: "memory");
        __hip_atomic_fetch_add(ctr, 1u, __ATOMIC_RELAXED, __HIP_MEMORY_SCOPE_AGENT);
        while (__hip_atomic_load(ctr, __ATOMIC_RELAXED, __HIP_MEMORY_SCOPE_AGENT) < target) __builtin_amdgcn_s_sleep(2);
        __builtin_amdgcn_fence(__ATOMIC_ACQUIRE, "agent");
        asm volatile("s_waitcnt vmcnt(0)" ::: "memory");
    }
    __syncthreads();
}
__global__ void __launch_bounds__(512, 2) fwd_megakernel(Params p) {
    extern __shared__ __attribute__((aligned(16))) unsigned char lds_raw[];
    LAS unsigned char* lds = (LAS unsigned char*)lds_raw;
    cg::grid_group grid = cg::this_grid();
    const int G = gridDim.x, c = blockIdx.x;
    bf16_t* H = (bf16_t*)((unsigned char*)p.out + DO_H);
    bf16_t* WIN = (bf16_t*)((unsigned char*)p.out + DO_WIN);
    bf16_t* QKV = (bf16_t*)(p.ws + WS_QKV); bf16_t* RW = (bf16_t*)(p.ws + WS_RW);
    float* X1 = (float*)(p.ws + WS_X1); bf16_t* ACT = (bf16_t*)(p.ws + WS_ACT);

    unsigned* gctr = (unsigned*)(p.ws + WS_CTL) + 64;
    grid.sync();
    phase0(p, lds);
    grid_bar(gctr, 1u * (unsigned)G);
    {
        pg8::Gemm g{H, D, WIN, MP, N1A, D}; pg8::StaticOrder S; S.init(MP, N1A, G, c);
        pg8::EpiSeg<0> E{QKV, QKVW, 3072, RW, RWW};
        pg8::gemm_phase<1024, 1024>(lds, g, S, E);
    }
    grid_bar(gctr, 2u * (unsigned)G);
    phase_scan(p, lds);
    grid_bar(gctr, 3u * (unsigned)G);
    {
        pg8::Gemm g{H, D, WIN + (size_t)N1A * D, MP, N1B, D}; pg8::StaticOrder S; S.init(MP, N1B, G, c);
        pg8::EpiSeg<0> E{QKV, QKVW, 2048, RW, RWW};
        pg8::gemm_phase<1024, 1024>(lds, g, S, E);
        pg8::Gemm g2{RW + 3200, RWW, (const bf16_t*)(p.ws + WS_WG2), MP, 1024, 128}; pg8::StaticOrder S2; S2.init(MP, 1024, G, c);
        pg8::EpiSeg<0> E2{RW + 1024, RWW, 1 << 30, RW, RWW};
        pg8::gemm_phase<128, 3328>(lds, g2, S2, E2);
    }
    grid_bar(gctr, 4u * (unsigned)G);
    phase_merge(p);
    grid_bar(gctr, 5u * (unsigned)G);
    {
        pg8::Gemm g{H, D, (const bf16_t*)(p.ws + WS_WOUT), MP, D, D}; pg8::StaticOrder S; S.init(MP, D, G, c);
        pg8::EpiRes<0> E{X1, p.in[0], p.in[1], p.in[6]};
        pg8::gemm_phase<1024, 1024>(lds, g, S, E);
    }
    grid_bar(gctr, 6u * (unsigned)G);
    phase_norm2(p);
    grid_bar(gctr, 7u * (unsigned)G);
    {
        pg8::Gemm g{H, D, (const bf16_t*)(p.ws + WS_WFF1), MP, FF, D}; pg8::StaticOrder S; S.init(MP, FF, G, c);
        pg8::EpiSeg<1> E{ACT, FF, 1 << 30, ACT, FF};
        pg8::gemm_phase<1024, 1024>(lds, g, S, E);
    }
    grid_bar(gctr, 8u * (unsigned)G);
    {
        pg8::Gemm g{ACT, FF, (const bf16_t*)(p.ws + WS_WFF2), MP, D, FF}; pg8::StaticOrder S; S.init(MP, D, G, c);
        pg8::EpiRes<1> E{X1, nullptr, nullptr, nullptr};
        pg8::gemm_phase<4096, 4096>(lds, g, S, E);
    }
    grid_bar(gctr, 9u * (unsigned)G);
    phase_final(p);
}

extern "C" void kernel_launch(void* const* d_in, const int* in_sizes, int n_in, void* d_out, int out_size, void* d_ws, size_t ws_size, hipStream_t stream) {
    static int grid = 0;
    if (grid == 0) {
        int dev = 0, cus = 0, per_cu = 0;
        hipGetDevice(&dev);
        hipDeviceGetAttribute(&cus, hipDeviceAttributeMultiprocessorCount, dev);
        if (hipFuncSetAttribute((const void*)fwd_megakernel, hipFuncAttributeMaxDynamicSharedMemorySize, LDS_BYTES) != hipSuccess) fprintf(stderr, "hipFuncSetAttribute failed\n");
        hipOccupancyMaxActiveBlocksPerMultiprocessor(&per_cu, (const void*)fwd_megakernel, 512, LDS_BYTES);
        if (per_cu < 1) { fprintf(stderr, "occupancy query says %d blocks per CU\n", per_cu); per_cu = 1; }
        grid = cus;
        if (n_in != 29 || ws_size < 256 * MiB) fprintf(stderr, "unexpected n_in %d / ws %zu\n", n_in, ws_size);
    }
    hipMemsetAsync((char*)d_ws + WS_CTL, 0, 4096, stream);
    Params p{};
    for (int i = 0; i < 29; ++i) p.in[i] = (const float*)d_in[i];
    p.out = (float*)d_out; p.ws = (unsigned char*)d_ws;
    void* args[] = {&p};
    hipError_t e = hipLaunchCooperativeKernel((const void*)fwd_megakernel, dim3(grid), dim3(512), args, LDS_BYTES, stream);
    if (e != hipSuccess) fprintf(stderr, "cooperative launch failed: %s (grid %d)\n", hipGetErrorString(e), grid);
}
```

```cpp
#include <hip/hip_runtime.h>
#include <hip/hip_cooperative_groups.h>
#include <cstdio>
#include <cstdint>
namespace cg = cooperative_groups;

#define DI __device__ __forceinline__
#define LAS __attribute__((address_space(3)))
typedef unsigned short bf16_t;
typedef short bf16x8 __attribute__((ext_vector_type(8)));
typedef float f32x4 __attribute__((ext_vector_type(4)));
typedef unsigned u32x4 __attribute__((ext_vector_type(4)));

constexpr int D = 1024, TP = 2064, NBP = 8, NBS = 128, TS = 8;
constexpr int MPR = NBP * TP;
constexpr int M = MPR + NBS * TS;
constexpr int MP = 17664;
constexpr int QKVW = 3072, RWW = 3328, PROJW = 9488, FF = 4096;
constexpr int N1A = 6400, N1B = 3072;
constexpr size_t MiB = 1u << 20;
constexpr size_t WS_CTL = 0;
constexpr size_t WS_WOUT = 1 * MiB, WS_WFF1 = 3 * MiB, WS_WFF2 = 11 * MiB, WS_WG2 = 19 * MiB;
constexpr size_t WS_GDN = 19 * MiB + 512 * 1024, WS_BETA = 20 * MiB + 512 * 1024;
constexpr size_t WS_QKV = 22 * MiB, WS_RW = 126 * MiB;
constexpr size_t WS_X1 = WS_QKV, WS_ACT = 92 * MiB;
constexpr size_t DO_H = 0, DO_WIN = 35 * MiB;
constexpr size_t O_YP = 0, O_YS = 16777216, O_CONVP = 17825792, O_DNP = 17899520, O_SHIFTP = 18948096, O_RWP = 18974720,
                 O_CONVS = 19499008, O_DNS = 20678656, O_SHIFTS = 37455872, O_RWS = 37881856;
constexpr int LDS_BYTES = 163840;

struct Params { const float* in[29]; float* out; unsigned char* ws; };

DI unsigned f2bf(float f) { unsigned u = __builtin_bit_cast(unsigned, f); return (u + 0x7fffu + ((u >> 16) & 1u)) >> 16; }
DI unsigned pk2(float lo, float hi) { return f2bf(lo) | (f2bf(hi) << 16); }
DI float bflo(unsigned u) { return __builtin_bit_cast(float, u << 16); }
DI float bfhi(unsigned u) { return __builtin_bit_cast(float, u & 0xffff0000u); }
DI void unpack8(const u32x4 v, float* o) { o[0] = bflo(v.x); o[1] = bfhi(v.x); o[2] = bflo(v.y); o[3] = bfhi(v.y); o[4] = bflo(v.z); o[5] = bfhi(v.z); o[6] = bflo(v.w); o[7] = bfhi(v.w); }
DI u32x4 pack8(const float* o) { u32x4 v; v.x = pk2(o[0], o[1]); v.y = pk2(o[2], o[3]); v.z = pk2(o[4], o[5]); v.w = pk2(o[6], o[7]); return v; }
DI void load8bf(const bf16_t* p, float* o) { unpack8(*(const u32x4*)p, o); }
DI float wave_sum(float v) {
#pragma unroll
    for (int o = 1; o < 64; o <<= 1) v += __shfl_xor(v, o);
    return v;
}
DI float sigmoidf_(float x) { return 1.f / (1.f + __expf(-x)); }
DI float softplusf_(float x) { return fmaxf(x, 0.f) + log1pf(__expf(-fabsf(x))); }
DI float siluf_(float x) { return x * sigmoidf_(x); }
DI int otid() { int t = threadIdx.x; asm volatile("" : "+v"(t)); return t; }
#define LDS_WAIT() asm volatile("s_waitcnt lgkmcnt(0)" ::: "memory")

DI const float* xrow3(const float* xp, const float* xs, const float* xm, int r) {
    if (r < MPR) { const int b = r / TP, t = r - b * TP; return t < 16 ? xm + (size_t)t * D : xp + ((size_t)b * 2048 + (t - 16)) * D; }
    return xs + (size_t)(r - MPR) * D;
}
DI const float* xrow(const Params& p, int r) {
    if (r < MPR) { const int b = r / TP, t = r - b * TP; return t < 16 ? p.in[6] + (size_t)t * D : p.in[0] + ((size_t)b * 2048 + (t - 16)) * D; }
    return p.in[1] + (size_t)(r - MPR) * D;
}

namespace pg8 {
constexpr int BM = 256, BK = 64, HALF = 128, HTB = HALF * BK * 2, STAGE_BYTES = 8 * HTB, NXCD = 8, WGM = 8;
DI int lds_byte(int r, int c) { const int st = (r >> 4) * 2 + (c >> 5), rr = r & 15, cc = c & 31, ob = rr * 64 + cc * 2; return st * 1024 + (ob ^ (((ob >> 9) & 1) << 5)); }
DI void stage_rc(int b, int& R, int& C) { const int st = b / 1024, sb = b % 1024, swz = sb ^ (((sb >> 9) & 1) << 5); R = (st >> 1) * 16 + swz / 64; C = (st & 1) * 32 + (swz % 64) / 2; }
DI int perm32(int rho) { const int n = rho >> 4, i = rho & 15; return 8 * (i >> 2) + 4 * n + (i & 3); }
struct Unit { int pm, pn; };
struct Gemm { const bf16_t* A; int lda; const bf16_t* Bt; int M, N, K; };
struct StaticOrder {
    int nM, nN, nwg, G, c;
    DI void init(int M_, int N_, int G_, int c_) { nM = M_ / BM; nN = N_ / BM; nwg = nM * nN; G = G_; c = c_; }
    DI bool next(int i, Unit& u) const {
        const long L = (long)i * G + c; if (L >= nwg) return false;
        int wgid = (int)L; { const int q = nwg / NXCD, r = nwg % NXCD, xcd = wgid % NXCD, off = wgid / NXCD; wgid = (xcd < r ? xcd * (q + 1) : r * (q + 1) + (xcd - r) * q) + off; }
        const int nig = WGM * nN, gid = wgid / nig, fm = gid * WGM, gsz = (nM - fm) < WGM ? (nM - fm) : WGM;
        u.pm = fm + ((wgid % nig) % gsz); u.pn = (wgid % nig) / gsz; return true;
    }
};
DI unsigned cvt_pk_bf16(float lo, float hi) { unsigned r; asm volatile("v_cvt_pk_bf16_f32 %0, %1, %2" : "=v"(r) : "v"(lo), "v"(hi)); return r; }

template <int ACT> struct EpiSeg {
    bf16_t* d0; int ld0; int split; bf16_t* d1; int ld1;
    DI void operator()(const f32x4 (&acc)[2][2][4][2], const Unit& u, int wr, int wc, int fr, int fq) const {
        const int row0 = u.pm * BM + wr * 64 + fr; int colt = u.pn * BM; bf16_t* base = d0; int ld = ld0;
        if (colt >= split) { base = d1; ld = ld1; colt -= split; }
        const int col0 = colt + wc * 32 + 8 * fq;
#pragma unroll
        for (int ai = 0; ai < 2; ++ai)
#pragma unroll
            for (int m = 0; m < 4; ++m) { bf16_t* rowp = base + (size_t)(row0 + ai * HALF + m * 16) * ld + col0;
#pragma unroll
                for (int bj = 0; bj < 2; ++bj) { f32x4 v0 = acc[ai][bj][m][0], v1 = acc[ai][bj][m][1];
                    if (ACT == 1) {
#pragma unroll
                        for (int e = 0; e < 4; ++e) { float a = fmaxf(v0[e], 0.f), b = fmaxf(v1[e], 0.f); v0[e] = a * a; v1[e] = b * b; } }
                    u32x4 w; w.x = cvt_pk_bf16(v0[0], v0[1]); w.y = cvt_pk_bf16(v0[2], v0[3]); w.z = cvt_pk_bf16(v1[0], v1[1]); w.w = cvt_pk_bf16(v1[2], v1[3]);
                    *(u32x4*)(rowp + bj * HALF) = w; } }
    }
};
template <int MODE> struct EpiRes {
    float* X1; const float* xp; const float* xs; const float* xm;
    DI void operator()(const f32x4 (&acc)[2][2][4][2], const Unit& u, int wr, int wc, int fr, int fq) const {
        const int row0 = u.pm * BM + wr * 64 + fr; const int col0 = u.pn * BM + wc * 32 + 8 * fq;
#pragma unroll
        for (int ai = 0; ai < 2; ++ai)
#pragma unroll
            for (int m = 0; m < 4; ++m) { const int row = row0 + ai * HALF + m * 16; float* op = X1 + (size_t)row * D + col0;
                const float* bp = (MODE == 1) ? op : (row < M ? xrow3(xp, xs, xm, row) + col0 : nullptr);
#pragma unroll
                for (int bj = 0; bj < 2; ++bj) { f32x4 b0 = (f32x4){0.f, 0.f, 0.f, 0.f}, b1 = b0;
                    if (bp) { b0 = *(const f32x4*)(bp + bj * HALF); b1 = *(const f32x4*)(bp + bj * HALF + 4); }
                    *(f32x4*)(op + bj * HALF) = acc[ai][bj][m][0] + b0; *(f32x4*)(op + bj * HALF + 4) = acc[ai][bj][m][1] + b1; } }
    }
};

template <int K, int lda, class Epi>
DI void gemm_phase(LAS unsigned char* lds, const Gemm g, const StaticOrder& S, const Epi& E) {
    const int tid = otid(), wid = __builtin_amdgcn_readfirstlane(tid >> 6), lane = tid & 63, wr = wid >> 2, wc = wid & 3, fr = lane & 15, fq = lane >> 4;
    constexpr int nt = K / BK;
    unsigned voffA[2], voffB[2];
#pragma unroll
    for (int i = 0; i < 2; ++i) { int R, C; stage_rc(tid * 16 + i * 8192, R, C); const int Rb = (R & ~31) + perm32(R & 31);
        voffA[i] = (unsigned)(R * lda + C) * 2u; voffB[i] = (unsigned)(Rb * K + C) * 2u; }
    const size_t kstep = (size_t)(BK * 2);
    const size_t hA = (size_t)HALF * lda * 2, hB = (size_t)HALF * K * 2;
    const size_t tA = 2 * hA, tB = 2 * hB;
    const unsigned ldsw = (unsigned)wid * 1024u;
    const int aoff = lds_byte(wr * 64 + fr, fq * 8), boff = lds_byte(wc * 32 + fr, fq * 8);
#define PG8_SA(b, h) (((b) * 2 + (h)) * HTB)
#define PG8_SB(b, h) ((4 + (b) * 2 + (h)) * HTB)
#define PG8_STAGE(bufoff, gbase, voff) do { _Pragma("unroll") for (int _i = 0; _i < 2; ++_i) \
        __builtin_amdgcn_global_load_lds((const unsigned*)((const char*)(gbase) + (voff)[_i]), (LAS unsigned*)(lds + (bufoff) + ldsw + _i * 8192), 16, 0, 0); } while (0)
#define PG8_LDA(dst, b, h) do { _Pragma("unroll") for (int m = 0; m < 4; ++m) _Pragma("unroll") for (int k = 0; k < 2; ++k) dst[m][k] = *(const LAS bf16x8*)(lds + PG8_SA(b, h) + aoff + m * 2048 + k * 1024); } while (0)
#define PG8_LDB(dst, b, h) do { _Pragma("unroll") for (int n = 0; n < 2; ++n) _Pragma("unroll") for (int k = 0; k < 2; ++k) dst[n][k] = *(const LAS bf16x8*)(lds + PG8_SB(b, h) + boff + n * 2048 + k * 1024); } while (0)
#define PG8_MMA(ai, bj, At, Bt) do { __builtin_amdgcn_s_setprio(1); _Pragma("unroll") for (int m = 0; m < 4; ++m) _Pragma("unroll") for (int n = 0; n < 2; ++n) _Pragma("unroll") for (int k = 0; k < 2; ++k) \
        acc[ai][bj][m][n] = __builtin_amdgcn_mfma_f32_16x16x32_bf16(Bt[n][k], At[m][k], acc[ai][bj][m][n], 0, 0, 0); __builtin_amdgcn_s_setprio(0); } while (0)
#define PG8_WAIT_V(n) asm volatile("s_waitcnt vmcnt(" #n ")" ::: "memory")
#define PG8_WAIT_L(n) asm volatile("s_waitcnt lgkmcnt(" #n ")" ::: "memory")
#define PG8_BAR __builtin_amdgcn_s_barrier()
#define PG8_SCHED __builtin_amdgcn_sched_barrier(0)
    Unit cur, nxt; int ui = 0;
    if (!S.next(0, cur)) return;
    f32x4 acc[2][2][4][2];
#pragma unroll
    for (int a = 0; a < 2; ++a)
#pragma unroll
        for (int b = 0; b < 2; ++b)
#pragma unroll
            for (int m = 0; m < 4; ++m)
#pragma unroll
                for (int n = 0; n < 2; ++n) acc[a][b][m][n] = (f32x4){0.f, 0.f, 0.f, 0.f};
    bf16x8 At[4][2], B0[2][2], B1[2][2];
    const char* cA = (const char*)g.A + (size_t)cur.pm * tA; const char* cB = (const char*)g.Bt + (size_t)cur.pn * tB;
    PG8_STAGE(PG8_SB(0, 0), cB, voffB); PG8_STAGE(PG8_SA(0, 0), cA, voffA); PG8_STAGE(PG8_SB(0, 1), cB + hB, voffB); PG8_STAGE(PG8_SA(0, 1), cA + hA, voffA);
    if (wr == 1) PG8_BAR;
    PG8_WAIT_V(4); PG8_BAR;
    PG8_STAGE(PG8_SB(1, 0), cB + kstep, voffB); PG8_STAGE(PG8_SA(1, 0), cA + kstep, voffA); PG8_STAGE(PG8_SB(1, 1), cB + hB + kstep, voffB);
    PG8_WAIT_V(6); PG8_BAR;
    for (;;) {
        const bool has_next = S.next(ui + 1, nxt);
        const char* nA = has_next ? (const char*)g.A + (size_t)nxt.pm * tA : cA; const char* nB = has_next ? (const char*)g.Bt + (size_t)nxt.pn * tB : cB;
        for (int t = 0; t < nt; t += 2) {
            const bool last = (t == nt - 2);
            const char* a1 = cA + (size_t)(t + 1) * kstep;
            const char* a2 = last ? nA : cA + (size_t)(t + 2) * kstep; const char* b2 = last ? nB : cB + (size_t)(t + 2) * kstep;
            const char* a3 = a2 + kstep; const char* b3 = b2 + kstep;
            PG8_LDB(B0, 0, 0); PG8_SCHED; PG8_LDA(At, 0, 0); PG8_STAGE(PG8_SA(1, 1), a1 + hA, voffA);
            PG8_WAIT_L(8); PG8_BAR; PG8_WAIT_L(0); PG8_MMA(0, 0, At, B0); PG8_BAR; PG8_SCHED;
            PG8_LDB(B1, 0, 1); PG8_STAGE(PG8_SB(0, 0), b2, voffB);
            PG8_BAR; PG8_WAIT_L(0); PG8_MMA(0, 1, At, B1); PG8_BAR;
            PG8_LDA(At, 0, 1); PG8_STAGE(PG8_SA(0, 0), a2, voffA);
            PG8_BAR; PG8_WAIT_L(0); PG8_MMA(1, 0, At, B0); PG8_BAR; PG8_SCHED;
            PG8_STAGE(PG8_SB(0, 1), b2 + hB, voffB);
            PG8_WAIT_V(6); PG8_BAR; PG8_MMA(1, 1, At, B1); PG8_BAR;
            PG8_LDB(B0, 1, 0); PG8_SCHED; PG8_LDA(At, 1, 0); PG8_STAGE(PG8_SA(0, 1), a2 + hA, voffA);
            PG8_WAIT_L(8); PG8_BAR; PG8_WAIT_L(0); PG8_MMA(0, 0, At, B0); PG8_BAR; PG8_SCHED;
            PG8_LDB(B1, 1, 1); PG8_STAGE(PG8_SB(1, 0), b3, voffB);
            PG8_BAR; PG8_WAIT_L(0); PG8_MMA(0, 1, At, B1); PG8_BAR;
            PG8_LDA(At, 1, 1); PG8_STAGE(PG8_SA(1, 0), a3, voffA);
            PG8_BAR; PG8_WAIT_L(0); PG8_MMA(1, 0, At, B0); PG8_BAR; PG8_SCHED;
            PG8_STAGE(PG8_SB(1, 1), b3 + hB, voffB);
            PG8_WAIT_V(6); PG8_BAR; PG8_MMA(1, 1, At, B1); PG8_BAR;
        }
        E(acc, cur, wr, wc, fr, fq);
        if (!has_next) break;
#pragma unroll
        for (int a = 0; a < 2; ++a)
#pragma unroll
            for (int b = 0; b < 2; ++b)
#pragma unroll
                for (int m = 0; m < 4; ++m)
#pragma unroll
                    for (int n = 0; n < 2; ++n) acc[a][b][m][n] = (f32x4){0.f, 0.f, 0.f, 0.f};
        cur = nxt; cA = nA; cB = nB; ++ui;
    }
    PG8_WAIT_V(0);
    if (wr == 0) PG8_BAR;
    PG8_BAR;
#undef PG8_SA
#undef PG8_SB
#undef PG8_STAGE
#undef PG8_LDA
#undef PG8_LDB
#undef PG8_MMA
#undef PG8_WAIT_V
#undef PG8_WAIT_L
#undef PG8_BAR
#undef PG8_SCHED
}
}

DI void transpose_item(const float* W, int ldw, int nblk, bf16_t* WT, int K, int row_off, LAS float* scr, int item, int lane) {
    const int kb = item / nblk, nb = item - kb * nblk, k0 = 64 * kb, n0 = 32 * nb;
#pragma unroll 8
    for (int i = 0; i < 32; ++i) { const int kk = 2 * i + (lane >> 5); scr[kk * 33 + (lane & 31)] = W[(size_t)(k0 + kk) * ldw + n0 + (lane & 31)]; }
    LDS_WAIT();
    const int c = lane & 7;
#pragma unroll
    for (int j = 0; j < 4; ++j) { const int n = (lane >> 3) + 8 * j; const LAS float* s = scr + (8 * c) * 33 + n;
        u32x4 o; o.x = pk2(s[0 * 33], s[1 * 33]); o.y = pk2(s[2 * 33], s[3 * 33]); o.z = pk2(s[4 * 33], s[5 * 33]); o.w = pk2(s[6 * 33], s[7 * 33]);
        *(u32x4*)(WT + (size_t)(row_off + n0 + n) * K + k0 + 8 * c) = o; }
    LDS_WAIT();
}

DI void rms_row(const float* xr, const float* g, bf16_t* orow, int lane, f32x4 (&v)[4]) {
    float s = 0.f;
#pragma unroll
    for (int j = 0; j < 4; ++j) { v[j] = *(const f32x4*)(xr + 4 * lane + 256 * j); s += (v[j].x * v[j].x + v[j].y * v[j].y) + (v[j].z * v[j].z + v[j].w * v[j].w); }
    const float rstd = 1.f / sqrtf(wave_sum(s) * (1.f / D) + 1e-6f);
#pragma unroll
    for (int j = 0; j < 4; ++j) { const f32x4 gg = *(const f32x4*)(g + 4 * lane + 256 * j); v[j] = v[j] * rstd * gg;
        if (orow) { unsigned long long o = (unsigned long long)pk2(v[j].x, v[j].y) | ((unsigned long long)pk2(v[j].z, v[j].w) << 32); *(unsigned long long*)(orow + 4 * lane + 256 * j) = o; } }
}

DI void phase0(const Params& p, LAS unsigned char* lds) {
    const int tid = otid(), lane = tid & 63, wave = __builtin_amdgcn_readfirstlane(tid >> 6);
    LAS float* scr = (LAS float*)(lds + wave * 16384);
    const int gw = blockIdx.x * 8 + wave, NGW = gridDim.x * 8;
    bf16_t* WIN = (bf16_t*)((unsigned char*)p.out + DO_WIN);
    bf16_t* WOUT = (bf16_t*)(p.ws + WS_WOUT); bf16_t* WF1 = (bf16_t*)(p.ws + WS_WFF1); bf16_t* WF2 = (bf16_t*)(p.ws + WS_WFF2); bf16_t* WG2 = (bf16_t*)(p.ws + WS_WG2);
    const float* w_in = p.in[8];
    constexpr int I0 = 16 * 96, I1 = 16 * 104, I2 = 16 * 32, I3 = 16 * 64, I4 = 16 * 32, I5 = 16 * 128, I6 = 64 * 32, I7 = 2 * 32;
    constexpr int NIT = I0 + I1 + I2 + I3 + I4 + I5 + I6 + I7;
    for (int it = gw; it < NIT; it += NGW) {
        int r = it;
        if (r < I0) { transpose_item(w_in, PROJW, 96, WIN, 1024, 0, scr, r, lane); continue; } r -= I0;
        if (r < I1) { transpose_item(w_in + 4112, PROJW, 104, WIN, 1024, 3072, scr, r, lane); continue; } r -= I1;
        if (r < I2) { transpose_item(w_in + 3072, PROJW, 32, WIN, 1024, 6400, scr, r, lane); continue; } r -= I2;
        if (r < I3) { transpose_item(w_in + 7440, PROJW, 64, WIN, 1024, 7424, scr, r, lane); continue; } r -= I3;
        if (r < I4) { transpose_item(p.in[24], 1024, 32, WOUT, 1024, 0, scr, r, lane); continue; } r -= I4;
        if (r < I5) { transpose_item(p.in[26], 4096, 128, WF1, 1024, 0, scr, r, lane); continue; } r -= I5;
        if (r < I6) { transpose_item(p.in[27], 1024, 32, WF2, 4096, 0, scr, r, lane); continue; } r -= I6;
        transpose_item(p.in[18], 1024, 32, WG2, 128, 0, scr, r, lane);
    }
    bf16_t* H = (bf16_t*)((unsigned char*)p.out + DO_H);
    float* GDN = (float*)(p.ws + WS_GDN); float* BETA = (float*)(p.ws + WS_BETA);
    __syncthreads();
    LAS float* sWab = (LAS float*)lds;
    for (int idx = tid; idx < 16384; idx += 512) { const int k = idx >> 4, i = idx & 15; sWab[i * 1028 + k] = w_in[(size_t)k * PROJW + 4096 + i]; }
    __syncthreads();
    for (int m = gw; m < MP; m += NGW) {
        bf16_t* hr = H + (size_t)m * D;
        if (m >= M) {
#pragma unroll
            for (int j = 0; j < 4; ++j) *(unsigned long long*)(hr + 4 * lane + 256 * j) = 0ull;
            continue;
        }
        f32x4 v[4];
        rms_row(xrow(p, m), p.in[7], hr, lane, v);
        float s[16];
#pragma unroll
        for (int i = 0; i < 16; ++i) { float a = 0.f;
#pragma unroll
            for (int j = 0; j < 4; ++j) { const f32x4 w4 = *(const LAS f32x4*)(sWab + i * 1028 + 256 * j + 4 * lane); a += v[j].x * w4.x + v[j].y * w4.y + v[j].z * w4.z + v[j].w * w4.w; }
            s[i] = a; }
        float mine = 0.f;
#pragma unroll
        for (int i = 0; i < 16; ++i) { const float t = wave_sum(s[i]); if (lane == i) mine = t; }
        if (lane < 8) GDN[(size_t)m * 8 + lane] = -__expf(p.in[10][lane]) * softplusf_(mine + p.in[11][lane]);
        else if (lane < 16) BETA[(size_t)m * 8 + lane - 8] = sigmoidf_(mine);
    }
}

typedef float f32x16 __attribute__((ext_vector_type(16)));
typedef unsigned u32x2 __attribute__((ext_vector_type(2)));
DI int crow(int reg, int hh) { return (reg & 3) + 8 * (reg >> 2) + 4 * hh; }
template <int KS> DI void mma32(f32x16& acc, const LAS bf16_t* A, int lda, const LAS bf16_t* Bt, int ldb, int lane) {
    const int r = lane & 31, hh = lane >> 5;
    const LAS bf16_t* pa = A + r * lda + 8 * hh; const LAS bf16_t* pb = Bt + r * ldb + 8 * hh;
#pragma unroll
    for (int ks = 0; ks < KS; ++ks) { const bf16x8 a = *(const LAS bf16x8*)(pa + 16 * ks); const bf16x8 b = *(const LAS bf16x8*)(pb + 16 * ks);
        acc = __builtin_amdgcn_mfma_f32_32x32x16_bf16(a, b, acc, 0, 0, 0); }
}
template <int s> DI void tri_level(LAS float* sA, LAS float* sX, LAS float* sM, int tid) {
    constexpr int NP = 32 / s, NOUT = NP * s * s, PER = (NOUT + 511) / 512, MS = s + 4;
    float res[PER];
#pragma unroll
    for (int u = 0; u < PER; ++u) { const int o = tid + 512 * u; res[u] = 0.f;
        if (o < NOUT) { const int pp = o / (s * s), r = (o / s) % s, c = o % s; const int R0 = 2 * s * pp + s, C0 = 2 * s * pp;
            const LAS float* ar = sA + (R0 + r) * 68 + C0; const LAS float* xc = sX + C0 * 68 + C0 + c; float acc = 0.f;
#pragma unroll
            for (int k4 = 0; k4 < s / 4; ++k4) { const f32x4 a = *(const LAS f32x4*)(ar + 4 * k4);
                acc += a.x * xc[(4 * k4) * 68] + a.y * xc[(4 * k4 + 1) * 68] + a.z * xc[(4 * k4 + 2) * 68] + a.w * xc[(4 * k4 + 3) * 68]; }
            sM[pp * (s * MS) + r * MS + c] = acc; } }
    __syncthreads();
#pragma unroll
    for (int u = 0; u < PER; ++u) { const int o = tid + 512 * u;
        if (o < NOUT) { const int pp = o / (s * s), r = (o / s) % s, c = o % s; const int R0 = 2 * s * pp + s, C0 = 2 * s * pp;
            const LAS float* xr = sX + (R0 + r) * 68 + R0; const LAS float* mc = sM + pp * (s * MS) + c; float acc = 0.f;
#pragma unroll
            for (int k4 = 0; k4 < s / 4; ++k4) { const f32x4 a = *(const LAS f32x4*)(xr + 4 * k4);
                acc += a.x * mc[(4 * k4) * MS] + a.y * mc[(4 * k4 + 1) * MS] + a.z * mc[(4 * k4 + 2) * MS] + a.w * mc[(4 * k4 + 3) * MS]; }
            sX[(R0 + r) * 68 + C0 + c] = -acc; } }
    __syncthreads();
}
DI void tri_inverse(LAS float* sA, LAS float* sX, LAS float* sM, LAS bf16_t* sTi, int tid, int C) {
    for (int i = tid; i < 64 * 17; i += 512) ((LAS f32x4*)sX)[i] = (f32x4){0.f, 0.f, 0.f, 0.f};
    __syncthreads();
    if (tid < 64) { const int blk = tid >> 3, c = tid & 7; const LAS float* ab = sA + (8 * blk) * 68 + 8 * blk; float x[8];
        f32x4 a0[8], a1[8];
#pragma unroll
        for (int r = 1; r < 8; ++r) { a0[r] = *(const LAS f32x4*)(ab + r * 68); a1[r] = *(const LAS f32x4*)(ab + r * 68 + 4); }
#pragma unroll
        for (int r = 0; r < 8; ++r) { float sacc = (r == c) ? 1.f : 0.f;
#pragma unroll
            for (int m = 0; m < r; ++m) sacc -= ((m < 4) ? a0[r][m & 3] : a1[r][m & 3]) * x[m];
            x[r] = sacc; }
#pragma unroll
        for (int r = 0; r < 8; ++r) sX[(8 * blk + r) * 68 + 8 * blk + c] = x[r];
    }
    __syncthreads();
    if (C > 8) tri_level<8>(sA, sX, sM, tid);
    if (C > 16) tri_level<16>(sA, sX, sM, tid);
    if (C > 32) tri_level<32>(sA, sX, sM, tid);
    for (int idx = tid; idx < 64 * 32; idx += 512) { const int i = idx >> 5, j2 = (idx & 31) * 2; *(LAS unsigned*)(sTi + i * 72 + j2) = pk2(sX[i * 68 + j2], sX[i * 68 + j2 + 1]); }
    __syncthreads();
}

DI void dn_item(const Params& p, LAS unsigned char* lds, int b, int h, int dvh, bool prompt) {
    const int tid0 = otid(), w = __builtin_amdgcn_readfirstlane(tid0 >> 6);
    LAS bf16_t* sQ = (LAS bf16_t*)(lds);
    LAS bf16_t* sK = (LAS bf16_t*)(lds + 17408);
    LAS bf16_t* sKT = (LAS bf16_t*)(lds + 34816);
    LAS bf16_t* sV = (LAS bf16_t*)(lds + 53248);
    LAS bf16_t* sST = (LAS bf16_t*)(lds + 62464);
    LAS float* sA = (LAS float*)(lds + 79872);
    LAS bf16_t* sRT = (LAS bf16_t*)(lds + 79872);
    LAS bf16_t* sUT = (LAS bf16_t*)(lds + 79872 + 9216);
    LAS bf16_t* sUdT = (LAS bf16_t*)(lds + 79872 + 18432);
    LAS float* sX = (LAS float*)(lds + 97280);
    LAS float* sM = (LAS float*)(lds + 114688);
    LAS bf16_t* sTi = (LAS bf16_t*)(lds + 119296);
    LAS bf16_t* sAqk = (LAS bf16_t*)(lds + 128512);
    LAS float* sHalo = (LAS float*)(lds + 137728);
    LAS float* sG = (LAS float*)(lds + 145408);
    LAS float* sBeta = (LAS float*)(lds + 145664);
    const int T = prompt ? TP : TS, row0 = prompt ? b * TP : MPR + b * TS;
    const bf16_t* QKV = (const bf16_t*)(p.ws + WS_QKV);
    bf16_t* QKVo = (bf16_t*)(p.ws + WS_QKV);
    const float* GDN = (const float*)(p.ws + WS_GDN); const float* BETA = (const float*)(p.ws + WS_BETA);
    const int aS = w >> 1, tjS = w & 1;
    f32x16 accS;
    {
        const int lane = tid0 & 63, hh = lane >> 5;
        const float* st = p.in[3] + ((size_t)(b * 8 + h) * 128) * 128 + dvh * 64 + 32 * tjS + (lane & 31);
#pragma unroll
        for (int reg = 0; reg < 16; ++reg) accS[reg] = prompt ? 0.f : st[(size_t)(32 * aS + crow(reg, hh)) * 128];
#pragma unroll
        for (int g4 = 0; g4 < 4; ++g4) { u32x2 v; v.x = pk2(accS[4 * g4], accS[4 * g4 + 1]); v.y = pk2(accS[4 * g4 + 2], accS[4 * g4 + 3]);
            *(LAS u32x2*)(sST + (32 * tjS + (lane & 31)) * 136 + 32 * aS + 8 * g4 + 4 * hh) = v; }
    }
    const int run = w;
    for (int idx = tid0; idx < 960; idx += 512) {
        const int j = idx / 320, c = idx - j * 320; const int cgi = c >> 3, e = c & 7;
        int chh; if (cgi < 16) chh = h * 128 + cgi * 8; else if (cgi < 32) chh = 1024 + h * 128 + (cgi - 16) * 8; else chh = 2048 + h * 128 + dvh * 64 + (cgi - 32) * 8;
        sHalo[idx] = prompt ? 0.f : p.in[2][((size_t)b * 3 + j) * QKVW + chh + e];
    }
    __syncthreads();
    int hb = 0;
    const float* cw = p.in[9];
    for (int t0 = 0; t0 < T; t0 += 64) {
        const int C = (T - t0) < 64 ? (T - t0) : 64;
        const int tid = otid(), lane = tid & 63, hh = lane >> 5, cg_ = lane;
        const bool act = cg_ < 40;
        int ch = 0;
        if (cg_ < 16) ch = h * 128 + cg_ * 8; else if (cg_ < 32) ch = 1024 + h * 128 + (cg_ - 16) * 8; else ch = 2048 + h * 128 + dvh * 64 + (cg_ - 32) * 8;
        if (w == 0) { float g = 0.f, be = 0.f; if (lane < C) { g = GDN[(size_t)(row0 + t0 + lane) * 8 + h]; be = BETA[(size_t)(row0 + t0 + lane) * 8 + h]; }
#pragma unroll
            for (int o = 1; o < 64; o <<= 1) { const float v = __shfl_up(g, o); if (lane >= o) g += v; }
            sG[lane] = g; sBeta[lane] = be; }
        float val[8][8];
        const bool mine = act && (run * 8 < C);
        if (mine) {
            float cwv[4][8];
#pragma unroll
            for (int j = 0; j < 4; ++j) { const f32x4 a = *(const f32x4*)(cw + j * QKVW + ch), bq = *(const f32x4*)(cw + j * QKVW + ch + 4);
                cwv[j][0] = a.x; cwv[j][1] = a.y; cwv[j][2] = a.z; cwv[j][3] = a.w; cwv[j][4] = bq.x; cwv[j][5] = bq.y; cwv[j][6] = bq.z; cwv[j][7] = bq.w; }
            float r0[8], r1[8], r2[8], r3[8];
            if (run == 0) {
#pragma unroll
                for (int e = 0; e < 8; ++e) { r0[e] = sHalo[hb * 960 + 0 * 320 + cg_ * 8 + e]; r1[e] = sHalo[hb * 960 + 320 + cg_ * 8 + e]; r2[e] = sHalo[hb * 960 + 640 + cg_ * 8 + e]; }
            } else {
                const bf16_t* bp = QKV + (size_t)(row0 + t0 + run * 8 - 3) * QKVW + ch;
                load8bf(bp, r0); load8bf(bp + QKVW, r1); load8bf(bp + 2 * QKVW, r2);
            }
            const bf16_t* bp = QKV + (size_t)(row0 + t0 + run * 8) * QKVW + ch;
#pragma unroll
            for (int tt = 0; tt < 8; ++tt) {
                load8bf(bp + (size_t)tt * QKVW, r3);
#pragma unroll
                for (int e = 0; e < 8; ++e) { const float x = cwv[0][e] * r0[e] + cwv[1][e] * r1[e] + cwv[2][e] * r2[e] + cwv[3][e] * r3[e]; val[tt][e] = siluf_(x); }
#pragma unroll
                for (int e = 0; e < 8; ++e) { r0[e] = r1[e]; r1[e] = r2[e]; r2[e] = r3[e]; }
            }
            if (run * 8 + 8 == C) {
#pragma unroll
                for (int e = 0; e < 8; ++e) { sHalo[(hb ^ 1) * 960 + cg_ * 8 + e] = r0[e]; sHalo[(hb ^ 1) * 960 + 320 + cg_ * 8 + e] = r1[e]; sHalo[(hb ^ 1) * 960 + 640 + cg_ * 8 + e] = r2[e]; }
            }
        } else {
#pragma unroll
            for (int tt = 0; tt < 8; ++tt)
#pragma unroll
                for (int e = 0; e < 8; ++e) val[tt][e] = 0.f;
        }
#pragma unroll
        for (int tt = 0; tt < 8; ++tt) {
            float ss = 0.f;
#pragma unroll
            for (int e = 0; e < 8; ++e) ss += val[tt][e] * val[tt][e];
            ss += __shfl_xor(ss, 1); ss += __shfl_xor(ss, 2); ss += __shfl_xor(ss, 4); ss += __shfl_xor(ss, 8);
            float sc = 1.f;
            if (cg_ < 32) { sc = 1.f / sqrtf(ss + 1e-6f); if (cg_ < 16) sc *= 0.08838834764831845f; }
#pragma unroll
            for (int e = 0; e < 8; ++e) val[tt][e] *= sc;
        }
        if (act) {
            if (cg_ < 16) {
#pragma unroll
                for (int tt = 0; tt < 8; ++tt) *(LAS u32x4*)(sQ + (run * 8 + tt) * 136 + cg_ * 8) = pack8(val[tt]);
            } else if (cg_ < 32) {
#pragma unroll
                for (int tt = 0; tt < 8; ++tt) *(LAS u32x4*)(sK + (run * 8 + tt) * 136 + (cg_ - 16) * 8) = pack8(val[tt]);
#pragma unroll
                for (int e = 0; e < 8; ++e) { float col[8];
#pragma unroll
                    for (int tt = 0; tt < 8; ++tt) col[tt] = val[tt][e];
                    *(LAS u32x4*)(sKT + ((cg_ - 16) * 8 + e) * 72 + run * 8) = pack8(col); }
            } else {
#pragma unroll
                for (int tt = 0; tt < 8; ++tt) *(LAS u32x4*)(sV + (run * 8 + tt) * 72 + (cg_ - 32) * 8) = pack8(val[tt]);
            }
        }
        hb ^= 1;
        __syncthreads();
        {
            const int type = w >> 2, ti = (w >> 1) & 1, tj = w & 1;
            f32x16 acc;
#pragma unroll
            for (int reg = 0; reg < 16; ++reg) acc[reg] = 0.f;
            if (!(ti == 0 && tj == 1)) mma32<8>(acc, (type ? sQ : sK) + 32 * ti * 136, 136, sK + 32 * tj * 136, 136, lane);
            const int j = 32 * tj + (lane & 31); const float Gj = sG[j];
#pragma unroll
            for (int reg = 0; reg < 16; ++reg) { const int i = 32 * ti + crow(reg, hh); const float dec = __expf(fminf(sG[i] - Gj, 0.f));
                if (type == 0) sA[i * 68 + j] = (i > j) ? sBeta[i] * acc[reg] * dec : 0.f;
                else sAqk[i * 72 + j] = (bf16_t)f2bf((i >= j) ? acc[reg] * dec : 0.f); }
        }
        __syncthreads();
        tri_inverse(sA, sX, sM, sTi, tid, C);
        f32x16 accO;
        {
            const int ti = (w >> 1) & 1, tj = w & 1;
            f32x16 acc;
#pragma unroll
            for (int reg = 0; reg < 16; ++reg) acc[reg] = 0.f;
            mma32<8>(acc, ((w < 4) ? sK : sQ) + 32 * ti * 136, 136, sST + 32 * tj * 136, 136, lane);
            const int j = 32 * tj + (lane & 31);
            if (w < 4) {
#pragma unroll
                for (int g4 = 0; g4 < 4; ++g4) { float rr[4];
#pragma unroll
                    for (int e = 0; e < 4; ++e) { const int i = 32 * ti + 8 * g4 + 4 * hh + e; rr[e] = sBeta[i] * (bflo((unsigned)sV[i * 72 + j]) - __expf(sG[i]) * acc[4 * g4 + e]); }
                    u32x2 v; v.x = pk2(rr[0], rr[1]); v.y = pk2(rr[2], rr[3]);
                    *(LAS u32x2*)(sRT + j * 72 + 32 * ti + 8 * g4 + 4 * hh) = v; }
            } else {
#pragma unroll
                for (int reg = 0; reg < 16; ++reg) { const int i = 32 * ti + crow(reg, hh); accO[reg] = __expf(sG[i]) * acc[reg]; }
            }
        }
        __syncthreads();
        if (w < 4) {
            const int ti = (w >> 1) & 1, tj = w & 1;
            f32x16 acc;
#pragma unroll
            for (int reg = 0; reg < 16; ++reg) acc[reg] = 0.f;
            mma32<4>(acc, sTi + 32 * ti * 72, 72, sRT + 32 * tj * 72, 72, lane);
            const int j = 32 * tj + (lane & 31); const float Gl = sG[63];
#pragma unroll
            for (int g4 = 0; g4 < 4; ++g4) { float d[4];
#pragma unroll
                for (int e = 0; e < 4; ++e) { const int i = 32 * ti + 8 * g4 + 4 * hh + e; d[e] = acc[4 * g4 + e] * __expf(Gl - sG[i]); }
                u32x2 v; v.x = pk2(acc[4 * g4], acc[4 * g4 + 1]); v.y = pk2(acc[4 * g4 + 2], acc[4 * g4 + 3]);
                u32x2 vd; vd.x = pk2(d[0], d[1]); vd.y = pk2(d[2], d[3]);
                *(LAS u32x2*)(sUT + j * 72 + 32 * ti + 8 * g4 + 4 * hh) = v;
                *(LAS u32x2*)(sUdT + j * 72 + 32 * ti + 8 * g4 + 4 * hh) = vd; }
        }
        __syncthreads();
        if (w >= 4) {
            const int ti = (w >> 1) & 1, tj = w & 1;
            mma32<4>(accO, sAqk + 32 * ti * 72, 72, sUT + 32 * tj * 72, 72, lane);
            bf16_t* ob = QKVo + (size_t)(row0 + t0) * QKVW + 2048 + h * 128 + dvh * 64 + 32 * tj + (lane & 31);
#pragma unroll
            for (int reg = 0; reg < 16; ++reg) { const int i = 32 * ti + crow(reg, hh); if (i < C) ob[(size_t)i * QKVW] = (bf16_t)f2bf(accO[reg]); }
        }
        {
            const float gl = __expf(sG[63]);
#pragma unroll
            for (int reg = 0; reg < 16; ++reg) accS[reg] *= gl;
            mma32<4>(accS, sKT + 32 * aS * 72, 72, sUdT + 32 * tjS * 72, 72, lane);
#pragma unroll
            for (int g4 = 0; g4 < 4; ++g4) { u32x2 v; v.x = pk2(accS[4 * g4], accS[4 * g4 + 1]); v.y = pk2(accS[4 * g4 + 2], accS[4 * g4 + 3]);
                *(LAS u32x2*)(sST + (32 * tjS + (lane & 31)) * 136 + 32 * aS + 8 * g4 + 4 * hh) = v; }
        }
        __syncthreads();
    }
    {
        const int tid = otid(), lane = tid & 63, hh = lane >> 5;
        float* so = p.out + (prompt ? O_DNP : O_DNS) + ((size_t)(b * 8 + h) * 128) * 128 + dvh * 64 + 32 * tjS + (lane & 31);
#pragma unroll
        for (int reg = 0; reg < 16; ++reg) so[(size_t)(32 * aS + crow(reg, hh)) * 128] = accS[reg];
    }
    float* co = p.out + (prompt ? O_CONVP : O_CONVS) + (size_t)b * 3 * QKVW;
    for (int idx = otid(); idx < 960; idx += 512) {
        const int j = idx / 320, c = idx - j * 320; const int cgi = c >> 3, e = c & 7;
        if (cgi < 32 && dvh != 0) continue;
        int chh; if (cgi < 16) chh = h * 128 + cgi * 8; else if (cgi < 32) chh = 1024 + h * 128 + (cgi - 16) * 8; else chh = 2048 + h * 128 + dvh * 64 + (cgi - 32) * 8;
        co[(size_t)j * QKVW + chh + e] = sHalo[hb * 960 + idx];
    }
    __syncthreads();
}

DI void rw_item(const Params& p, LAS unsigned char* lds, int b, int h, bool prompt) {
    const int tid0 = otid(), w = __builtin_amdgcn_readfirstlane(tid0 >> 6);
    LAS bf16_t* sAt = (LAS bf16_t*)(lds);
    LAS bf16_t* sRt = (LAS bf16_t*)(lds + 9216);
    LAS bf16_t* sKt = (LAS bf16_t*)(lds + 18432);
    LAS bf16_t* sRT = sKt;
    LAS bf16_t* sBt = (LAS bf16_t*)(lds + 27648);
    LAS bf16_t* sYT = sBt;
    LAS bf16_t* sKdT = (LAS bf16_t*)(lds + 36864);
    LAS bf16_t* sNBdT = (LAS bf16_t*)(lds + 46080);
    LAS bf16_t* sVT = (LAS bf16_t*)(lds + 55296);
    LAS bf16_t* sAak = (LAS bf16_t*)(lds + 64512);
    LAS bf16_t* sArk = (LAS bf16_t*)(lds + 73728);
    LAS bf16_t* sNArb = (LAS bf16_t*)(lds + 82944);
    LAS bf16_t* sTi = (LAS bf16_t*)(lds + 92160);
    LAS bf16_t* sST = (LAS bf16_t*)(lds + 101376);
    LAS float* sA = (LAS float*)(lds + 110592);
    LAS float* sO = sA; LAS float* sTW = sA;
    LAS float* sX = (LAS float*)(lds + 128000);
    LAS float* sAL = sX; LAS float* sL = sX;
    LAS float* sM = (LAS float*)(lds + 145408);
    LAS float* sPrev = (LAS float*)(lds + 150016);
    LAS float* sPC = (LAS float*)(lds + 153600);
    LAS float* sBonus = (LAS float*)(lds + 153856);
    const int T = prompt ? TP : TS, row0 = prompt ? b * TP : MPR + b * TS;
    bf16_t* RW = (bf16_t*)(p.ws + WS_RW);
    const float* mu = p.in[13];
    const int aS = (w >> 1) & 1, tjS = w & 1;
    f32x16 accH;
    {
        const int lane = tid0 & 63, hh = lane >> 5;
        const float* st = p.in[5] + ((size_t)(b * 16 + h) * 64 + 32 * tjS + (lane & 31)) * 64 + 32 * aS;
#pragma unroll
        for (int reg = 0; reg < 16; ++reg) accH[reg] = (prompt || w >= 4) ? 0.f : st[crow(reg, hh)];
        if (w < 4) {
#pragma unroll
            for (int g4 = 0; g4 < 4; ++g4) { u32x2 v; v.x = pk2(accH[4 * g4], accH[4 * g4 + 1]); v.y = pk2(accH[4 * g4 + 2], accH[4 * g4 + 3]);
                *(LAS u32x2*)(sST + (32 * tjS + (lane & 31)) * 72 + 32 * aS + 8 * g4 + 4 * hh) = v; }
        }
    }
    for (int i = tid0; i < 448; i += 512) {
        int col; if (i < 64) col = h * 64 + i; else if (i < 128) col = 1024 + h * 64 + (i - 64); else if (i < 192) col = 2048 + h * 64 + (i - 128); else col = 3072 + (i - 192);
        sPrev[i] = prompt ? 0.f : p.in[4][(size_t)b * RWW + col];
    }
    __syncthreads();
    int pb = 0;
    for (int t0 = 0; t0 < T; t0 += 64) {
        const int C = (T - t0) < 64 ? (T - t0) : 64;
        const int tid = otid(), lane = tid & 63, hh = lane >> 5;
        const int t = tid >> 3, part = tid & 7;
        const int cb[5] = {h * 64 + 8 * part, 1024 + h * 64 + 8 * part, 2048 + h * 64 + 8 * part, 3072 + 8 * part, 3136 + 8 * part};
        const bool actv = t < C;
        const size_t row = (size_t)(row0 + t0 + t);
        float xr[8], kr[8], vv[8];
        float gsig[16];
#pragma unroll
        for (int e = 0; e < 8; ++e) { xr[e] = 0.f; kr[e] = 0.f; vv[e] = 0.f; }
        if (actv) {
#pragma unroll
            for (int s = 0; s < 5; ++s) {
                float cur[8], prv[8];
                load8bf(RW + row * RWW + cb[s], cur);
                if (t > 0) load8bf(RW + (row - 1) * RWW + cb[s], prv);
                else {
#pragma unroll
                    for (int e = 0; e < 8; ++e) prv[e] = sPrev[pb * 448 + s * 64 + 8 * part + e];
                }
                if (t == C - 1) {
#pragma unroll
                    for (int e = 0; e < 8; ++e) sPrev[(pb ^ 1) * 448 + s * 64 + 8 * part + e] = cur[e];
                }
                const f32x4 m0 = *(const f32x4*)(mu + cb[s]), m1 = *(const f32x4*)(mu + cb[s] + 4);
                const float mm[8] = {m0.x, m0.y, m0.z, m0.w, m1.x, m1.y, m1.z, m1.w};
                float xm[8];
#pragma unroll
                for (int e = 0; e < 8; ++e) xm[e] = cur[e] + (prv[e] - cur[e]) * mm[e];
                if (s == 0) {
#pragma unroll
                    for (int e = 0; e < 8; ++e) xr[e] = xm[e];
                } else if (s == 1) {
#pragma unroll
                    for (int e = 0; e < 8; ++e) kr[e] = xm[e];
                } else if (s == 2) {
#pragma unroll
                    for (int e = 0; e < 8; ++e) vv[e] = xm[e];
                } else if (s == 3) {
#pragma unroll
                    for (int e = 0; e < 8; ++e) sTW[t * 64 + 8 * part + e] = tanhf(xm[e]);
                } else {
#pragma unroll
                    for (int e = 0; e < 8; ++e) sAL[t * 64 + 8 * part + e] = xm[e];
                }
            }
            if (h == 0) {
#pragma unroll
                for (int q = 0; q < 2; ++q) {
                    const int c0 = 3200 + 16 * part + 8 * q;
                    float cur[8], prv[8];
                    load8bf(RW + row * RWW + c0, cur);
                    if (t > 0) load8bf(RW + (row - 1) * RWW + c0, prv);
                    else {
#pragma unroll
                        for (int e = 0; e < 8; ++e) prv[e] = sPrev[pb * 448 + 320 + 16 * part + 8 * q + e];
                    }
                    if (t == C - 1) {
#pragma unroll
                        for (int e = 0; e < 8; ++e) sPrev[(pb ^ 1) * 448 + 320 + 16 * part + 8 * q + e] = cur[e];
                    }
                    const f32x4 m0 = *(const f32x4*)(mu + c0), m1 = *(const f32x4*)(mu + c0 + 4);
                    const float mm[8] = {m0.x, m0.y, m0.z, m0.w, m1.x, m1.y, m1.z, m1.w};
#pragma unroll
                    for (int e = 0; e < 8; ++e) gsig[8 * q + e] = sigmoidf_(cur[e] + (prv[e] - cur[e]) * mm[e]);
                }
            }
        }
        __syncthreads();
        if (actv && h == 0) {
            *(u32x4*)(RW + row * RWW + 3200 + 16 * part) = pack8(gsig);
            *(u32x4*)(RW + row * RWW + 3200 + 16 * part + 8) = pack8(gsig + 8);
        }
        float lw[8], kk[8], bb[8], kn[8]; float bonus = 0.f;
        {
            float n2 = 0.f, a_[8], kkr[8];
            if (actv) {
                float ws_[8], as_[8];
#pragma unroll
                for (int e = 0; e < 8; ++e) { ws_[e] = 0.f; as_[e] = 0.f; }
                const float* w2 = p.in[15] + h * 64 + 8 * part; const float* a2 = p.in[17] + h * 64 + 8 * part;
#pragma unroll 4
                for (int j = 0; j < 64; ++j) {
                    const float tw = sTW[t * 64 + j], al = sAL[t * 64 + j];
                    const f32x4 wa = *(const f32x4*)(w2 + (size_t)j * 1024), wb = *(const f32x4*)(w2 + (size_t)j * 1024 + 4);
                    const f32x4 aa = *(const f32x4*)(a2 + (size_t)j * 1024), ab = *(const f32x4*)(a2 + (size_t)j * 1024 + 4);
                    ws_[0] += tw * wa.x; ws_[1] += tw * wa.y; ws_[2] += tw * wa.z; ws_[3] += tw * wa.w; ws_[4] += tw * wb.x; ws_[5] += tw * wb.y; ws_[6] += tw * wb.z; ws_[7] += tw * wb.w;
                    as_[0] += al * aa.x; as_[1] += al * aa.y; as_[2] += al * aa.z; as_[3] += al * aa.w; as_[4] += al * ab.x; as_[5] += al * ab.y; as_[6] += al * ab.z; as_[7] += al * ab.w;
                }
                const int c0 = h * 64 + 8 * part;
#pragma unroll
                for (int e = 0; e < 8; ++e) {
                    const float wl = -softplusf_(-(p.in[14][c0 + e] + ws_[e])) - 0.5f;
                    lw[e] = -__expf(wl);
                    a_[e] = sigmoidf_(p.in[16][c0 + e] + as_[e]);
                    kkr[e] = kr[e] * p.in[19][c0 + e]; n2 += kkr[e] * kkr[e];
                    kn[e] = kr[e] * (1.f + (a_[e] - 1.f) * p.in[20][c0 + e]);
                    bonus += xr[e] * kn[e] * p.in[21][c0 + e];
                }
            } else {
#pragma unroll
                for (int e = 0; e < 8; ++e) { lw[e] = 0.f; a_[e] = 0.f; kkr[e] = 0.f; kn[e] = 0.f; }
            }
            n2 += __shfl_xor(n2, 1); n2 += __shfl_xor(n2, 2); n2 += __shfl_xor(n2, 4);
            bonus += __shfl_xor(bonus, 1); bonus += __shfl_xor(bonus, 2); bonus += __shfl_xor(bonus, 4);
            const float rn = 1.f / sqrtf(n2 + 1e-6f);
#pragma unroll
            for (int e = 0; e < 8; ++e) { kk[e] = kkr[e] * rn; bb[e] = kk[e] * a_[e]; }
        }
        __syncthreads();
#pragma unroll
        for (int e = 0; e < 8; ++e) sL[t * 65 + 8 * part + e] = lw[e];
        __syncthreads();
        {
            float x[8];
#pragma unroll
            for (int e = 0; e < 8; ++e) x[e] = sL[lane * 65 + 8 * w + e];
#pragma unroll
            for (int o = 1; o < 64; o <<= 1) {
#pragma unroll
                for (int e = 0; e < 8; ++e) { const float v = __shfl_up(x[e], o); if (lane >= o) x[e] += v; }
            }
#pragma unroll
            for (int e = 0; e < 8; ++e) sL[lane * 65 + 8 * w + e] = x[e];
        }
        __syncthreads();
        {
            float at[8], rt[8], kt[8], bt[8];
#pragma unroll
            for (int e = 0; e < 8; ++e) {
                const int c = 8 * part + e;
                const float Lt = sL[t * 65 + c], Lp = (t > 0) ? sL[(t - 1) * 65 + c] : 0.f, Lc = sL[63 * 65 + c];
                const float ep = __expf(Lp), et = __expf(Lt), ei = __expf(-Lt), ec = __expf(Lc - Lt);
                at[e] = kk[e] * ep; rt[e] = xr[e] * et; kt[e] = kn[e] * ei; bt[e] = bb[e] * ei;
                sKdT[c * 72 + t] = (bf16_t)f2bf(kn[e] * ec); sNBdT[c * 72 + t] = (bf16_t)f2bf(-bb[e] * ec); sVT[c * 72 + t] = (bf16_t)f2bf(vv[e]);
                if (t == 0) sPC[c] = __expf(Lc);
            }
            *(LAS u32x4*)(sAt + t * 72 + 8 * part) = pack8(at); *(LAS u32x4*)(sRt + t * 72 + 8 * part) = pack8(rt);
            *(LAS u32x4*)(sKt + t * 72 + 8 * part) = pack8(kt); *(LAS u32x4*)(sBt + t * 72 + 8 * part) = pack8(bt);
            if (part == 0) sBonus[t] = bonus;
        }
        pb ^= 1;
        __syncthreads();
        {
            const int m = w >> 1, q = w & 1;
            const LAS bf16_t* Aop = (m < 2) ? sAt : sRt; const LAS bf16_t* Bop = (m == 0 || m == 3) ? sBt : sKt;
            LAS bf16_t* dst = (m == 1) ? sAak : (m == 2 ? sArk : sNArb);
#pragma unroll
            for (int rep = 0; rep < 2; ++rep) {
                int ti, tj; bool zero = false;
                if (q == 0) { ti = rep; tj = rep; } else { ti = 1 - rep; tj = rep; if (rep == 1) { ti = 0; tj = 1; zero = true; } }
                f32x16 acc;
#pragma unroll
                for (int reg = 0; reg < 16; ++reg) acc[reg] = 0.f;
                if (!zero) mma32<4>(acc, Aop + 32 * ti * 72, 72, Bop + 32 * tj * 72, 72, lane);
                const int j = 32 * tj + (lane & 31);
#pragma unroll
                for (int reg = 0; reg < 16; ++reg) { const int i = 32 * ti + crow(reg, hh);
                    if (m == 0) { if (!zero) sA[i * 68 + j] = (i > j) ? acc[reg] : 0.f; }
                    else if (m == 1) dst[i * 72 + j] = (bf16_t)f2bf((i > j && !zero) ? acc[reg] : 0.f);
                    else if (m == 2) dst[i * 72 + j] = (bf16_t)f2bf((i >= j && !zero) ? acc[reg] : 0.f);
                    else dst[i * 72 + j] = (bf16_t)f2bf((i >= j && !zero) ? -acc[reg] : 0.f); }
            }
        }
        __syncthreads();
        tri_inverse(sA, sX, sM, sTi, tid, C);
        f32x16 accO;
        {
            const int ti = (w >> 1) & 1, tj = w & 1;
            f32x16 acc;
#pragma unroll
            for (int reg = 0; reg < 16; ++reg) acc[reg] = 0.f;
            mma32<4>(acc, ((w < 4) ? sAt : sRt) + 32 * ti * 72, 72, sST + 32 * tj * 72, 72, lane);
            mma32<4>(acc, ((w < 4) ? sAak : sArk) + 32 * ti * 72, 72, sVT + 32 * tj * 72, 72, lane);
            __syncthreads();
            if (w < 4) {
                const int j = 32 * tj + (lane & 31);
#pragma unroll
                for (int g4 = 0; g4 < 4; ++g4) { u32x2 v; v.x = pk2(acc[4 * g4], acc[4 * g4 + 1]); v.y = pk2(acc[4 * g4 + 2], acc[4 * g4 + 3]);
                    *(LAS u32x2*)(sRT + j * 72 + 32 * ti + 8 * g4 + 4 * hh) = v; }
            } else accO = acc;
        }
        __syncthreads();
        if (w < 4) {
            const int ti = (w >> 1) & 1, tj = w & 1;
            f32x16 acc;
#pragma unroll
            for (int reg = 0; reg < 16; ++reg) acc[reg] = 0.f;
            mma32<4>(acc, sTi + 32 * ti * 72, 72, sRT + 32 * tj * 72, 72, lane);
            const int j = 32 * tj + (lane & 31);
#pragma unroll
            for (int g4 = 0; g4 < 4; ++g4) { u32x2 v; v.x = pk2(acc[4 * g4], acc[4 * g4 + 1]); v.y = pk2(acc[4 * g4 + 2], acc[4 * g4 + 3]);
                *(LAS u32x2*)(sYT + j * 72 + 32 * ti + 8 * g4 + 4 * hh) = v; }
        }
        __syncthreads();
        if (w >= 4) {
            const int ti = (w >> 1) & 1, tj = w & 1;
            mma32<4>(accO, sNArb + 32 * ti * 72, 72, sYT + 32 * tj * 72, 72, lane);
            const int j = 32 * tj + (lane & 31);
#pragma unroll
            for (int reg = 0; reg < 16; ++reg) sO[(32 * ti + crow(reg, hh)) * 65 + j] = accO[reg];
        } else {
#pragma unroll
            for (int reg = 0; reg < 16; ++reg) accH[reg] *= sPC[32 * aS + crow(reg, hh)];
            mma32<4>(accH, sKdT + 32 * aS * 72, 72, sVT + 32 * tjS * 72, 72, lane);
            mma32<4>(accH, sNBdT + 32 * aS * 72, 72, sYT + 32 * tjS * 72, 72, lane);
#pragma unroll
            for (int g4 = 0; g4 < 4; ++g4) { u32x2 v; v.x = pk2(accH[4 * g4], accH[4 * g4 + 1]); v.y = pk2(accH[4 * g4 + 2], accH[4 * g4 + 3]);
                *(LAS u32x2*)(sST + (32 * tjS + (lane & 31)) * 72 + 32 * aS + 8 * g4 + 4 * hh) = v; }
        }
        __syncthreads();
        {
            float o[8]; float sm = 0.f;
#pragma unroll
            for (int e = 0; e < 8; ++e) { o[e] = actv ? sO[t * 65 + 8 * part + e] : 0.f; sm += o[e]; }
            sm += __shfl_xor(sm, 1); sm += __shfl_xor(sm, 2); sm += __shfl_xor(sm, 4);
            const float mean = sm * (1.f / 64.f); float vs = 0.f;
#pragma unroll
            for (int e = 0; e < 8; ++e) { o[e] -= mean; vs += o[e] * o[e]; }
            vs += __shfl_xor(vs, 1); vs += __shfl_xor(vs, 2); vs += __shfl_xor(vs, 4);
            const float rs = 1.f / sqrtf(vs * (1.f / 64.f) + 64e-5f);
            if (actv) { const int c0 = h * 64 + 8 * part; const float bo = sBonus[t]; float y[8];
#pragma unroll
                for (int e = 0; e < 8; ++e) y[e] = o[e] * rs * p.in[22][c0 + e] + p.in[23][c0 + e] + bo * vv[e];
                *(u32x4*)(RW + row * RWW + 2048 + c0) = pack8(y); }
        }
        __syncthreads();
    }
    if (w < 4) {
        const int tid = otid(), lane = tid & 63, hh = lane >> 5;
        float* so = p.out + (prompt ? O_RWP : O_RWS) + ((size_t)(b * 16 + h) * 64 + 32 * tjS + (lane & 31)) * 64 + 32 * aS;
#pragma unroll
        for (int reg = 0; reg < 16; ++reg) so[crow(reg, hh)] = accH[reg];
    }
    float* sh = p.out + (prompt ? O_SHIFTP : O_SHIFTS) + (size_t)b * RWW;
    for (int i = otid(); i < 448; i += 512) {
        if (i >= 192 && h != 0) continue;
        int col; if (i < 64) col = h * 64 + i; else if (i < 128) col = 1024 + h * 64 + (i - 64); else if (i < 192) col = 2048 + h * 64 + (i - 128); else col = 3072 + (i - 192);
        sh[col] = sPrev[pb * 448 + i];
    }
    __syncthreads();
}

DI void phase_scan(const Params& p, LAS unsigned char* lds) {
    unsigned* ctr = (unsigned*)(p.ws + WS_CTL);
    LAS int* sItem = (LAS int*)(lds + LDS_BYTES - 16);
    for (;;) {
        if (threadIdx.x == 0) *sItem = (int)atomicAdd(ctr, 1u);
        __syncthreads();
        const int item = __builtin_amdgcn_readfirstlane(*sItem);
        __syncthreads();
        if (item >= 4352) break;
        if (item < 128) dn_item(p, lds, item >> 4, (item >> 1) & 7, item & 1, true);
        else if (item < 256) { const int j = item - 128; rw_item(p, lds, j >> 4, j & 15, true); }
        else if (item < 2304) { const int j = item - 256; dn_item(p, lds, j >> 4, (j >> 1) & 7, j & 1, false); }
        else { const int j = item - 2304; rw_item(p, lds, j >> 4, j & 15, false); }
    }
}

DI void phase_merge(const Params& p) {
    const bf16_t* QKV = (const bf16_t*)(p.ws + WS_QKV); const bf16_t* RW = (const bf16_t*)(p.ws + WS_RW);
    bf16_t* MIX = (bf16_t*)((unsigned char*)p.out + DO_H);
    const int gt = blockIdx.x * 512 + otid(), NT = gridDim.x * 512;
    for (int u = gt; u < M * 128; u += NT) {
        const int row = u >> 7, c = (u & 127) * 8;
        float o[8], z[8], ga[8], gb[8], orw[8], gate[8];
        load8bf(QKV + (size_t)row * QKVW + 2048 + c, o); load8bf(QKV + (size_t)row * QKVW + c, z); load8bf(QKV + (size_t)row * QKVW + 1024 + c, ga);
        load8bf(RW + (size_t)row * RWW + c, gb); load8bf(RW + (size_t)row * RWW + 2048 + c, orw); load8bf(RW + (size_t)row * RWW + 1024 + c, gate);
        float ss = 0.f;
#pragma unroll
        for (int e = 0; e < 8; ++e) ss += o[e] * o[e];
        ss += __shfl_xor(ss, 1); ss += __shfl_xor(ss, 2); ss += __shfl_xor(ss, 4); ss += __shfl_xor(ss, 8);
        const float rs = 1.f / sqrtf(ss * (1.f / 128.f) + 1e-6f);
        float mix[8];
#pragma unroll
        for (int e = 0; e < 8; ++e) { const float odn = o[e] * rs * p.in[12][(c & 127) + e] * siluf_(z[e]); mix[e] = sigmoidf_(ga[e]) * odn + sigmoidf_(gb[e]) * (orw[e] * gate[e]); }
        *(u32x4*)(MIX + (size_t)row * D + c) = pack8(mix);
    }
}
DI void phase_norm2(const Params& p) {
    const int tid_ = otid(); const int lane = tid_ & 63, gw = blockIdx.x * 8 + (tid_ >> 6), NGW = gridDim.x * 8;
    const float* X1 = (const float*)(p.ws + WS_X1); bf16_t* H = (bf16_t*)((unsigned char*)p.out + DO_H);
    for (int m = gw; m < M; m += NGW) { f32x4 v[4]; rms_row(X1 + (size_t)m * D, p.in[25], H + (size_t)m * D, lane, v); }
}
DI void phase_final(const Params& p) {
    const int tid_ = otid(); const int lane = tid_ & 63, gw = blockIdx.x * 8 + (tid_ >> 6), NGW = gridDim.x * 8;
    const float* X1 = (const float*)(p.ws + WS_X1);
    for (int m = gw; m < M; m += NGW) {
        float* orow;
        if (m < MPR) { const int b = m / TP, t = m - b * TP; if (t < 16) continue; orow = p.out + O_YP + ((size_t)b * 2048 + (t - 16)) * D; }
        else orow = p.out + O_YS + (size_t)(m - MPR) * D;
        f32x4 v[4]; rms_row(X1 + (size_t)m * D, p.in[28], nullptr, lane, v);
#pragma unroll
        for (int j = 0; j < 4; ++j) *(f32x4*)(orow + 4 * lane + 256 * j) = v[j];
    }
}


DI void grid_bar(unsigned* ctr, unsigned target) {
    asm volatile("s_waitcnt vmcnt(0)" ::: "memory");
    __syncthreads();
    if (threadIdx.x == 0) {
        __builtin_amdgcn_fence(__ATOMIC_RELEASE, "agent");
        asm volatile("s_waitcnt vmcnt(0)" ::: "memory");
        __hip_atomic_fetch_add(ctr, 1u, __ATOMIC_RELAXED, __HIP_MEMORY_SCOPE_AGENT);
        while (__hip_atomic_load(ctr, __ATOMIC_RELAXED, __HIP_MEMORY_SCOPE_AGENT) < target) __builtin_amdgcn_s_sleep(2);
        __builtin_amdgcn_fence(__ATOMIC_ACQUIRE, "agent");
        asm volatile("s_waitcnt vmcnt(0)" ::: "memory");
    }
    __syncthreads();
}
__global__ void __launch_bounds__(512, 2) fwd_megakernel(Params p) {
    extern __shared__ __attribute__((aligned(16))) unsigned char lds_raw[];
    LAS unsigned char* lds = (LAS unsigned char*)lds_raw;
    cg::grid_group grid = cg::this_grid();
    const int G = gridDim.x, c = blockIdx.x;
    bf16_t* H = (bf16_t*)((unsigned char*)p.out + DO_H);
    bf16_t* WIN = (bf16_t*)((unsigned char*)p.out + DO_WIN);
    bf16_t* QKV = (bf16_t*)(p.ws + WS_QKV); bf16_t* RW = (bf16_t*)(p.ws + WS_RW);
    float* X1 = (float*)(p.ws + WS_X1); bf16_t* ACT = (bf16_t*)(p.ws + WS_ACT);

    unsigned* gctr = (unsigned*)(p.ws + WS_CTL) + 64;
    grid.sync();
    phase0(p, lds);
    grid_bar(gctr, 1u * (unsigned)G);
    {
        pg8::Gemm g{H, D, WIN, MP, N1A, D}; pg8::StaticOrder S; S.init(MP, N1A, G, c);
        pg8::EpiSeg<0> E{QKV, QKVW, 3072, RW, RWW};
        pg8::gemm_phase<1024, 1024>(lds, g, S, E);
    }
    grid_bar(gctr, 2u * (unsigned)G);
    phase_scan(p, lds);
    grid_bar(gctr, 3u * (unsigned)G);
    {
        pg8::Gemm g{H, D, WIN + (size_t)N1A * D, MP, N1B, D}; pg8::StaticOrder S; S.init(MP, N1B, G, c);
        pg8::EpiSeg<0> E{QKV, QKVW, 2048, RW, RWW};
        pg8::gemm_phase<1024, 1024>(lds, g, S, E);
        pg8::Gemm g2{RW + 3200, RWW, (const bf16_t*)(p.ws + WS_WG2), MP, 1024, 128}; pg8::StaticOrder S2; S2.init(MP, 1024, G, c);
        pg8::EpiSeg<0> E2{RW + 1024, RWW, 1 << 30, RW, RWW};
        pg8::gemm_phase<128, 3328>(lds, g2, S2, E2);
    }
    grid_bar(gctr, 4u * (unsigned)G);
    phase_merge(p);
    grid_bar(gctr, 5u * (unsigned)G);
    {
        pg8::Gemm g{H, D, (const bf16_t*)(p.ws + WS_WOUT), MP, D, D}; pg8::StaticOrder S; S.init(MP, D, G, c);
        pg8::EpiRes<0> E{X1, p.in[0], p.in[1], p.in[6]};
        pg8::gemm_phase<1024, 1024>(lds, g, S, E);
    }
    grid_bar(gctr, 6u * (unsigned)G);
    phase_norm2(p);
    grid_bar(gctr, 7u * (unsigned)G);
    {
        pg8::Gemm g{H, D, (const bf16_t*)(p.ws + WS_WFF1), MP, FF, D}; pg8::StaticOrder S; S.init(MP, FF, G, c);
        pg8::EpiSeg<1> E{ACT, FF, 1 << 30, ACT, FF};
        pg8::gemm_phase<1024, 1024>(lds, g, S, E);
    }
    grid_bar(gctr, 8u * (unsigned)G);
    {
        pg8::Gemm g{ACT, FF, (const bf16_t*)(p.ws + WS_WFF2), MP, D, FF}; pg8::StaticOrder S; S.init(MP, D, G, c);
        pg8::EpiRes<1> E{X1, nullptr, nullptr, nullptr};
        pg8::gemm_phase<4096, 4096>(lds, g, S, E);
    }
    grid_bar(gctr, 9u * (unsigned)G);
    phase_final(p);
}

extern "C" void kernel_launch(void* const* d_in, const int* in_sizes, int n_in, void* d_out, int out_size, void* d_ws, size_t ws_size, hipStream_t stream) {
    static int grid = 0;
    if (grid == 0) {
        int dev = 0, cus = 0, per_cu = 0;
        hipGetDevice(&dev);
        hipDeviceGetAttribute(&cus, hipDeviceAttributeMultiprocessorCount, dev);
        if (hipFuncSetAttribute((const void*)fwd_megakernel, hipFuncAttributeMaxDynamicSharedMemorySize, LDS_BYTES) != hipSuccess) fprintf(stderr, "hipFuncSetAttribute failed\n");
        hipOccupancyMaxActiveBlocksPerMultiprocessor(&per_cu, (const void*)fwd_megakernel, 512, LDS_BYTES);
        if (per_cu < 1) { fprintf(stderr, "occupancy query says %d blocks per CU\n", per_cu); per_cu = 1; }
        grid = cus;
        if (n_in != 29 || ws_size < 256 * MiB) fprintf(stderr, "unexpected n_in %d / ws %zu\n", n_in, ws_size);
    }
    hipMemsetAsync((char*)d_ws + WS_CTL, 0, 4096, stream);
    Params p{};
    for (int i = 0; i < 29; ++i) p.in[i] = (const float*)d_in[i];
    p.out = (float*)d_out; p.ws = (unsigned char*)d_ws;
    void* args[] = {&p};
    hipError_t e = hipLaunchCooperativeKernel((const void*)fwd_megakernel, dim3(grid), dim3(512), args, LDS_BYTES, stream);
    if (e != hipSuccess) fprintf(stderr, "cooperative launch failed: %s (grid %d)\n", hipGetErrorString(e), grid);
}
```

```cpp
#include <hip/hip_runtime.h>
#include <hip/hip_cooperative_groups.h>
#include <cstdio>
#include <cstdint>
namespace cg = cooperative_groups;

#define DI __device__ __forceinline__
#define LAS __attribute__((address_space(3)))
typedef unsigned short bf16_t;
typedef short bf16x8 __attribute__((ext_vector_type(8)));
typedef float f32x4 __attribute__((ext_vector_type(4)));
typedef unsigned u32x4 __attribute__((ext_vector_type(4)));

constexpr int D = 1024, TP = 2064, NBP = 8, NBS = 128, TS = 8;
constexpr int MPR = NBP * TP;
constexpr int M = MPR + NBS * TS;
constexpr int MP = 17664;
constexpr int QKVW = 3072, RWW = 3328, PROJW = 9488, FF = 4096;
constexpr int N1A = 6400, N1B = 3072;
constexpr size_t MiB = 1u << 20;
constexpr size_t WS_CTL = 0;
constexpr size_t WS_WOUT = 1 * MiB, WS_WFF1 = 3 * MiB, WS_WFF2 = 11 * MiB, WS_WG2 = 19 * MiB;
constexpr size_t WS_GDN = 19 * MiB + 512 * 1024, WS_BETA = 20 * MiB + 512 * 1024;
constexpr size_t WS_QKV = 22 * MiB, WS_RW = 126 * MiB;
constexpr size_t WS_X1 = WS_QKV, WS_ACT = 92 * MiB;
constexpr size_t DO_H = 0, DO_WIN = 35 * MiB;
constexpr size_t O_YP = 0, O_YS = 16777216, O_CONVP = 17825792, O_DNP = 17899520, O_SHIFTP = 18948096, O_RWP = 18974720,
                 O_CONVS = 19499008, O_DNS = 20678656, O_SHIFTS = 37455872, O_RWS = 37881856;
constexpr int LDS_BYTES = 163840;

struct Params { const float* in[29]; float* out; unsigned char* ws; };

typedef __bf16 bf16v2 __attribute__((ext_vector_type(2)));
typedef float f32x2 __attribute__((ext_vector_type(2)));
DI unsigned pk2(float lo, float hi) { const f32x2 v = {lo, hi}; return __builtin_bit_cast(unsigned, __builtin_convertvector(v, bf16v2)); }
DI unsigned f2bf(float f) { return pk2(f, 0.f) & 0xffffu; }
DI float bflo(unsigned u) { return __builtin_bit_cast(float, u << 16); }
DI float bfhi(unsigned u) { return __builtin_bit_cast(float, u & 0xffff0000u); }
DI void unpack8(const u32x4 v, float* o) { o[0] = bflo(v.x); o[1] = bfhi(v.x); o[2] = bflo(v.y); o[3] = bfhi(v.y); o[4] = bflo(v.z); o[5] = bfhi(v.z); o[6] = bflo(v.w); o[7] = bfhi(v.w); }
DI u32x4 pack8(const float* o) { u32x4 v; v.x = pk2(o[0], o[1]); v.y = pk2(o[2], o[3]); v.z = pk2(o[4], o[5]); v.w = pk2(o[6], o[7]); return v; }
DI void load8bf(const bf16_t* p, float* o) { unpack8(*(const u32x4*)p, o); }
DI float wave_sum(float v) {
#pragma unroll
    for (int o = 1; o < 64; o <<= 1) v += __shfl_xor(v, o);
    return v;
}
DI float sigmoidf_(float x) { return __builtin_amdgcn_rcpf(1.f + __expf(-x)); }
DI float tanhf_(float x) { return 1.f - 2.f * __builtin_amdgcn_rcpf(__expf(2.f * x) + 1.f); }
DI float rsqrtf_(float x) { return __builtin_amdgcn_rsqf(x); }
DI float softplusf_(float x) { return fmaxf(x, 0.f) + __logf(1.f + __expf(-fabsf(x))); }
DI float siluf_(float x) { return x * sigmoidf_(x); }
DI int otid() { int t = threadIdx.x; asm volatile("" : "+v"(t)); return t; }
#define LDS_WAIT() asm volatile("s_waitcnt lgkmcnt(0)" ::: "memory")

DI const float* xrow3(const float* xp, const float* xs, const float* xm, int r) {
    if (r < MPR) { const int b = r / TP, t = r - b * TP; return t < 16 ? xm + (size_t)t * D : xp + ((size_t)b * 2048 + (t - 16)) * D; }
    return xs + (size_t)(r - MPR) * D;
}
DI const float* xrow(const Params& p, int r) {
    if (r < MPR) { const int b = r / TP, t = r - b * TP; return t < 16 ? p.in[6] + (size_t)t * D : p.in[0] + ((size_t)b * 2048 + (t - 16)) * D; }
    return p.in[1] + (size_t)(r - MPR) * D;
}

namespace pg8 {
constexpr int BM = 256, BK = 64, HALF = 128, HTB = HALF * BK * 2, STAGE_BYTES = 8 * HTB, NXCD = 8, WGM = 8;
DI int lds_byte(int r, int c) { const int st = (r >> 4) * 2 + (c >> 5), rr = r & 15, cc = c & 31, ob = rr * 64 + cc * 2; return st * 1024 + (ob ^ (((ob >> 9) & 1) << 5)); }
DI void stage_rc(int b, int& R, int& C) { const int st = b / 1024, sb = b % 1024, swz = sb ^ (((sb >> 9) & 1) << 5); R = (st >> 1) * 16 + swz / 64; C = (st & 1) * 32 + (swz % 64) / 2; }
DI int perm32(int rho) { const int n = rho >> 4, i = rho & 15; return 8 * (i >> 2) + 4 * n + (i & 3); }
struct Unit { int pm, pn; };
struct Gemm { const bf16_t* A; int lda; const bf16_t* Bt; int M, N, K; };
struct StaticOrder {
    int nM, nN, nwg, G, c;
    DI void init(int M_, int N_, int G_, int c_) { nM = M_ / BM; nN = N_ / BM; nwg = nM * nN; G = G_; c = c_; }
    DI bool next(int i, Unit& u) const {
        const long L = (long)i * G + c; if (L >= nwg) return false;
        int wgid = (int)L; { const int q = nwg / NXCD, r = nwg % NXCD, xcd = wgid % NXCD, off = wgid / NXCD; wgid = (xcd < r ? xcd * (q + 1) : r * (q + 1) + (xcd - r) * q) + off; }
        const int nig = WGM * nN, gid = wgid / nig, fm = gid * WGM, gsz = (nM - fm) < WGM ? (nM - fm) : WGM;
        u.pm = fm + ((wgid % nig) % gsz); u.pn = (wgid % nig) / gsz; return true;
    }
};
DI unsigned cvt_pk_bf16(float lo, float hi) { return pk2(lo, hi); }

template <int ACT> struct EpiSeg {
    bf16_t* d0; int ld0; int split; bf16_t* d1; int ld1;
    DI void operator()(const f32x4 (&acc)[2][2][4][2], const Unit& u, int wr, int wc, int fr, int fq) const {
        const int row0 = u.pm * BM + wr * 64 + fr; int colt = u.pn * BM; bf16_t* base = d0; int ld = ld0;
        if (colt >= split) { base = d1; ld = ld1; colt -= split; }
        const int col0 = colt + wc * 32 + 8 * fq;
#pragma unroll
        for (int ai = 0; ai < 2; ++ai)
#pragma unroll
            for (int m = 0; m < 4; ++m) { bf16_t* rowp = base + (size_t)(row0 + ai * HALF + m * 16) * ld + col0;
#pragma unroll
                for (int bj = 0; bj < 2; ++bj) { f32x4 v0 = acc[ai][bj][m][0], v1 = acc[ai][bj][m][1];
                    if (ACT == 1) {
#pragma unroll
                        for (int e = 0; e < 4; ++e) { float a = fmaxf(v0[e], 0.f), b = fmaxf(v1[e], 0.f); v0[e] = a * a; v1[e] = b * b; } }
                    u32x4 w; w.x = cvt_pk_bf16(v0[0], v0[1]); w.y = cvt_pk_bf16(v0[2], v0[3]); w.z = cvt_pk_bf16(v1[0], v1[1]); w.w = cvt_pk_bf16(v1[2], v1[3]);
                    *(u32x4*)(rowp + bj * HALF) = w; } }
    }
};
template <int MODE> struct EpiRes {
    float* X1; const float* xp; const float* xs; const float* xm;
    DI void operator()(const f32x4 (&acc)[2][2][4][2], const Unit& u, int wr, int wc, int fr, int fq) const {
        const int row0 = u.pm * BM + wr * 64 + fr; const int col0 = u.pn * BM + wc * 32 + 8 * fq;
#pragma unroll
        for (int ai = 0; ai < 2; ++ai)
#pragma unroll
            for (int m = 0; m < 4; ++m) { const int row = row0 + ai * HALF + m * 16; float* op = X1 + (size_t)row * D + col0;
                const float* bp = (MODE == 1) ? op : (row < M ? xrow3(xp, xs, xm, row) + col0 : nullptr);
#pragma unroll
                for (int bj = 0; bj < 2; ++bj) { f32x4 b0 = (f32x4){0.f, 0.f, 0.f, 0.f}, b1 = b0;
                    if (bp) { b0 = *(const f32x4*)(bp + bj * HALF); b1 = *(const f32x4*)(bp + bj * HALF + 4); }
                    *(f32x4*)(op + bj * HALF) = acc[ai][bj][m][0] + b0; *(f32x4*)(op + bj * HALF + 4) = acc[ai][bj][m][1] + b1; } }
    }
};

template <int K, int lda, class Epi>
DI void gemm_phase(LAS unsigned char* lds, const Gemm g, const StaticOrder& S, const Epi& E) {
    const int tid = otid(), wid = __builtin_amdgcn_readfirstlane(tid >> 6), lane = tid & 63, wr = wid >> 2, wc = wid & 3, fr = lane & 15, fq = lane >> 4;
    constexpr int nt = K / BK;
    unsigned voffA[2], voffB[2];
#pragma unroll
    for (int i = 0; i < 2; ++i) { int R, C; stage_rc(tid * 16 + i * 8192, R, C); const int Rb = (R & ~31) + perm32(R & 31);
        voffA[i] = (unsigned)(R * lda + C) * 2u; voffB[i] = (unsigned)(Rb * K + C) * 2u; }
    const size_t kstep = (size_t)(BK * 2);
    const size_t hA = (size_t)HALF * lda * 2, hB = (size_t)HALF * K * 2;
    const size_t tA = 2 * hA, tB = 2 * hB;
    const unsigned ldsw = (unsigned)wid * 1024u;
    const int aoff = lds_byte(wr * 64 + fr, fq * 8), boff = lds_byte(wc * 32 + fr, fq * 8);
#define PG8_SA(b, h) (((b) * 2 + (h)) * HTB)
#define PG8_SB(b, h) ((4 + (b) * 2 + (h)) * HTB)
#define PG8_STAGE(bufoff, gbase, voff) do { _Pragma("unroll") for (int _i = 0; _i < 2; ++_i) \
        __builtin_amdgcn_global_load_lds((const unsigned*)((const char*)(gbase) + (voff)[_i]), (LAS unsigned*)(lds + (bufoff) + ldsw + _i * 8192), 16, 0, 0); } while (0)
#define PG8_LDA(dst, b, h) do { _Pragma("unroll") for (int m = 0; m < 4; ++m) _Pragma("unroll") for (int k = 0; k < 2; ++k) dst[m][k] = *(const LAS bf16x8*)(lds + PG8_SA(b, h) + aoff + m * 2048 + k * 1024); } while (0)
#define PG8_LDB(dst, b, h) do { _Pragma("unroll") for (int n = 0; n < 2; ++n) _Pragma("unroll") for (int k = 0; k < 2; ++k) dst[n][k] = *(const LAS bf16x8*)(lds + PG8_SB(b, h) + boff + n * 2048 + k * 1024); } while (0)
#define PG8_MMA(ai, bj, At, Bt) do { __builtin_amdgcn_s_setprio(1); _Pragma("unroll") for (int m = 0; m < 4; ++m) _Pragma("unroll") for (int n = 0; n < 2; ++n) _Pragma("unroll") for (int k = 0; k < 2; ++k) \
        acc[ai][bj][m][n] = __builtin_amdgcn_mfma_f32_16x16x32_bf16(Bt[n][k], At[m][k], acc[ai][bj][m][n], 0, 0, 0); __builtin_amdgcn_s_setprio(0); } while (0)
#define PG8_WAIT_V(n) asm volatile("s_waitcnt vmcnt(" #n ")" ::: "memory")
#define PG8_WAIT_L(n) asm volatile("s_waitcnt lgkmcnt(" #n ")" ::: "memory")
#define PG8_BAR __builtin_amdgcn_s_barrier()
#define PG8_SCHED __builtin_amdgcn_sched_barrier(0)
    Unit cur, nxt; int ui = 0;
    if (!S.next(0, cur)) return;
    f32x4 acc[2][2][4][2];
#pragma unroll
    for (int a = 0; a < 2; ++a)
#pragma unroll
        for (int b = 0; b < 2; ++b)
#pragma unroll
            for (int m = 0; m < 4; ++m)
#pragma unroll
                for (int n = 0; n < 2; ++n) acc[a][b][m][n] = (f32x4){0.f, 0.f, 0.f, 0.f};
    bf16x8 At[4][2], B0[2][2], B1[2][2];
    const char* cA = (const char*)g.A + (size_t)cur.pm * tA; const char* cB = (const char*)g.Bt + (size_t)cur.pn * tB;
    PG8_STAGE(PG8_SB(0, 0), cB, voffB); PG8_STAGE(PG8_SA(0, 0), cA, voffA); PG8_STAGE(PG8_SB(0, 1), cB + hB, voffB); PG8_STAGE(PG8_SA(0, 1), cA + hA, voffA);
    if (wr == 1) PG8_BAR;
    PG8_WAIT_V(4); PG8_BAR;
    PG8_STAGE(PG8_SB(1, 0), cB + kstep, voffB); PG8_STAGE(PG8_SA(1, 0), cA + kstep, voffA); PG8_STAGE(PG8_SB(1, 1), cB + hB + kstep, voffB);
    PG8_WAIT_V(6); PG8_BAR;
    for (;;) {
        const bool has_next = S.next(ui + 1, nxt);
        const char* nA = has_next ? (const char*)g.A + (size_t)nxt.pm * tA : cA; const char* nB = has_next ? (const char*)g.Bt + (size_t)nxt.pn * tB : cB;
        for (int t = 0; t < nt; t += 2) {
            const bool last = (t == nt - 2);
            const char* a1 = cA + (size_t)(t + 1) * kstep;
            const char* a2 = last ? nA : cA + (size_t)(t + 2) * kstep; const char* b2 = last ? nB : cB + (size_t)(t + 2) * kstep;
            const char* a3 = a2 + kstep; const char* b3 = b2 + kstep;
            PG8_LDB(B0, 0, 0); PG8_SCHED; PG8_LDA(At, 0, 0); PG8_STAGE(PG8_SA(1, 1), a1 + hA, voffA);
            PG8_WAIT_L(8); PG8_BAR; PG8_WAIT_L(0); PG8_MMA(0, 0, At, B0); PG8_BAR; PG8_SCHED;
            PG8_LDB(B1, 0, 1); PG8_STAGE(PG8_SB(0, 0), b2, voffB);
            PG8_BAR; PG8_WAIT_L(0); PG8_MMA(0, 1, At, B1); PG8_BAR;
            PG8_LDA(At, 0, 1); PG8_STAGE(PG8_SA(0, 0), a2, voffA);
            PG8_BAR; PG8_WAIT_L(0); PG8_MMA(1, 0, At, B0); PG8_BAR; PG8_SCHED;
            PG8_STAGE(PG8_SB(0, 1), b2 + hB, voffB);
            PG8_WAIT_V(6); PG8_BAR; PG8_MMA(1, 1, At, B1); PG8_BAR;
            PG8_LDB(B0, 1, 0); PG8_SCHED; PG8_LDA(At, 1, 0); PG8_STAGE(PG8_SA(0, 1), a2 + hA, voffA);
            PG8_WAIT_L(8); PG8_BAR; PG8_WAIT_L(0); PG8_MMA(0, 0, At, B0); PG8_BAR; PG8_SCHED;
            PG8_LDB(B1, 1, 1); PG8_STAGE(PG8_SB(1, 0), b3, voffB);
            PG8_BAR; PG8_WAIT_L(0); PG8_MMA(0, 1, At, B1); PG8_BAR;
            PG8_LDA(At, 1, 1); PG8_STAGE(PG8_SA(1, 0), a3, voffA);
            PG8_BAR; PG8_WAIT_L(0); PG8_MMA(1, 0, At, B0); PG8_BAR; PG8_SCHED;
            PG8_STAGE(PG8_SB(1, 1), b3 + hB, voffB);
            PG8_WAIT_V(6); PG8_BAR; PG8_MMA(1, 1, At, B1); PG8_BAR;
        }
        E(acc, cur, wr, wc, fr, fq);
        if (!has_next) break;
#pragma unroll
        for (int a = 0; a < 2; ++a)
#pragma unroll
            for (int b = 0; b < 2; ++b)
#pragma unroll
                for (int m = 0; m < 4; ++m)
#pragma unroll
                    for (int n = 0; n < 2; ++n) acc[a][b][m][n] = (f32x4){0.f, 0.f, 0.f, 0.f};
        cur = nxt; cA = nA; cB = nB; ++ui;
    }
    PG8_WAIT_V(0);
    if (wr == 0) PG8_BAR;
    PG8_BAR;
#undef PG8_SA
#undef PG8_SB
#undef PG8_STAGE
#undef PG8_LDA
#undef PG8_LDB
#undef PG8_MMA
#undef PG8_WAIT_V
#undef PG8_WAIT_L
#undef PG8_BAR
#undef PG8_SCHED
}
}

DI void transpose_item(const float* W, int ldw, int nblk, bf16_t* WT, int K, int row_off, LAS float* scr, int item, int lane) {
    const int kb = item / nblk, nb = item - kb * nblk, k0 = 64 * kb, n0 = 32 * nb;
#pragma unroll 8
    for (int i = 0; i < 32; ++i) { const int kk = 2 * i + (lane >> 5); scr[kk * 33 + (lane & 31)] = W[(size_t)(k0 + kk) * ldw + n0 + (lane & 31)]; }
    LDS_WAIT();
    const int c = lane & 7;
#pragma unroll
    for (int j = 0; j < 4; ++j) { const int n = (lane >> 3) + 8 * j; const LAS float* s = scr + (8 * c) * 33 + n;
        u32x4 o; o.x = pk2(s[0 * 33], s[1 * 33]); o.y = pk2(s[2 * 33], s[3 * 33]); o.z = pk2(s[4 * 33], s[5 * 33]); o.w = pk2(s[6 * 33], s[7 * 33]);
        *(u32x4*)(WT + (size_t)(row_off + n0 + n) * K + k0 + 8 * c) = o; }
    LDS_WAIT();
}

DI void rms_row(const float* xr, const float* g, bf16_t* orow, int lane, f32x4 (&v)[4]) {
    float s = 0.f;
#pragma unroll
    for (int j = 0; j < 4; ++j) { v[j] = *(const f32x4*)(xr + 4 * lane + 256 * j); s += (v[j].x * v[j].x + v[j].y * v[j].y) + (v[j].z * v[j].z + v[j].w * v[j].w); }
    const float rstd = 1.f / sqrtf(wave_sum(s) * (1.f / D) + 1e-6f);
#pragma unroll
    for (int j = 0; j < 4; ++j) { const f32x4 gg = *(const f32x4*)(g + 4 * lane + 256 * j); v[j] = v[j] * rstd * gg;
        if (orow) { unsigned long long o = (unsigned long long)pk2(v[j].x, v[j].y) | ((unsigned long long)pk2(v[j].z, v[j].w) << 32); *(unsigned long long*)(orow + 4 * lane + 256 * j) = o; } }
}

DI void phase0(const Params& p, LAS unsigned char* lds) {
    const int tid = otid(), lane = tid & 63, wave = __builtin_amdgcn_readfirstlane(tid >> 6);
    LAS float* scr = (LAS float*)(lds + wave * 16384);
    const int gw = blockIdx.x * 8 + wave, NGW = gridDim.x * 8;
    bf16_t* WIN = (bf16_t*)((unsigned char*)p.out + DO_WIN);
    bf16_t* WOUT = (bf16_t*)(p.ws + WS_WOUT); bf16_t* WF1 = (bf16_t*)(p.ws + WS_WFF1); bf16_t* WF2 = (bf16_t*)(p.ws + WS_WFF2); bf16_t* WG2 = (bf16_t*)(p.ws + WS_WG2);
    const float* w_in = p.in[8];
    constexpr int I0 = 16 * 96, I1 = 16 * 104, I2 = 16 * 32, I3 = 16 * 64, I4 = 16 * 32, I5 = 16 * 128, I6 = 64 * 32, I7 = 2 * 32;
    constexpr int NIT = I0 + I1 + I2 + I3 + I4 + I5 + I6 + I7;
    for (int it = gw; it < NIT; it += NGW) {
        int r = it;
        if (r < I0) { transpose_item(w_in, PROJW, 96, WIN, 1024, 0, scr, r, lane); continue; } r -= I0;
        if (r < I1) { transpose_item(w_in + 4112, PROJW, 104, WIN, 1024, 3072, scr, r, lane); continue; } r -= I1;
        if (r < I2) { transpose_item(w_in + 3072, PROJW, 32, WIN, 1024, 6400, scr, r, lane); continue; } r -= I2;
        if (r < I3) { transpose_item(w_in + 7440, PROJW, 64, WIN, 1024, 7424, scr, r, lane); continue; } r -= I3;
        if (r < I4) { transpose_item(p.in[24], 1024, 32, WOUT, 1024, 0, scr, r, lane); continue; } r -= I4;
        if (r < I5) { transpose_item(p.in[26], 4096, 128, WF1, 1024, 0, scr, r, lane); continue; } r -= I5;
        if (r < I6) { transpose_item(p.in[27], 1024, 32, WF2, 4096, 0, scr, r, lane); continue; } r -= I6;
        transpose_item(p.in[18], 1024, 32, WG2, 128, 0, scr, r, lane);
    }
    bf16_t* H = (bf16_t*)((unsigned char*)p.out + DO_H);
    float* GDN = (float*)(p.ws + WS_GDN); float* BETA = (float*)(p.ws + WS_BETA);
    __syncthreads();
    LAS float* sWab = (LAS float*)lds;
    for (int idx = tid; idx < 16384; idx += 512) { const int k = idx >> 4, i = idx & 15; sWab[i * 1028 + k] = w_in[(size_t)k * PROJW + 4096 + i]; }
    __syncthreads();
    for (int m = gw; m < MP; m += NGW) {
        bf16_t* hr = H + (size_t)m * D;
        if (m >= M) {
#pragma unroll
            for (int j = 0; j < 4; ++j) *(unsigned long long*)(hr + 4 * lane + 256 * j) = 0ull;
            continue;
        }
        f32x4 v[4];
        rms_row(xrow(p, m), p.in[7], hr, lane, v);
        float s[16];
#pragma unroll
        for (int i = 0; i < 16; ++i) { float a = 0.f;
#pragma unroll
            for (int j = 0; j < 4; ++j) { const f32x4 w4 = *(const LAS f32x4*)(sWab + i * 1028 + 256 * j + 4 * lane); a += v[j].x * w4.x + v[j].y * w4.y + v[j].z * w4.z + v[j].w * w4.w; }
            s[i] = a; }
        float mine = 0.f;
#pragma unroll
        for (int i = 0; i < 16; ++i) { const float t = wave_sum(s[i]); if (lane == i) mine = t; }
        if (lane < 8) GDN[(size_t)m * 8 + lane] = -__expf(p.in[10][lane]) * softplusf_(mine + p.in[11][lane]);
        else if (lane < 16) BETA[(size_t)m * 8 + lane - 8] = sigmoidf_(mine);
    }
}

typedef float f32x16 __attribute__((ext_vector_type(16)));
typedef unsigned u32x2 __attribute__((ext_vector_type(2)));
DI int crow(int reg, int hh) { return (reg & 3) + 8 * (reg >> 2) + 4 * hh; }
template <int KS> DI void mma32(f32x16& acc, const LAS bf16_t* A, int lda, const LAS bf16_t* Bt, int ldb, int lane) {
    const int r = lane & 31, hh = lane >> 5;
    const LAS bf16_t* pa = A + r * lda + 8 * hh; const LAS bf16_t* pb = Bt + r * ldb + 8 * hh;
#pragma unroll
    for (int ks = 0; ks < KS; ++ks) { const bf16x8 a = *(const LAS bf16x8*)(pa + 16 * ks); const bf16x8 b = *(const LAS bf16x8*)(pb + 16 * ks);
        acc = __builtin_amdgcn_mfma_f32_32x32x16_bf16(a, b, acc, 0, 0, 0); }
}
template <int s> DI void tri_level(LAS float* sA, LAS float* sX, LAS float* sM, int tid) {
    constexpr int NP = 32 / s, NOUT = NP * s * s, PER = (NOUT + 511) / 512, MS = s + 4;
    float res[PER];
#pragma unroll
    for (int u = 0; u < PER; ++u) { const int o = tid + 512 * u; res[u] = 0.f;
        if (o < NOUT) { const int pp = o / (s * s), r = (o / s) % s, c = o % s; const int R0 = 2 * s * pp + s, C0 = 2 * s * pp;
            const LAS float* ar = sA + (R0 + r) * 68 + C0; const LAS float* xc = sX + C0 * 68 + C0 + c; float acc = 0.f;
#pragma unroll
            for (int k4 = 0; k4 < s / 4; ++k4) { const f32x4 a = *(const LAS f32x4*)(ar + 4 * k4);
                acc += a.x * xc[(4 * k4) * 68] + a.y * xc[(4 * k4 + 1) * 68] + a.z * xc[(4 * k4 + 2) * 68] + a.w * xc[(4 * k4 + 3) * 68]; }
            sM[pp * (s * MS) + r * MS + c] = acc; } }
    __syncthreads();
#pragma unroll
    for (int u = 0; u < PER; ++u) { const int o = tid + 512 * u;
        if (o < NOUT) { const int pp = o / (s * s), r = (o / s) % s, c = o % s; const int R0 = 2 * s * pp + s, C0 = 2 * s * pp;
            const LAS float* xr = sX + (R0 + r) * 68 + R0; const LAS float* mc = sM + pp * (s * MS) + c; float acc = 0.f;
#pragma unroll
            for (int k4 = 0; k4 < s / 4; ++k4) { const f32x4 a = *(const LAS f32x4*)(xr + 4 * k4);
                acc += a.x * mc[(4 * k4) * MS] + a.y * mc[(4 * k4 + 1) * MS] + a.z * mc[(4 * k4 + 2) * MS] + a.w * mc[(4 * k4 + 3) * MS]; }
            sX[(R0 + r) * 68 + C0 + c] = -acc; } }
    __syncthreads();
}
DI void tri_inverse(LAS float* sA, LAS float* sX, LAS float* sM, LAS bf16_t* sTi, int tid, int C) {
    for (int i = tid; i < 64 * 17; i += 512) ((LAS f32x4*)sX)[i] = (f32x4){0.f, 0.f, 0.f, 0.f};
    __syncthreads();
    if (tid < 64) { const int blk = tid >> 3, c = tid & 7; const LAS float* ab = sA + (8 * blk) * 68 + 8 * blk; float x[8];
        f32x4 a0[8], a1[8];
#pragma unroll
        for (int r = 1; r < 8; ++r) { a0[r] = *(const LAS f32x4*)(ab + r * 68); a1[r] = *(const LAS f32x4*)(ab + r * 68 + 4); }
#pragma unroll
        for (int r = 0; r < 8; ++r) { float sacc = (r == c) ? 1.f : 0.f;
#pragma unroll
            for (int m = 0; m < r; ++m) sacc -= ((m < 4) ? a0[r][m & 3] : a1[r][m & 3]) * x[m];
            x[r] = sacc; }
#pragma unroll
        for (int r = 0; r < 8; ++r) sX[(8 * blk + r) * 68 + 8 * blk + c] = x[r];
    }
    __syncthreads();
    if (C > 8) tri_level<8>(sA, sX, sM, tid);
    if (C > 16) tri_level<16>(sA, sX, sM, tid);
    if (C > 32) tri_level<32>(sA, sX, sM, tid);
    for (int idx = tid; idx < 64 * 32; idx += 512) { const int i = idx >> 5, j2 = (idx & 31) * 2; *(LAS unsigned*)(sTi + i * 72 + j2) = pk2(sX[i * 68 + j2], sX[i * 68 + j2 + 1]); }
    __syncthreads();
}

DI void dn_item(const Params& p, LAS unsigned char* lds, int b, int h, int dvh, bool prompt) {
    const int tid0 = otid(), w = __builtin_amdgcn_readfirstlane(tid0 >> 6);
    LAS bf16_t* sQ = (LAS bf16_t*)(lds);
    LAS bf16_t* sK = (LAS bf16_t*)(lds + 17408);
    LAS bf16_t* sKT = (LAS bf16_t*)(lds + 34816);
    LAS bf16_t* sV = (LAS bf16_t*)(lds + 53248);
    LAS bf16_t* sST = (LAS bf16_t*)(lds + 62464);
    LAS float* sA = (LAS float*)(lds + 79872);
    LAS bf16_t* sRT = (LAS bf16_t*)(lds + 79872);
    LAS bf16_t* sUT = (LAS bf16_t*)(lds + 79872 + 9216);
    LAS bf16_t* sUdT = (LAS bf16_t*)(lds + 79872 + 18432);
    LAS float* sX = (LAS float*)(lds + 97280);
    LAS float* sM = (LAS float*)(lds + 114688);
    LAS bf16_t* sTi = (LAS bf16_t*)(lds + 119296);
    LAS bf16_t* sAqk = (LAS bf16_t*)(lds + 128512);
    LAS float* sHalo = (LAS float*)(lds + 137728);
    LAS float* sG = (LAS float*)(lds + 145408);
    LAS float* sBeta = (LAS float*)(lds + 145664);
    const int T = prompt ? TP : TS, row0 = prompt ? b * TP : MPR + b * TS;
    const bf16_t* QKV = (const bf16_t*)(p.ws + WS_QKV);
    bf16_t* QKVo = (bf16_t*)(p.ws + WS_QKV);
    const float* GDN = (const float*)(p.ws + WS_GDN); const float* BETA = (const float*)(p.ws + WS_BETA);
    const int aS = w >> 1, tjS = w & 1;
    f32x16 accS;
    {
        const int lane = tid0 & 63, hh = lane >> 5;
        const float* st = p.in[3] + ((size_t)(b * 8 + h) * 128) * 128 + dvh * 64 + 32 * tjS + (lane & 31);
#pragma unroll
        for (int reg = 0; reg < 16; ++reg) accS[reg] = prompt ? 0.f : st[(size_t)(32 * aS + crow(reg, hh)) * 128];
#pragma unroll
        for (int g4 = 0; g4 < 4; ++g4) { u32x2 v; v.x = pk2(accS[4 * g4], accS[4 * g4 + 1]); v.y = pk2(accS[4 * g4 + 2], accS[4 * g4 + 3]);
            *(LAS u32x2*)(sST + (32 * tjS + (lane & 31)) * 136 + 32 * aS + 8 * g4 + 4 * hh) = v; }
    }
    const int run = w;
    for (int idx = tid0; idx < 960; idx += 512) {
        const int j = idx / 320, c = idx - j * 320; const int cgi = c >> 3, e = c & 7;
        int chh; if (cgi < 16) chh = h * 128 + cgi * 8; else if (cgi < 32) chh = 1024 + h * 128 + (cgi - 16) * 8; else chh = 2048 + h * 128 + dvh * 64 + (cgi - 32) * 8;
        sHalo[idx] = prompt ? 0.f : p.in[2][((size_t)b * 3 + j) * QKVW + chh + e];
    }
    __syncthreads();
    int hb = 0;
    const float* cw = p.in[9];
    for (int t0 = 0; t0 < T; t0 += 64) {
        const int C = (T - t0) < 64 ? (T - t0) : 64;
        const int tid = otid(), lane = tid & 63, hh = lane >> 5, cg_ = lane;
        const bool act = cg_ < 40;
        int ch = 0;
        if (cg_ < 16) ch = h * 128 + cg_ * 8; else if (cg_ < 32) ch = 1024 + h * 128 + (cg_ - 16) * 8; else ch = 2048 + h * 128 + dvh * 64 + (cg_ - 32) * 8;
        if (w == 0) { float g = 0.f, be = 0.f; if (lane < C) { g = GDN[(size_t)(row0 + t0 + lane) * 8 + h]; be = BETA[(size_t)(row0 + t0 + lane) * 8 + h]; }
#pragma unroll
            for (int o = 1; o < 64; o <<= 1) { const float v = __shfl_up(g, o); if (lane >= o) g += v; }
            sG[lane] = g; sBeta[lane] = be; }
        float val[8][8];
        const bool mine = act && (run * 8 < C);
        if (mine) {
            float cwv[4][8];
#pragma unroll
            for (int j = 0; j < 4; ++j) { const f32x4 a = *(const f32x4*)(cw + j * QKVW + ch), bq = *(const f32x4*)(cw + j * QKVW + ch + 4);
                cwv[j][0] = a.x; cwv[j][1] = a.y; cwv[j][2] = a.z; cwv[j][3] = a.w; cwv[j][4] = bq.x; cwv[j][5] = bq.y; cwv[j][6] = bq.z; cwv[j][7] = bq.w; }
            float r0[8], r1[8], r2[8], r3[8];
            if (run == 0) {
#pragma unroll
                for (int e = 0; e < 8; ++e) { r0[e] = sHalo[hb * 960 + 0 * 320 + cg_ * 8 + e]; r1[e] = sHalo[hb * 960 + 320 + cg_ * 8 + e]; r2[e] = sHalo[hb * 960 + 640 + cg_ * 8 + e]; }
            } else {
                const bf16_t* bp = QKV + (size_t)(row0 + t0 + run * 8 - 3) * QKVW + ch;
                load8bf(bp, r0); load8bf(bp + QKVW, r1); load8bf(bp + 2 * QKVW, r2);
            }
            const bf16_t* bp = QKV + (size_t)(row0 + t0 + run * 8) * QKVW + ch;
#pragma unroll
            for (int tt = 0; tt < 8; ++tt) {
                load8bf(bp + (size_t)tt * QKVW, r3);
#pragma unroll
                for (int e = 0; e < 8; ++e) { const float x = cwv[0][e] * r0[e] + cwv[1][e] * r1[e] + cwv[2][e] * r2[e] + cwv[3][e] * r3[e]; val[tt][e] = siluf_(x); }
#pragma unroll
                for (int e = 0; e < 8; ++e) { r0[e] = r1[e]; r1[e] = r2[e]; r2[e] = r3[e]; }
            }
            if (run * 8 + 8 == C) {
#pragma unroll
                for (int e = 0; e < 8; ++e) { sHalo[(hb ^ 1) * 960 + cg_ * 8 + e] = r0[e]; sHalo[(hb ^ 1) * 960 + 320 + cg_ * 8 + e] = r1[e]; sHalo[(hb ^ 1) * 960 + 640 + cg_ * 8 + e] = r2[e]; }
            }
        } else {
#pragma unroll
            for (int tt = 0; tt < 8; ++tt)
#pragma unroll
                for (int e = 0; e < 8; ++e) val[tt][e] = 0.f;
        }
#pragma unroll
        for (int tt = 0; tt < 8; ++tt) {
            float ss = 0.f;
#pragma unroll
            for (int e = 0; e < 8; ++e) ss += val[tt][e] * val[tt][e];
            ss += __shfl_xor(ss, 1); ss += __shfl_xor(ss, 2); ss += __shfl_xor(ss, 4); ss += __shfl_xor(ss, 8);
            float sc = 1.f;
            if (cg_ < 32) { sc = rsqrtf_(ss + 1e-6f); if (cg_ < 16) sc *= 0.08838834764831845f; }
#pragma unroll
            for (int e = 0; e < 8; ++e) val[tt][e] *= sc;
        }
        if (act) {
            if (cg_ < 16) {
#pragma unroll
                for (int tt = 0; tt < 8; ++tt) *(LAS u32x4*)(sQ + (run * 8 + tt) * 136 + cg_ * 8) = pack8(val[tt]);
            } else if (cg_ < 32) {
#pragma unroll
                for (int tt = 0; tt < 8; ++tt) *(LAS u32x4*)(sK + (run * 8 + tt) * 136 + (cg_ - 16) * 8) = pack8(val[tt]);
#pragma unroll
                for (int e = 0; e < 8; ++e) { float col[8];
#pragma unroll
                    for (int tt = 0; tt < 8; ++tt) col[tt] = val[tt][e];
                    *(LAS u32x4*)(sKT + ((cg_ - 16) * 8 + e) * 72 + run * 8) = pack8(col); }
            } else {
#pragma unroll
                for (int tt = 0; tt < 8; ++tt) *(LAS u32x4*)(sV + (run * 8 + tt) * 72 + (cg_ - 32) * 8) = pack8(val[tt]);
            }
        }
        hb ^= 1;
        __syncthreads();
        {
            const int type = w >> 2, ti = (w >> 1) & 1, tj = w & 1;
            f32x16 acc;
#pragma unroll
            for (int reg = 0; reg < 16; ++reg) acc[reg] = 0.f;
            if (!(ti == 0 && tj == 1)) mma32<8>(acc, sK + 32 * tj * 136, 136, (type ? sQ : sK) + 32 * ti * 136, 136, lane);
            const int i = 32 * ti + (lane & 31); const float Gi = sG[i], bi = sBeta[i];
#pragma unroll
            for (int g4 = 0; g4 < 4; ++g4) { const int j0 = 32 * tj + 8 * g4 + 4 * hh; float o4[4];
#pragma unroll
                for (int e = 0; e < 4; ++e) { const int j = j0 + e; const float dec = __expf(fminf(Gi - sG[j], 0.f));
                    o4[e] = (type == 0) ? ((i > j) ? bi * acc[4 * g4 + e] * dec : 0.f) : ((i >= j) ? acc[4 * g4 + e] * dec : 0.f); }
                if (type == 0) *(LAS f32x4*)(sA + i * 68 + j0) = (f32x4){o4[0], o4[1], o4[2], o4[3]};
                else { u32x2 v; v.x = pk2(o4[0], o4[1]); v.y = pk2(o4[2], o4[3]); *(LAS u32x2*)(sAqk + i * 72 + j0) = v; } }
        }
        __syncthreads();
        tri_inverse(sA, sX, sM, sTi, tid, C);
        f32x16 accO;
        {
            const int ti = (w >> 1) & 1, tj = w & 1;
            f32x16 acc;
#pragma unroll
            for (int reg = 0; reg < 16; ++reg) acc[reg] = 0.f;
            mma32<8>(acc, ((w < 4) ? sK : sQ) + 32 * ti * 136, 136, sST + 32 * tj * 136, 136, lane);
            const int j = 32 * tj + (lane & 31);
            if (w < 4) {
#pragma unroll
                for (int g4 = 0; g4 < 4; ++g4) { float rr[4];
#pragma unroll
                    for (int e = 0; e < 4; ++e) { const int i = 32 * ti + 8 * g4 + 4 * hh + e; rr[e] = sBeta[i] * (bflo((unsigned)sV[i * 72 + j]) - __expf(sG[i]) * acc[4 * g4 + e]); }
                    u32x2 v; v.x = pk2(rr[0], rr[1]); v.y = pk2(rr[2], rr[3]);
                    *(LAS u32x2*)(sRT + j * 72 + 32 * ti + 8 * g4 + 4 * hh) = v; }
            } else {
#pragma unroll
                for (int reg = 0; reg < 16; ++reg) { const int i = 32 * ti + crow(reg, hh); accO[reg] = __expf(sG[i]) * acc[reg]; }
            }
        }
        __syncthreads();
        if (w < 4) {
            const int ti = (w >> 1) & 1, tj = w & 1;
            f32x16 acc;
#pragma unroll
            for (int reg = 0; reg < 16; ++reg) acc[reg] = 0.f;
            mma32<4>(acc, sTi + 32 * ti * 72, 72, sRT + 32 * tj * 72, 72, lane);
            const int j = 32 * tj + (lane & 31); const float Gl = sG[63];
#pragma unroll
            for (int g4 = 0; g4 < 4; ++g4) { float d[4];
#pragma unroll
                for (int e = 0; e < 4; ++e) { const int i = 32 * ti + 8 * g4 + 4 * hh + e; d[e] = acc[4 * g4 + e] * __expf(Gl - sG[i]); }
                u32x2 v; v.x = pk2(acc[4 * g4], acc[4 * g4 + 1]); v.y = pk2(acc[4 * g4 + 2], acc[4 * g4 + 3]);
                u32x2 vd; vd.x = pk2(d[0], d[1]); vd.y = pk2(d[2], d[3]);
                *(LAS u32x2*)(sUT + j * 72 + 32 * ti + 8 * g4 + 4 * hh) = v;
                *(LAS u32x2*)(sUdT + j * 72 + 32 * ti + 8 * g4 + 4 * hh) = vd; }
        }
        __syncthreads();
        if (w >= 4) {
            const int ti = (w >> 1) & 1, tj = w & 1;
            mma32<4>(accO, sAqk + 32 * ti * 72, 72, sUT + 32 * tj * 72, 72, lane);
            bf16_t* ob = QKVo + (size_t)(row0 + t0) * QKVW + 2048 + h * 128 + dvh * 64 + 32 * tj + (lane & 31);
#pragma unroll
            for (int reg = 0; reg < 16; ++reg) { const int i = 32 * ti + crow(reg, hh); if (i < C) ob[(size_t)i * QKVW] = (bf16_t)f2bf(accO[reg]); }
        }
        {
            const float gl = __expf(sG[63]);
#pragma unroll
            for (int reg = 0; reg < 16; ++reg) accS[reg] *= gl;
            mma32<4>(accS, sKT + 32 * aS * 72, 72, sUdT + 32 * tjS * 72, 72, lane);
#pragma unroll
            for (int g4 = 0; g4 < 4; ++g4) { u32x2 v; v.x = pk2(accS[4 * g4], accS[4 * g4 + 1]); v.y = pk2(accS[4 * g4 + 2], accS[4 * g4 + 3]);
                *(LAS u32x2*)(sST + (32 * tjS + (lane & 31)) * 136 + 32 * aS + 8 * g4 + 4 * hh) = v; }
        }
        __syncthreads();
    }
    {
        const int tid = otid(), lane = tid & 63, hh = lane >> 5;
        float* so = p.out + (prompt ? O_DNP : O_DNS) + ((size_t)(b * 8 + h) * 128) * 128 + dvh * 64 + 32 * tjS + (lane & 31);
#pragma unroll
        for (int reg = 0; reg < 16; ++reg) so[(size_t)(32 * aS + crow(reg, hh)) * 128] = accS[reg];
    }
    float* co = p.out + (prompt ? O_CONVP : O_CONVS) + (size_t)b * 3 * QKVW;
    for (int idx = otid(); idx < 960; idx += 512) {
        const int j = idx / 320, c = idx - j * 320; const int cgi = c >> 3, e = c & 7;
        if (cgi < 32 && dvh != 0) continue;
        int chh; if (cgi < 16) chh = h * 128 + cgi * 8; else if (cgi < 32) chh = 1024 + h * 128 + (cgi - 16) * 8; else chh = 2048 + h * 128 + dvh * 64 + (cgi - 32) * 8;
        co[(size_t)j * QKVW + chh + e] = sHalo[hb * 960 + idx];
    }
    __syncthreads();
}

DI void rw_item(const Params& p, LAS unsigned char* lds, int b, int h, bool prompt) {
    const int tid0 = otid(), w = __builtin_amdgcn_readfirstlane(tid0 >> 6);
    LAS bf16_t* sAt = (LAS bf16_t*)(lds);
    LAS bf16_t* sRt = (LAS bf16_t*)(lds + 9216);
    LAS bf16_t* sKt = (LAS bf16_t*)(lds + 18432);
    LAS bf16_t* sRT = sKt;
    LAS bf16_t* sBt = (LAS bf16_t*)(lds + 27648);
    LAS bf16_t* sYT = sBt;
    LAS bf16_t* sW2T = (LAS bf16_t*)(lds + 36864);
    LAS bf16_t* sKdT = (LAS bf16_t*)(lds + 128000);
    LAS bf16_t* sA2T = (LAS bf16_t*)(lds + 46080);
    LAS bf16_t* sNBdT = (LAS bf16_t*)(lds + 137216);
    LAS bf16_t* sVT = (LAS bf16_t*)(lds + 55296);
    LAS bf16_t* sAak = (LAS bf16_t*)(lds + 64512);
    LAS bf16_t* sArk = (LAS bf16_t*)(lds + 73728);
    LAS bf16_t* sNArb = (LAS bf16_t*)(lds + 82944);
    LAS bf16_t* sTi = (LAS bf16_t*)(lds + 92160);
    LAS bf16_t* sST = (LAS bf16_t*)(lds + 101376);
    LAS float* sA = (LAS float*)(lds + 110592);
    LAS float* sO = sA; LAS float* sLw = sA;
    LAS bf16_t* sTWb = sAak; LAS bf16_t* sALb = sArk;
    LAS float* sX = (LAS float*)(lds + 128000);
    LAS float* sLa = sX; LAS float* sL = sX;
    LAS float* sM = (LAS float*)(lds + 145408);
    LAS float* sPrev = (LAS float*)(lds + 150016);
    LAS float* sPC = (LAS float*)(lds + 153600);
    LAS float* sBonus = (LAS float*)(lds + 153856);
    const int T = prompt ? TP : TS, row0 = prompt ? b * TP : MPR + b * TS;
    bf16_t* RW = (bf16_t*)(p.ws + WS_RW);
    const float* mu = p.in[13];
    const int aS = (w >> 1) & 1, tjS = w & 1;
    f32x16 accH;
    {
        const int lane = tid0 & 63, hh = lane >> 5;
        const float* st = p.in[5] + ((size_t)(b * 16 + h) * 64 + 32 * tjS + (lane & 31)) * 64 + 32 * aS;
#pragma unroll
        for (int reg = 0; reg < 16; ++reg) accH[reg] = (prompt || w >= 4) ? 0.f : st[crow(reg, hh)];
        if (w < 4) {
#pragma unroll
            for (int g4 = 0; g4 < 4; ++g4) { u32x2 v; v.x = pk2(accH[4 * g4], accH[4 * g4 + 1]); v.y = pk2(accH[4 * g4 + 2], accH[4 * g4 + 3]);
                *(LAS u32x2*)(sST + (32 * tjS + (lane & 31)) * 72 + 32 * aS + 8 * g4 + 4 * hh) = v; }
        }
    }
    for (int idx = tid0; idx < 4096; idx += 512) { const int j = idx >> 6, c = idx & 63;
        sW2T[c * 72 + j] = (bf16_t)f2bf(p.in[15][(size_t)j * 1024 + h * 64 + c]); sA2T[c * 72 + j] = (bf16_t)f2bf(p.in[17][(size_t)j * 1024 + h * 64 + c]); }
    for (int i = tid0; i < 448; i += 512) {
        int col; if (i < 64) col = h * 64 + i; else if (i < 128) col = 1024 + h * 64 + (i - 64); else if (i < 192) col = 2048 + h * 64 + (i - 128); else col = 3072 + (i - 192);
        sPrev[i] = prompt ? 0.f : p.in[4][(size_t)b * RWW + col];
    }
    __syncthreads();
    int pb = 0;
    for (int t0 = 0; t0 < T; t0 += 64) {
        const int C = (T - t0) < 64 ? (T - t0) : 64;
        const int tid = otid(), lane = tid & 63, hh = lane >> 5;
        const int t = tid >> 3, part = tid & 7;
        const int cb[5] = {h * 64 + 8 * part, 1024 + h * 64 + 8 * part, 2048 + h * 64 + 8 * part, 3072 + 8 * part, 3136 + 8 * part};
        const bool actv = t < C;
        const size_t row = (size_t)(row0 + t0 + t);
        float xr[8], kr[8], vv[8];
        float gsig[16];
#pragma unroll
        for (int e = 0; e < 8; ++e) { xr[e] = 0.f; kr[e] = 0.f; vv[e] = 0.f; }
        if (actv) {
#pragma unroll
            for (int s = 0; s < 5; ++s) {
                float cur[8], prv[8];
                load8bf(RW + row * RWW + cb[s], cur);
                if (t > 0) load8bf(RW + (row - 1) * RWW + cb[s], prv);
                else {
#pragma unroll
                    for (int e = 0; e < 8; ++e) prv[e] = sPrev[pb * 448 + s * 64 + 8 * part + e];
                }
                if (t == C - 1) {
#pragma unroll
                    for (int e = 0; e < 8; ++e) sPrev[(pb ^ 1) * 448 + s * 64 + 8 * part + e] = cur[e];
                }
                const f32x4 m0 = *(const f32x4*)(mu + cb[s]), m1 = *(const f32x4*)(mu + cb[s] + 4);
                const float mm[8] = {m0.x, m0.y, m0.z, m0.w, m1.x, m1.y, m1.z, m1.w};
                float xm[8];
#pragma unroll
                for (int e = 0; e < 8; ++e) xm[e] = cur[e] + (prv[e] - cur[e]) * mm[e];
                if (s == 0) {
#pragma unroll
                    for (int e = 0; e < 8; ++e) xr[e] = xm[e];
                } else if (s == 1) {
#pragma unroll
                    for (int e = 0; e < 8; ++e) kr[e] = xm[e];
                } else if (s == 2) {
#pragma unroll
                    for (int e = 0; e < 8; ++e) vv[e] = xm[e];
                } else if (s == 3) {
#pragma unroll
                    for (int e = 0; e < 8; ++e) xm[e] = tanhf_(xm[e]);
                    *(LAS u32x4*)(sTWb + t * 72 + 8 * part) = pack8(xm);
                } else {
                    *(LAS u32x4*)(sALb + t * 72 + 8 * part) = pack8(xm);
                }
            }
            if (h == 0) {
#pragma unroll
                for (int q = 0; q < 2; ++q) {
                    const int c0 = 3200 + 16 * part + 8 * q;
                    float cur[8], prv[8];
                    load8bf(RW + row * RWW + c0, cur);
                    if (t > 0) load8bf(RW + (row - 1) * RWW + c0, prv);
                    else {
#pragma unroll
                        for (int e = 0; e < 8; ++e) prv[e] = sPrev[pb * 448 + 320 + 16 * part + 8 * q + e];
                    }
                    if (t == C - 1) {
#pragma unroll
                        for (int e = 0; e < 8; ++e) sPrev[(pb ^ 1) * 448 + 320 + 16 * part + 8 * q + e] = cur[e];
                    }
                    const f32x4 m0 = *(const f32x4*)(mu + c0), m1 = *(const f32x4*)(mu + c0 + 4);
                    const float mm[8] = {m0.x, m0.y, m0.z, m0.w, m1.x, m1.y, m1.z, m1.w};
#pragma unroll
                    for (int e = 0; e < 8; ++e) gsig[8 * q + e] = sigmoidf_(cur[e] + (prv[e] - cur[e]) * mm[e]);
                }
            }
        }
        if (!actv) { const u32x4 z = (u32x4){0u, 0u, 0u, 0u}; *(LAS u32x4*)(sTWb + t * 72 + 8 * part) = z; *(LAS u32x4*)(sALb + t * 72 + 8 * part) = z; }
        __syncthreads();
        {
            const int mat = w >> 2, ti = (w >> 1) & 1, tj = w & 1;
            f32x16 acc;
#pragma unroll
            for (int reg = 0; reg < 16; ++reg) acc[reg] = 0.f;
            mma32<4>(acc, (mat ? sALb : sTWb) + 32 * ti * 72, 72, (mat ? sA2T : sW2T) + 32 * tj * 72, 72, lane);
            LAS float* dstl = mat ? sLa : sLw; const int j = 32 * tj + (lane & 31);
#pragma unroll
            for (int reg = 0; reg < 16; ++reg) dstl[(32 * ti + crow(reg, hh)) * 65 + j] = acc[reg];
        }
        if (actv && h == 0) {
            *(u32x4*)(RW + row * RWW + 3200 + 16 * part) = pack8(gsig);
            *(u32x4*)(RW + row * RWW + 3200 + 16 * part + 8) = pack8(gsig + 8);
        }
        __syncthreads();
        float lw[8], kk[8], bb[8], kn[8]; float bonus = 0.f;
        {
            float n2 = 0.f, a_[8], kkr[8];
            if (actv) {
                float ws_[8], as_[8];
#pragma unroll
                for (int e = 0; e < 8; ++e) { ws_[e] = sLw[t * 65 + 8 * part + e]; as_[e] = sLa[t * 65 + 8 * part + e]; }
                const int c0 = h * 64 + 8 * part;
#pragma unroll
                for (int e = 0; e < 8; ++e) {
                    const float wl = -softplusf_(-(p.in[14][c0 + e] + ws_[e])) - 0.5f;
                    lw[e] = -__expf(wl);
                    a_[e] = sigmoidf_(p.in[16][c0 + e] + as_[e]);
                    kkr[e] = kr[e] * p.in[19][c0 + e]; n2 += kkr[e] * kkr[e];
                    kn[e] = kr[e] * (1.f + (a_[e] - 1.f) * p.in[20][c0 + e]);
                    bonus += xr[e] * kn[e] * p.in[21][c0 + e];
                }
            } else {
#pragma unroll
                for (int e = 0; e < 8; ++e) { lw[e] = 0.f; a_[e] = 0.f; kkr[e] = 0.f; kn[e] = 0.f; }
            }
            n2 += __shfl_xor(n2, 1); n2 += __shfl_xor(n2, 2); n2 += __shfl_xor(n2, 4);
            bonus += __shfl_xor(bonus, 1); bonus += __shfl_xor(bonus, 2); bonus += __shfl_xor(bonus, 4);
            const float rn = rsqrtf_(n2 + 1e-6f);
#pragma unroll
            for (int e = 0; e < 8; ++e) { kk[e] = kkr[e] * rn; bb[e] = kk[e] * a_[e]; }
        }
#pragma unroll
        for (int e = 0; e < 8; ++e) sL[t * 65 + 8 * part + e] = lw[e];
        __syncthreads();
        {
            float x[8];
#pragma unroll
            for (int e = 0; e < 8; ++e) x[e] = sL[lane * 65 + 8 * w + e];
#pragma unroll
            for (int o = 1; o < 64; o <<= 1) {
#pragma unroll
                for (int e = 0; e < 8; ++e) { const float v = __shfl_up(x[e], o); if (lane >= o) x[e] += v; }
            }
#pragma unroll
            for (int e = 0; e < 8; ++e) sL[lane * 65 + 8 * w + e] = x[e];
        }
        __syncthreads();
        float kd[8], nbd[8];
        {
            float at[8], rt[8], kt[8], bt[8];
#pragma unroll
            for (int e = 0; e < 8; ++e) {
                const int c = 8 * part + e;
                const float Lt = sL[t * 65 + c], Lp = (t > 0) ? sL[(t - 1) * 65 + c] : 0.f, Lc = sL[63 * 65 + c];
                const float ep = __expf(Lp), et = __expf(Lt), ei = __expf(-Lt), ec = __expf(Lc - Lt);
                at[e] = kk[e] * ep; rt[e] = xr[e] * et; kt[e] = kn[e] * ei; bt[e] = bb[e] * ei;
                kd[e] = kn[e] * ec; nbd[e] = -bb[e] * ec; sVT[c * 72 + t] = (bf16_t)f2bf(vv[e]);
                if (t == 0) sPC[c] = __expf(Lc);
            }
            *(LAS u32x4*)(sAt + t * 72 + 8 * part) = pack8(at); *(LAS u32x4*)(sRt + t * 72 + 8 * part) = pack8(rt);
            *(LAS u32x4*)(sKt + t * 72 + 8 * part) = pack8(kt); *(LAS u32x4*)(sBt + t * 72 + 8 * part) = pack8(bt);
            if (part == 0) sBonus[t] = bonus;
        }
        pb ^= 1;
        __syncthreads();
        {
            const int m = w >> 1, q = w & 1;
            const LAS bf16_t* Aop = (m < 2) ? sAt : sRt; const LAS bf16_t* Bop = (m == 0 || m == 3) ? sBt : sKt;
            LAS bf16_t* dst = (m == 1) ? sAak : (m == 2 ? sArk : sNArb);
#pragma unroll
            for (int rep = 0; rep < 2; ++rep) {
                int ti, tj; bool zero = false;
                if (q == 0) { ti = rep; tj = rep; } else { ti = 1 - rep; tj = rep; if (rep == 1) { ti = 0; tj = 1; zero = true; } }
                f32x16 acc;
#pragma unroll
                for (int reg = 0; reg < 16; ++reg) acc[reg] = 0.f;
                if (!zero) mma32<4>(acc, Bop + 32 * tj * 72, 72, Aop + 32 * ti * 72, 72, lane);
                const int i = 32 * ti + (lane & 31);
#pragma unroll
                for (int g4 = 0; g4 < 4; ++g4) { const int j0 = 32 * tj + 8 * g4 + 4 * hh; float o4[4];
#pragma unroll
                    for (int e = 0; e < 4; ++e) { const int j = j0 + e; const float a = acc[4 * g4 + e];
                        o4[e] = (m < 2) ? ((i > j) ? a : 0.f) : ((i >= j) ? (m == 2 ? a : -a) : 0.f); }
                    if (m == 0) { if (!zero) *(LAS f32x4*)(sA + i * 68 + j0) = (f32x4){o4[0], o4[1], o4[2], o4[3]}; }
                    else { u32x2 v; v.x = pk2(o4[0], o4[1]); v.y = pk2(o4[2], o4[3]); *(LAS u32x2*)(dst + i * 72 + j0) = v; } }
            }
        }
        __syncthreads();
        tri_inverse(sA, sX, sM, sTi, tid, C);
#pragma unroll
        for (int e = 0; e < 8; ++e) { const int c = 8 * part + e; sKdT[c * 72 + t] = (bf16_t)f2bf(kd[e]); sNBdT[c * 72 + t] = (bf16_t)f2bf(nbd[e]); }
        f32x16 accO;
        {
            const int ti = (w >> 1) & 1, tj = w & 1;
            f32x16 acc;
#pragma unroll
            for (int reg = 0; reg < 16; ++reg) acc[reg] = 0.f;
            mma32<4>(acc, ((w < 4) ? sAt : sRt) + 32 * ti * 72, 72, sST + 32 * tj * 72, 72, lane);
            mma32<4>(acc, ((w < 4) ? sAak : sArk) + 32 * ti * 72, 72, sVT + 32 * tj * 72, 72, lane);
            __syncthreads();
            if (w < 4) {
                const int j = 32 * tj + (lane & 31);
#pragma unroll
                for (int g4 = 0; g4 < 4; ++g4) { u32x2 v; v.x = pk2(acc[4 * g4], acc[4 * g4 + 1]); v.y = pk2(acc[4 * g4 + 2], acc[4 * g4 + 3]);
                    *(LAS u32x2*)(sRT + j * 72 + 32 * ti + 8 * g4 + 4 * hh) = v; }
            } else accO = acc;
        }
        __syncthreads();
        if (w < 4) {
            const int ti = (w >> 1) & 1, tj = w & 1;
            f32x16 acc;
#pragma unroll
            for (int reg = 0; reg < 16; ++reg) acc[reg] = 0.f;
            mma32<4>(acc, sTi + 32 * ti * 72, 72, sRT + 32 * tj * 72, 72, lane);
            const int j = 32 * tj + (lane & 31);
#pragma unroll
            for (int g4 = 0; g4 < 4; ++g4) { u32x2 v; v.x = pk2(acc[4 * g4], acc[4 * g4 + 1]); v.y = pk2(acc[4 * g4 + 2], acc[4 * g4 + 3]);
                *(LAS u32x2*)(sYT + j * 72 + 32 * ti + 8 * g4 + 4 * hh) = v; }
        }
        __syncthreads();
        if (w >= 4) {
            const int ti = (w >> 1) & 1, tj = w & 1;
            mma32<4>(accO, sNArb + 32 * ti * 72, 72, sYT + 32 * tj * 72, 72, lane);
            const int j = 32 * tj + (lane & 31);
#pragma unroll
            for (int reg = 0; reg < 16; ++reg) sO[(32 * ti + crow(reg, hh)) * 65 + j] = accO[reg];
        } else {
#pragma unroll
            for (int reg = 0; reg < 16; ++reg) accH[reg] *= sPC[32 * aS + crow(reg, hh)];
            mma32<4>(accH, sKdT + 32 * aS * 72, 72, sVT + 32 * tjS * 72, 72, lane);
            mma32<4>(accH, sNBdT + 32 * aS * 72, 72, sYT + 32 * tjS * 72, 72, lane);
#pragma unroll
            for (int g4 = 0; g4 < 4; ++g4) { u32x2 v; v.x = pk2(accH[4 * g4], accH[4 * g4 + 1]); v.y = pk2(accH[4 * g4 + 2], accH[4 * g4 + 3]);
                *(LAS u32x2*)(sST + (32 * tjS + (lane & 31)) * 72 + 32 * aS + 8 * g4 + 4 * hh) = v; }
        }
        __syncthreads();
        {
            float o[8]; float sm = 0.f;
#pragma unroll
            for (int e = 0; e < 8; ++e) { o[e] = actv ? sO[t * 65 + 8 * part + e] : 0.f; sm += o[e]; }
            sm += __shfl_xor(sm, 1); sm += __shfl_xor(sm, 2); sm += __shfl_xor(sm, 4);
            const float mean = sm * (1.f / 64.f); float vs = 0.f;
#pragma unroll
            for (int e = 0; e < 8; ++e) { o[e] -= mean; vs += o[e] * o[e]; }
            vs += __shfl_xor(vs, 1); vs += __shfl_xor(vs, 2); vs += __shfl_xor(vs, 4);
            const float rs = rsqrtf_(vs * (1.f / 64.f) + 64e-5f);
            if (actv) { const int c0 = h * 64 + 8 * part; const float bo = sBonus[t]; float y[8];
#pragma unroll
                for (int e = 0; e < 8; ++e) y[e] = o[e] * rs * p.in[22][c0 + e] + p.in[23][c0 + e] + bo * vv[e];
                *(u32x4*)(RW + row * RWW + 2048 + c0) = pack8(y); }
        }
        __syncthreads();
    }
    if (w < 4) {
        const int tid = otid(), lane = tid & 63, hh = lane >> 5;
        float* so = p.out + (prompt ? O_RWP : O_RWS) + ((size_t)(b * 16 + h) * 64 + 32 * tjS + (lane & 31)) * 64 + 32 * aS;
#pragma unroll
        for (int reg = 0; reg < 16; ++reg) so[crow(reg, hh)] = accH[reg];
    }
    float* sh = p.out + (prompt ? O_SHIFTP : O_SHIFTS) + (size_t)b * RWW;
    for (int i = otid(); i < 448; i += 512) {
        if (i >= 192 && h != 0) continue;
        int col; if (i < 64) col = h * 64 + i; else if (i < 128) col = 1024 + h * 64 + (i - 64); else if (i < 192) col = 2048 + h * 64 + (i - 128); else col = 3072 + (i - 192);
        sh[col] = sPrev[pb * 448 + i];
    }
    __syncthreads();
}

DI void phase_scan(const Params& p, LAS unsigned char* lds) {
    unsigned* ctr = (unsigned*)(p.ws + WS_CTL);
    LAS int* sItem = (LAS int*)(lds + LDS_BYTES - 16);
    for (;;) {
        if (threadIdx.x == 0) *sItem = (int)atomicAdd(ctr, 1u);
        __syncthreads();
        const int item = __builtin_amdgcn_readfirstlane(*sItem);
        __syncthreads();
        if (item >= 4352) break;
        bool prompt; int typ, j;
        if (item < 128) { typ = 0; j = item; prompt = true; } else if (item < 256) { typ = 1; j = item - 128; prompt = true; }
        else if (item < 2304) { typ = 0; j = item - 256; prompt = false; } else { typ = 1; j = item - 2304; prompt = false; }
        if (typ == 0) dn_item(p, lds, j >> 4, (j >> 1) & 7, j & 1, prompt);
        else rw_item(p, lds, j >> 4, j & 15, prompt);
    }
}

DI void phase_merge(const Params& p) {
    const bf16_t* QKV = (const bf16_t*)(p.ws + WS_QKV); const bf16_t* RW = (const bf16_t*)(p.ws + WS_RW);
    bf16_t* MIX = (bf16_t*)((unsigned char*)p.out + DO_H);
    const int gt = blockIdx.x * 512 + otid(), NT = gridDim.x * 512;
    for (int u = gt; u < M * 128; u += NT) {
        const int row = u >> 7, c = (u & 127) * 8;
        float o[8], z[8], ga[8], gb[8], orw[8], gate[8];
        load8bf(QKV + (size_t)row * QKVW + 2048 + c, o); load8bf(QKV + (size_t)row * QKVW + c, z); load8bf(QKV + (size_t)row * QKVW + 1024 + c, ga);
        load8bf(RW + (size_t)row * RWW + c, gb); load8bf(RW + (size_t)row * RWW + 2048 + c, orw); load8bf(RW + (size_t)row * RWW + 1024 + c, gate);
        float ss = 0.f;
#pragma unroll
        for (int e = 0; e < 8; ++e) ss += o[e] * o[e];
        ss += __shfl_xor(ss, 1); ss += __shfl_xor(ss, 2); ss += __shfl_xor(ss, 4); ss += __shfl_xor(ss, 8);
        const float rs = rsqrtf_(ss * (1.f / 128.f) + 1e-6f);
        float mix[8];
#pragma unroll
        for (int e = 0; e < 8; ++e) { const float odn = o[e] * rs * p.in[12][(c & 127) + e] * siluf_(z[e]); mix[e] = sigmoidf_(ga[e]) * odn + sigmoidf_(gb[e]) * (orw[e] * gate[e]); }
        *(u32x4*)(MIX + (size_t)row * D + c) = pack8(mix);
    }
}
DI void phase_norm2(const Params& p) {
    const int tid_ = otid(); const int lane = tid_ & 63, gw = blockIdx.x * 8 + (tid_ >> 6), NGW = gridDim.x * 8;
    const float* X1 = (const float*)(p.ws + WS_X1); bf16_t* H = (bf16_t*)((unsigned char*)p.out + DO_H);
    for (int m = gw; m < M; m += NGW) { f32x4 v[4]; rms_row(X1 + (size_t)m * D, p.in[25], H + (size_t)m * D, lane, v); }
}
DI void phase_final(const Params& p) {
    const int tid_ = otid(); const int lane = tid_ & 63, gw = blockIdx.x * 8 + (tid_ >> 6), NGW = gridDim.x * 8;
    const float* X1 = (const float*)(p.ws + WS_X1);
    for (int m = gw; m < M; m += NGW) {
        float* orow;
        if (m < MPR) { const int b = m / TP, t = m - b * TP; if (t < 16) continue; orow = p.out + O_YP + ((size_t)b * 2048 + (t - 16)) * D; }
        else orow = p.out + O_YS + (size_t)(m - MPR) * D;
        f32x4 v[4]; rms_row(X1 + (size_t)m * D, p.in[28], nullptr, lane, v);
#pragma unroll
        for (int j = 0; j < 4; ++j) *(f32x4*)(orow + 4 * lane + 256 * j) = v[j];
    }
}


DI void grid_bar(unsigned* ctr, unsigned target) {
    asm volatile("s_waitcnt vmcnt(0)" ::: "memory");
    __syncthreads();
    if (threadIdx.x == 0) {
        __builtin_amdgcn_fence(__ATOMIC_RELEASE, "agent");
        asm volatile("s_waitcnt vmcnt(0)" ::: "memory");
        __hip_atomic_fetch_add(ctr, 1u, __ATOMIC_RELAXED, __HIP_MEMORY_SCOPE_AGENT);
        while (__hip_atomic_load(ctr, __ATOMIC_RELAXED, __HIP_MEMORY_SCOPE_AGENT) < target) __builtin_amdgcn_s_sleep(2);
        __builtin_amdgcn_fence(__ATOMIC_ACQUIRE, "agent");
        asm volatile("s_waitcnt vmcnt(0)" ::: "memory");
    }
    __syncthreads();
}
__global__ void __launch_bounds__(512, 2) fwd_megakernel(Params p) {
    extern __shared__ __attribute__((aligned(16))) unsigned char lds_raw[];
    LAS unsigned char* lds = (LAS unsigned char*)lds_raw;
    cg::grid_group grid = cg::this_grid();
    const int G = gridDim.x, c = blockIdx.x;
    bf16_t* H = (bf16_t*)((unsigned char*)p.out + DO_H);
    bf16_t* WIN = (bf16_t*)((unsigned char*)p.out + DO_WIN);
    bf16_t* QKV = (bf16_t*)(p.ws + WS_QKV); bf16_t* RW = (bf16_t*)(p.ws + WS_RW);
    float* X1 = (float*)(p.ws + WS_X1); bf16_t* ACT = (bf16_t*)(p.ws + WS_ACT);

    unsigned* gctr = (unsigned*)(p.ws + WS_CTL) + 64;
    grid.sync();
    phase0(p, lds);
    grid_bar(gctr, 1u * (unsigned)G);
    {
        pg8::Gemm g{H, D, WIN, MP, N1A, D}; pg8::StaticOrder S; S.init(MP, N1A, G, c);
        pg8::EpiSeg<0> E{QKV, QKVW, 3072, RW, RWW};
        pg8::gemm_phase<1024, 1024>(lds, g, S, E);
    }
    grid_bar(gctr, 2u * (unsigned)G);
    phase_scan(p, lds);
    grid_bar(gctr, 3u * (unsigned)G);
    {
        pg8::Gemm g{H, D, WIN + (size_t)N1A * D, MP, N1B, D}; pg8::StaticOrder S; S.init(MP, N1B, G, c);
        pg8::EpiSeg<0> E{QKV, QKVW, 2048, RW, RWW};
        pg8::gemm_phase<1024, 1024>(lds, g, S, E);
        pg8::Gemm g2{RW + 3200, RWW, (const bf16_t*)(p.ws + WS_WG2), MP, 1024, 128}; pg8::StaticOrder S2; S2.init(MP, 1024, G, c);
        pg8::EpiSeg<0> E2{RW + 1024, RWW, 1 << 30, RW, RWW};
        pg8::gemm_phase<128, 3328>(lds, g2, S2, E2);
    }
    grid_bar(gctr, 4u * (unsigned)G);
    phase_merge(p);
    grid_bar(gctr, 5u * (unsigned)G);
    {
        pg8::Gemm g{H, D, (const bf16_t*)(p.ws + WS_WOUT), MP, D, D}; pg8::StaticOrder S; S.init(MP, D, G, c);
        pg8::EpiRes<0> E{X1, p.in[0], p.in[1], p.in[6]};
        pg8::gemm_phase<1024, 1024>(lds, g, S, E);
    }
    grid_bar(gctr, 6u * (unsigned)G);
    phase_norm2(p);
    grid_bar(gctr, 7u * (unsigned)G);
    {
        pg8::Gemm g{H, D, (const bf16_t*)(p.ws + WS_WFF1), MP, FF, D}; pg8::StaticOrder S; S.init(MP, FF, G, c);
        pg8::EpiSeg<1> E{ACT, FF, 1 << 30, ACT, FF};
        pg8::gemm_phase<1024, 1024>(lds, g, S, E);
    }
    grid_bar(gctr, 8u * (unsigned)G);
    {
        pg8::Gemm g{ACT, FF, (const bf16_t*)(p.ws + WS_WFF2), MP, D, FF}; pg8::StaticOrder S; S.init(MP, D, G, c);
        pg8::EpiRes<1> E{X1, nullptr, nullptr, nullptr};
        pg8::gemm_phase<4096, 4096>(lds, g, S, E);
    }
    grid_bar(gctr, 9u * (unsigned)G);
    phase_final(p);
}

extern "C" void kernel_launch(void* const* d_in, const int* in_sizes, int n_in, void* d_out, int out_size, void* d_ws, size_t ws_size, hipStream_t stream) {
    static int grid = 0;
    if (grid == 0) {
        int dev = 0, cus = 0, per_cu = 0;
        hipGetDevice(&dev);
        hipDeviceGetAttribute(&cus, hipDeviceAttributeMultiprocessorCount, dev);
        if (hipFuncSetAttribute((const void*)fwd_megakernel, hipFuncAttributeMaxDynamicSharedMemorySize, LDS_BYTES) != hipSuccess) fprintf(stderr, "hipFuncSetAttribute failed\n");
        hipOccupancyMaxActiveBlocksPerMultiprocessor(&per_cu, (const void*)fwd_megakernel, 512, LDS_BYTES);
        if (per_cu < 1) { fprintf(stderr, "occupancy query says %d blocks per CU\n", per_cu); per_cu = 1; }
        grid = cus;
        if (n_in != 29 || ws_size < 256 * MiB) fprintf(stderr, "unexpected n_in %d / ws %zu\n", n_in, ws_size);
    }
    hipMemsetAsync((char*)d_ws + WS_CTL, 0, 4096, stream);
    Params p{};
    for (int i = 0; i < 29; ++i) p.in[i] = (const float*)d_in[i];
    p.out = (float*)d_out; p.ws = (unsigned char*)d_ws;
    void* args[] = {&p};
    hipError_t e = hipLaunchCooperativeKernel((const void*)fwd_megakernel, dim3(grid), dim3(512), args, LDS_BYTES, stream);
    if (e != hipSuccess) fprintf(stderr, "cooperative launch failed: %s (grid %d)\n", hipGetErrorString(e), grid);
}
```

```cpp
#include <hip/hip_runtime.h>
#include <hip/hip_cooperative_groups.h>
#include <cstdio>
#include <cstdint>
namespace cg = cooperative_groups;
#define PROBE_ITEM_BLOCK -1
#define PROBE_MASK 0

#define DI __device__ __forceinline__
#define LAS __attribute__((address_space(3)))
typedef unsigned short bf16_t;
typedef short bf16x8 __attribute__((ext_vector_type(8)));
typedef float f32x4 __attribute__((ext_vector_type(4)));
typedef unsigned u32x4 __attribute__((ext_vector_type(4)));

constexpr int D = 1024, TP = 2064, NBP = 8, NBS = 128, TS = 8;
constexpr int MPR = NBP * TP;
constexpr int M = MPR + NBS * TS;
constexpr int MP = 17664;
constexpr int QKVW = 3072, RWW = 3328, PROJW = 9488, FF = 4096;
constexpr int N1A = 6400, N1B = 3072;
constexpr size_t MiB = 1u << 20;
constexpr size_t WS_CTL = 0;
constexpr size_t WS_WOUT = 1 * MiB, WS_WFF1 = 3 * MiB, WS_WFF2 = 11 * MiB, WS_WG2 = 19 * MiB;
constexpr size_t WS_GDN = 19 * MiB + 512 * 1024, WS_BETA = 20 * MiB + 512 * 1024;
constexpr size_t WS_QKV = 22 * MiB, WS_RW = 126 * MiB;
constexpr size_t WS_X1 = WS_QKV, WS_ACT = 92 * MiB;
constexpr size_t WS_GA = 246 * MiB;
constexpr size_t WS_PART = 231 * MiB;
constexpr size_t DO_H = 0, DO_WIN = 35 * MiB;
constexpr size_t DO_X1B = 35 * MiB, WS_X1B2 = 250 * MiB + 512 * 1024;
constexpr int X1B_SPLIT = 16384;
constexpr size_t DO_TMP = 54 * MiB;
constexpr int BOR_N = 60, BOR_FIRST = 768;
constexpr size_t O_YP = 0, O_YS = 16777216, O_CONVP = 17825792, O_DNP = 17899520, O_SHIFTP = 18948096, O_RWP = 18974720,
                 O_CONVS = 19499008, O_DNS = 20678656, O_SHIFTS = 37455872, O_RWS = 37881856;
constexpr int LDS_BYTES = 163840;
constexpr bool GEMM_ALIGN = true;

struct Params { const float* in[29]; float* out; unsigned char* ws; };

typedef __bf16 bf16v2 __attribute__((ext_vector_type(2)));
typedef float f32x2 __attribute__((ext_vector_type(2)));
DI unsigned pk2(float lo, float hi) { const f32x2 v = {lo, hi}; return __builtin_bit_cast(unsigned, __builtin_convertvector(v, bf16v2)); }
DI unsigned f2bf(float f) { return pk2(f, 0.f) & 0xffffu; }
DI float bflo(unsigned u) { return __builtin_bit_cast(float, u << 16); }
DI float bfhi(unsigned u) { return __builtin_bit_cast(float, u & 0xffff0000u); }
DI void unpack8(const u32x4 v, float* o) { o[0] = bflo(v.x); o[1] = bfhi(v.x); o[2] = bflo(v.y); o[3] = bfhi(v.y); o[4] = bflo(v.z); o[5] = bfhi(v.z); o[6] = bflo(v.w); o[7] = bfhi(v.w); }
DI u32x4 pack8(const float* o) { u32x4 v; v.x = pk2(o[0], o[1]); v.y = pk2(o[2], o[3]); v.z = pk2(o[4], o[5]); v.w = pk2(o[6], o[7]); return v; }
DI void load8bf(const bf16_t* p, float* o) { unpack8(*(const u32x4*)p, o); }
template <int CTRL, int RMASK> DI float dpp_add(float x) { return x + __builtin_bit_cast(float, __builtin_amdgcn_update_dpp(0, __builtin_bit_cast(int, x), CTRL, RMASK, 0xf, false)); }
DI float red8(float x) { x = dpp_add<0xB1, 0xf>(x); x = dpp_add<0x4E, 0xf>(x); return dpp_add<0x141, 0xf>(x); }
DI float red16(float x) { return dpp_add<0x140, 0xf>(red8(x)); }
DI float wave_sum(float v) {
    v = red16(v); v = dpp_add<0x142, 0xa>(v); v = dpp_add<0x143, 0xc>(v);
    return __builtin_bit_cast(float, __builtin_amdgcn_readlane(__builtin_bit_cast(int, v), 63));
}
DI float sigmoidf_(float x) { return __builtin_amdgcn_rcpf(1.f + __expf(-x)); }
DI float tanhf_(float x) { return 1.f - 2.f * __builtin_amdgcn_rcpf(__expf(2.f * x) + 1.f); }
DI float rsqrtf_(float x) { return __builtin_amdgcn_rsqf(x); }
DI float softplusf_(float x) { return fmaxf(x, 0.f) + __logf(1.f + __expf(-fabsf(x))); }
DI float siluf_(float x) { return x * sigmoidf_(x); }
DI unsigned long long rtc() { unsigned long long t; asm volatile("s_memrealtime %0\n\ts_waitcnt lgkmcnt(0)" : "=s"(t) :: "memory"); return t; }
DI int otid() { int t = threadIdx.x; asm volatile("" : "+v"(t)); return t; }
#define LDS_WAIT() asm volatile("s_waitcnt lgkmcnt(0)" ::: "memory")

DI const float* xrow3(const float* xp, const float* xs, const float* xm, int r) {
    if (r < MPR) { const int b = r / TP, t = r - b * TP; return t < 16 ? xm + (size_t)t * D : xp + ((size_t)b * 2048 + (t - 16)) * D; }
    return xs + (size_t)(r - MPR) * D;
}
DI const float* xrow(const Params& p, int r) {
    if (r < MPR) { const int b = r / TP, t = r - b * TP; return t < 16 ? p.in[6] + (size_t)t * D : p.in[0] + ((size_t)b * 2048 + (t - 16)) * D; }
    return p.in[1] + (size_t)(r - MPR) * D;
}

namespace pg8 {
constexpr int BM = 256, BK = 64, HALF = 128, HTB = HALF * BK * 2, STAGE_BYTES = 8 * HTB, NXCD = 8, WGM = 8;
DI int lds_byte(int r, int c) { const int st = (r >> 4) * 2 + (c >> 5), rr = r & 15, cc = c & 31, ob = rr * 64 + cc * 2; return st * 1024 + (ob ^ (((ob >> 9) & 1) << 5)); }
DI void stage_rc(int b, int& R, int& C) { const int st = b / 1024, sb = b % 1024, swz = sb ^ (((sb >> 9) & 1) << 5); R = (st >> 1) * 16 + swz / 64; C = (st & 1) * 32 + (swz % 64) / 2; }
DI int perm32(int rho) { const int n = rho >> 4, i = rho & 15; return 8 * (i >> 2) + 4 * n + (i & 3); }
struct Unit { int pm, pn, k0, nt, part, slot, alt; };
struct Gemm { const bf16_t* A; int lda; const bf16_t* Bt; int M, N, K; const bf16_t* Bt2 = nullptr; };
DI void map_tile(int L, int nM, int nN, int nwg, int& pm, int& pn) {
    int wgid = L; { const int q = nwg / NXCD, r = nwg % NXCD, xcd = wgid % NXCD, off = wgid / NXCD; wgid = (xcd < r ? xcd * (q + 1) : r * (q + 1) + (xcd - r) * q) + off; }
    const int nig = WGM * nN, gid = wgid / nig, fm = gid * WGM, gsz = (nM - fm) < WGM ? (nM - fm) : WGM;
    pm = fm + ((wgid % nig) % gsz); pn = (wgid % nig) / gsz;
}
struct StaticOrder {
    int nM, nN, nwg, G, c, ntf, split;
    int limit = 1 << 30;
    int bor_n = 0, bor_first = 0, bor_nN = 0, bor_nwg = 0;
    DI void init(int M_, int N_, int G_, int c_, int ntf_ = 16, int split_ = 0) { nM = M_ / BM; nN = N_ / BM; nwg = nM * nN; G = G_; c = c_; ntf = ntf_;
        split = (split_ && nwg > G && nwg <= 2 * G && (nwg - G) * 4 <= G && (nwg - G) <= 20) ? 1 : 0; }
    DI bool next(int i, Unit& u) const {
        long L = (long)i * G + c; u.k0 = 0; u.nt = ntf; u.part = 0; u.slot = -1;
        if (split && i >= 1) { if (i > 1 || c >= 4 * (nwg - G)) return false; L = G + (c >> 2); u.part = c & 3; u.nt = ntf >> 2; u.k0 = u.part * u.nt; u.slot = c >> 2; }
        u.alt = 0;
        if (L >= nwg || L >= limit) {
            const int idx = c - (nwg % G);
            if (bor_n > 0 && L < limit && i == nwg / G && idx >= 0 && idx < bor_n) { map_tile(bor_first + idx, nM, bor_nN, bor_nwg, u.pm, u.pn); u.alt = 1; u.slot = idx; return true; }
            return false;
        }
        map_tile((int)L, nM, nN, nwg, u.pm, u.pn); return true;
    }
};
DI unsigned cvt_pk_bf16(float lo, float hi) { return pk2(lo, hi); }

template <int ACT> struct EpiSeg {
    bf16_t* d0; int ld0; int split; bf16_t* d1; int ld1; bf16_t* tmp = nullptr;
    DI void operator()(const f32x4 (&acc)[2][2][4][2], const Unit& u, int wr, int wc, int fr, int fq) const {
        const int row0 = u.pm * BM + wr * 64 + fr; int colt = u.pn * BM; bf16_t* base = d0; int ld = ld0;
        if (colt >= split) { base = d1; ld = ld1; colt -= split; }
        if (u.alt) { base = tmp + (size_t)u.slot * 65536 - (size_t)(u.pm * BM) * 256; ld = 256; colt = 0; }
        const int col0 = colt + wc * 32 + 8 * fq;
#pragma unroll
        for (int ai = 0; ai < 2; ++ai)
#pragma unroll
            for (int m = 0; m < 4; ++m) { bf16_t* rowp = base + (size_t)(row0 + ai * HALF + m * 16) * ld + col0;
#pragma unroll
                for (int bj = 0; bj < 2; ++bj) { f32x4 v0 = acc[ai][bj][m][0], v1 = acc[ai][bj][m][1];
                    if (ACT == 1) {
#pragma unroll
                        for (int e = 0; e < 4; ++e) { float a = fmaxf(v0[e], 0.f), b = fmaxf(v1[e], 0.f); v0[e] = a * a; v1[e] = b * b; } }
                    u32x4 w; w.x = cvt_pk_bf16(v0[0], v0[1]); w.y = cvt_pk_bf16(v0[2], v0[3]); w.z = cvt_pk_bf16(v1[0], v1[1]); w.w = cvt_pk_bf16(v1[2], v1[3]);
                    *(u32x4*)(rowp + bj * HALF) = w; } }
    }
};
template <int MODE> struct EpiRes {
    float* X1; const float* xp; const float* xs; const float* xm; float* part; bf16_t* x1a; bf16_t* x1b;
    DI void operator()(const f32x4 (&acc)[2][2][4][2], const Unit& u, int wr, int wc, int fr, int fq) const {
        const int row0 = u.pm * BM + wr * 64 + fr; const int col0 = u.pn * BM + wc * 32 + 8 * fq;
        if (u.part > 0) {
            float* pb = part + (size_t)((u.part - 1) * 20 + u.slot) * 65536 + (size_t)(wr * 64 + fr) * 256 + wc * 32 + 8 * fq;
#pragma unroll
            for (int ai = 0; ai < 2; ++ai)
#pragma unroll
                for (int m = 0; m < 4; ++m)
#pragma unroll
                    for (int bj = 0; bj < 2; ++bj) { float* o = pb + (size_t)(ai * HALF + m * 16) * 256 + bj * HALF; *(f32x4*)o = acc[ai][bj][m][0]; *(f32x4*)(o + 4) = acc[ai][bj][m][1]; }
            return;
        }
#pragma unroll
        for (int ai = 0; ai < 2; ++ai)
#pragma unroll
            for (int m = 0; m < 4; ++m) { const int row = row0 + ai * HALF + m * 16;
                bf16_t* xb = (row < X1B_SPLIT ? x1a + (size_t)row * D : x1b + (size_t)(row - X1B_SPLIT) * D) + col0;
                if (MODE == 0) {
                    const float* bp = row < M ? xrow3(xp, xs, xm, row) + col0 : nullptr;
#pragma unroll
                    for (int bj = 0; bj < 2; ++bj) { f32x4 b0 = (f32x4){0.f, 0.f, 0.f, 0.f}, b1 = b0;
                        if (bp) { b0 = *(const f32x4*)(bp + bj * HALF); b1 = *(const f32x4*)(bp + bj * HALF + 4); }
                        const f32x4 v0 = acc[ai][bj][m][0] + b0, v1 = acc[ai][bj][m][1] + b1;
                        u32x4 w; w.x = pk2(v0[0], v0[1]); w.y = pk2(v0[2], v0[3]); w.z = pk2(v1[0], v1[1]); w.w = pk2(v1[2], v1[3]);
                        *(u32x4*)(xb + bj * HALF) = w; }
                } else {
                    float* op = X1 + (size_t)row * D + col0;
#pragma unroll
                    for (int bj = 0; bj < 2; ++bj) { float b[8]; unpack8(*(const u32x4*)(xb + bj * HALF), b);
                        *(f32x4*)(op + bj * HALF) = acc[ai][bj][m][0] + (f32x4){b[0], b[1], b[2], b[3]}; *(f32x4*)(op + bj * HALF + 4) = acc[ai][bj][m][1] + (f32x4){b[4], b[5], b[6], b[7]}; }
                } }
    }
};

template <int K, int lda, bool ALIGN_EPI, class Epi>
DI void gemm_phase(LAS unsigned char* lds, const Gemm g, const StaticOrder& S, const Epi& E) {
    const int tid = otid(), wid = __builtin_amdgcn_readfirstlane(tid >> 6), lane = tid & 63, wr = wid >> 2, wc = wid & 3, fr = lane & 15, fq = lane >> 4;
    unsigned voffA[2], voffB[2];
#pragma unroll
    for (int i = 0; i < 2; ++i) { int R, C; stage_rc(tid * 16 + i * 8192, R, C); const int Rb = (R & ~31) + perm32(R & 31);
        voffA[i] = (unsigned)(R * lda + C) * 2u; voffB[i] = (unsigned)(Rb * K + C) * 2u; }
    const size_t kstep = (size_t)(BK * 2);
    const size_t hA = (size_t)HALF * lda * 2, hB = (size_t)HALF * K * 2;
    const size_t tA = 2 * hA, tB = 2 * hB;
    const unsigned ldsw = (unsigned)wid * 1024u;
    const int aoff = lds_byte(wr * 64 + fr, fq * 8), boff = lds_byte(wc * 32 + fr, fq * 8);
#define PG8_SA(b, h) (((b) * 2 + (h)) * HTB)
#define PG8_SB(b, h) ((4 + (b) * 2 + (h)) * HTB)
#define PG8_STAGE(bufoff, gbase, voff) do { _Pragma("unroll") for (int _i = 0; _i < 2; ++_i) \
        __builtin_amdgcn_global_load_lds((const unsigned*)((const char*)(gbase) + (voff)[_i]), (LAS unsigned*)(lds + (bufoff) + ldsw + _i * 8192), 16, 0, 0); } while (0)
#define PG8_LDA(dst, b, h) do { _Pragma("unroll") for (int m = 0; m < 4; ++m) _Pragma("unroll") for (int k = 0; k < 2; ++k) dst[m][k] = *(const LAS bf16x8*)(lds + PG8_SA(b, h) + aoff + m * 2048 + k * 1024); } while (0)
#define PG8_LDB(dst, b, h) do { _Pragma("unroll") for (int n = 0; n < 2; ++n) _Pragma("unroll") for (int k = 0; k < 2; ++k) dst[n][k] = *(const LAS bf16x8*)(lds + PG8_SB(b, h) + boff + n * 2048 + k * 1024); } while (0)
#define PG8_MMA(ai, bj, At, Bt) do { __builtin_amdgcn_s_setprio(1); _Pragma("unroll") for (int m = 0; m < 4; ++m) _Pragma("unroll") for (int n = 0; n < 2; ++n) _Pragma("unroll") for (int k = 0; k < 2; ++k) \
        acc[ai][bj][m][n] = __builtin_amdgcn_mfma_f32_16x16x32_bf16(Bt[n][k], At[m][k], acc[ai][bj][m][n], 0, 0, 0); __builtin_amdgcn_s_setprio(0); } while (0)
#define PG8_WAIT_V(n) asm volatile("s_waitcnt vmcnt(" #n ")" ::: "memory")
#define PG8_WAIT_L(n) asm volatile("s_waitcnt lgkmcnt(" #n ")" ::: "memory")
#define PG8_BAR __builtin_amdgcn_s_barrier()
#define PG8_SCHED __builtin_amdgcn_sched_barrier(0)
    Unit cur, nxt; int ui = 0;
    if (!S.next(0, cur)) return;
    f32x4 acc[2][2][4][2];
#pragma unroll
    for (int a = 0; a < 2; ++a)
#pragma unroll
        for (int b = 0; b < 2; ++b)
#pragma unroll
            for (int m = 0; m < 4; ++m)
#pragma unroll
                for (int n = 0; n < 2; ++n) acc[a][b][m][n] = (f32x4){0.f, 0.f, 0.f, 0.f};
    bf16x8 At[4][2], B0[2][2], B1[2][2];
    const char* cA = (const char*)g.A + (size_t)cur.pm * tA + (size_t)cur.k0 * kstep; const char* cB = (const char*)(cur.alt ? g.Bt2 : g.Bt) + (size_t)cur.pn * tB + (size_t)cur.k0 * kstep;
    PG8_STAGE(PG8_SB(0, 0), cB, voffB); PG8_STAGE(PG8_SB(0, 1), cB + hB, voffB); PG8_STAGE(PG8_SA(0, 0), cA, voffA); PG8_STAGE(PG8_SA(0, 1), cA + hA, voffA);
    if (wr == 1) PG8_BAR;
    PG8_WAIT_V(2); PG8_BAR;
    PG8_STAGE(PG8_SB(1, 0), cB + kstep, voffB); PG8_STAGE(PG8_SA(1, 0), cA + kstep, voffA); PG8_STAGE(PG8_SB(1, 1), cB + hB + kstep, voffB);
    PG8_WAIT_V(6); PG8_BAR;
    for (;;) {
        const bool has_next = S.next(ui + 1, nxt);
        const char* nA = has_next ? (const char*)g.A + (size_t)nxt.pm * tA + (size_t)nxt.k0 * kstep : cA; const char* nB = has_next ? (const char*)(nxt.alt ? g.Bt2 : g.Bt) + (size_t)nxt.pn * tB + (size_t)nxt.k0 * kstep : cB;
        const int nt = cur.nt;
        for (int t = 0; t < nt; t += 2) {
            const bool last = (t == nt - 2);
            const char* a1 = cA + (size_t)(t + 1) * kstep;
            const char* a2 = last ? nA : cA + (size_t)(t + 2) * kstep; const char* b2 = last ? nB : cB + (size_t)(t + 2) * kstep;
            const char* a3 = a2 + kstep; const char* b3 = b2 + kstep;
            PG8_LDB(B0, 0, 0); PG8_LDB(B1, 0, 1); PG8_SCHED; PG8_LDA(At, 0, 0); PG8_STAGE(PG8_SA(1, 1), a1 + hA, voffA);
            PG8_WAIT_V(8); PG8_WAIT_L(0); PG8_BAR; PG8_MMA(0, 0, At, B0); PG8_MMA(0, 1, At, B1); PG8_BAR; PG8_SCHED;
            PG8_LDA(At, 0, 1); PG8_STAGE(PG8_SB(0, 0), b2, voffB); PG8_STAGE(PG8_SB(0, 1), b2 + hB, voffB); PG8_STAGE(PG8_SA(0, 0), a2, voffA);
            PG8_WAIT_V(8); PG8_WAIT_L(0); PG8_BAR; PG8_MMA(1, 0, At, B0); PG8_MMA(1, 1, At, B1); PG8_BAR; PG8_SCHED;
            PG8_LDB(B0, 1, 0); PG8_LDB(B1, 1, 1); PG8_SCHED; PG8_LDA(At, 1, 0); PG8_STAGE(PG8_SA(0, 1), a2 + hA, voffA);
            PG8_WAIT_V(8); PG8_WAIT_L(0); PG8_BAR; PG8_MMA(0, 0, At, B0); PG8_MMA(0, 1, At, B1); PG8_BAR; PG8_SCHED;
            PG8_LDA(At, 1, 1); PG8_STAGE(PG8_SB(1, 0), b3, voffB); PG8_STAGE(PG8_SB(1, 1), b3 + hB, voffB); PG8_STAGE(PG8_SA(1, 0), a3, voffA);
            PG8_WAIT_V(8); PG8_WAIT_L(0); PG8_BAR; PG8_MMA(1, 0, At, B0); PG8_MMA(1, 1, At, B1); PG8_BAR; PG8_SCHED;
        }
        if constexpr (ALIGN_EPI) { if (wr == 0) PG8_BAR; }
        E(acc, cur, wr, wc, fr, fq);
        if (!has_next) break;
#pragma unroll
        for (int a = 0; a < 2; ++a)
#pragma unroll
            for (int b = 0; b < 2; ++b)
#pragma unroll
                for (int m = 0; m < 4; ++m)
#pragma unroll
                    for (int n = 0; n < 2; ++n) acc[a][b][m][n] = (f32x4){0.f, 0.f, 0.f, 0.f};
        cur = nxt; cA = nA; cB = nB; ++ui;
        if constexpr (ALIGN_EPI) { if (wr == 1) PG8_BAR; }
    }
    PG8_WAIT_V(0);
    if constexpr (!ALIGN_EPI) { if (wr == 0) PG8_BAR; }
    PG8_BAR;
#undef PG8_SA
#undef PG8_SB
#undef PG8_STAGE
#undef PG8_LDA
#undef PG8_LDB
#undef PG8_MMA
#undef PG8_WAIT_V
#undef PG8_WAIT_L
#undef PG8_BAR
#undef PG8_SCHED
}
}

DI void transpose_item(const float* W, int ldw, int nblk, bf16_t* WT, int K, int row_off, LAS float* scr, int item, int lane) {
    const int kb = item / nblk, nb = item - kb * nblk, k0 = 64 * kb, n0 = 32 * nb;
#pragma unroll 8
    for (int i = 0; i < 32; ++i) { const int kk = 2 * i + (lane >> 5); scr[kk * 33 + (lane & 31)] = W[(size_t)(k0 + kk) * ldw + n0 + (lane & 31)]; }
    LDS_WAIT();
    const int c = lane & 7;
#pragma unroll
    for (int j = 0; j < 4; ++j) { const int n = (lane >> 3) + 8 * j; const LAS float* s = scr + (8 * c) * 33 + n;
        u32x4 o; o.x = pk2(s[0 * 33], s[1 * 33]); o.y = pk2(s[2 * 33], s[3 * 33]); o.z = pk2(s[4 * 33], s[5 * 33]); o.w = pk2(s[6 * 33], s[7 * 33]);
        *(u32x4*)(WT + (size_t)(row_off + n0 + n) * K + k0 + 8 * c) = o; }
    LDS_WAIT();
}

DI void load_row(const float* xr, int lane, f32x4 (&v)[4]) {
#pragma unroll
    for (int j = 0; j < 4; ++j) v[j] = *(const f32x4*)(xr + 4 * lane + 256 * j);
}
DI void rms_row(const float* xr, const float* g, bf16_t* orow, int lane, f32x4 (&v)[4], const float* part = nullptr, const LAS int* slots = nullptr, int prow = 0, float* wb = nullptr, bool pre = false, bf16_t* wbb = nullptr) {
    float s = 0.f;
#pragma unroll
    for (int j = 0; j < 4; ++j) { if (!pre) v[j] = *(const f32x4*)(xr + 4 * lane + 256 * j);
        if (part) { const int sl = slots[j]; if (sl >= 0) { const float* pp = part + (size_t)sl * 65536 + (size_t)prow * 256 + 4 * lane;
                v[j] = v[j] + *(const f32x4*)pp + *(const f32x4*)(pp + (size_t)20 * 65536) + *(const f32x4*)(pp + (size_t)40 * 65536);
                if (wb) *(f32x4*)(wb + 4 * lane + 256 * j) = v[j];
                if (wbb) { const unsigned long long o = (unsigned long long)pk2(v[j].x, v[j].y) | ((unsigned long long)pk2(v[j].z, v[j].w) << 32); *(unsigned long long*)(wbb + 4 * lane + 256 * j) = o; } } }
        s += (v[j].x * v[j].x + v[j].y * v[j].y) + (v[j].z * v[j].z + v[j].w * v[j].w); }
    const float rstd = 1.f / sqrtf(wave_sum(s) * (1.f / D) + 1e-6f);
#pragma unroll
    for (int j = 0; j < 4; ++j) { const f32x4 gg = *(const f32x4*)(g + 4 * lane + 256 * j); v[j] = v[j] * rstd * gg;
        if (orow) { unsigned long long o = (unsigned long long)pk2(v[j].x, v[j].y) | ((unsigned long long)pk2(v[j].z, v[j].w) << 32); *(unsigned long long*)(orow + 4 * lane + 256 * j) = o; } }
}

DI void phase0(const Params& p, LAS unsigned char* lds) {
    const int tid = otid(), lane = tid & 63, wave = __builtin_amdgcn_readfirstlane(tid >> 6);
    LAS float* scr = (LAS float*)(lds + wave * 16384);
    const int gw = blockIdx.x * 8 + wave, NGW = gridDim.x * 8;
    bf16_t* WIN = (bf16_t*)((unsigned char*)p.out + DO_WIN);
    bf16_t* WOUT = (bf16_t*)(p.ws + WS_WOUT); bf16_t* WF1 = (bf16_t*)(p.ws + WS_WFF1); bf16_t* WF2 = (bf16_t*)(p.ws + WS_WFF2); bf16_t* WG2 = (bf16_t*)(p.ws + WS_WG2);
    const float* w_in = p.in[8];
    constexpr int I0 = 16 * 96, I1 = 16 * 104, I2 = 16 * 32, I3 = 16 * 64, I4 = 16 * 32, I5 = 16 * 128, I6 = 64 * 32, I7 = 2 * 32;
    constexpr int NIT = I0 + I1 + I2 + I3 + I4 + I5 + I6 + I7;
    for (int it = gw; it < NIT; it += NGW) {
        int r = it;
        if (r < I0) { transpose_item(w_in, PROJW, 96, WIN, 1024, 0, scr, r, lane); continue; } r -= I0;
        if (r < I1) { transpose_item(w_in + 4112, PROJW, 104, WIN, 1024, 3072, scr, r, lane); continue; } r -= I1;
        if (r < I2) { transpose_item(w_in + 3072, PROJW, 32, WIN, 1024, 6400, scr, r, lane); continue; } r -= I2;
        if (r < I3) { transpose_item(w_in + 7440, PROJW, 64, WIN, 1024, 7424, scr, r, lane); continue; } r -= I3;
        if (r < I4) { transpose_item(p.in[24], 1024, 32, WOUT, 1024, 0, scr, r, lane); continue; } r -= I4;
        if (r < I5) { transpose_item(p.in[26], 4096, 128, WF1, 1024, 0, scr, r, lane); continue; } r -= I5;
        if (r < I6) { transpose_item(p.in[27], 1024, 32, WF2, 4096, 0, scr, r, lane); continue; } r -= I6;
        transpose_item(p.in[18], 1024, 32, WG2, 128, 0, scr, r, lane);
    }
    bf16_t* H = (bf16_t*)((unsigned char*)p.out + DO_H);
    float* GDN = (float*)(p.ws + WS_GDN); float* BETA = (float*)(p.ws + WS_BETA);
    __syncthreads();
    LAS float* sWab = (LAS float*)lds;
    for (int idx = tid; idx < 16384; idx += 512) { const int k = idx >> 4, i = idx & 15; sWab[i * 1028 + k] = w_in[(size_t)k * PROJW + 4096 + i]; }
    __syncthreads();
    f32x4 nv[4];
    if (gw < M) load_row(xrow(p, gw), lane, nv);
    for (int m = gw; m < MP; m += NGW) {
        bf16_t* hr = H + (size_t)m * D;
        if (m >= M) {
#pragma unroll
            for (int j = 0; j < 4; ++j) *(unsigned long long*)(hr + 4 * lane + 256 * j) = 0ull;
            continue;
        }
        f32x4 v[4];
#pragma unroll
        for (int j = 0; j < 4; ++j) v[j] = nv[j];
        if (m + NGW < M) load_row(xrow(p, m + NGW), lane, nv);
        rms_row(nullptr, p.in[7], hr, lane, v, nullptr, nullptr, 0, nullptr, true);
        float s[16];
#pragma unroll
        for (int i = 0; i < 16; ++i) { float a = 0.f;
#pragma unroll
            for (int j = 0; j < 4; ++j) { const f32x4 w4 = *(const LAS f32x4*)(sWab + i * 1028 + 256 * j + 4 * lane); a += v[j].x * w4.x + v[j].y * w4.y + v[j].z * w4.z + v[j].w * w4.w; }
            s[i] = a; }
        float mine = 0.f;
#pragma unroll
        for (int i = 0; i < 16; ++i) { const float t = wave_sum(s[i]); if (lane == i) mine = t; }
        if (lane < 8) GDN[(size_t)m * 8 + lane] = -__expf(p.in[10][lane]) * softplusf_(mine + p.in[11][lane]);
        else if (lane < 16) BETA[(size_t)m * 8 + lane - 8] = sigmoidf_(mine);
    }
}

typedef float f32x16 __attribute__((ext_vector_type(16)));
typedef unsigned u32x2 __attribute__((ext_vector_type(2)));
DI int crow(int reg, int hh) { return (reg & 3) + 8 * (reg >> 2) + 4 * hh; }
template <int KS> DI void mma32(f32x16& acc, const LAS bf16_t* A, int lda, const LAS bf16_t* Bt, int ldb, int lane) {
    const int r = lane & 31, hh = lane >> 5;
    const LAS bf16_t* pa = A + r * lda + 8 * hh; const LAS bf16_t* pb = Bt + r * ldb + 8 * hh;
#pragma unroll
    for (int ks = 0; ks < KS; ++ks) { const bf16x8 a = *(const LAS bf16x8*)(pa + 16 * ks); const bf16x8 b = *(const LAS bf16x8*)(pb + 16 * ks);
        acc = __builtin_amdgcn_mfma_f32_32x32x16_bf16(a, b, acc, 0, 0, 0); }
}
template <int s> DI void tri_level(LAS float* sA, LAS float* sX, LAS float* sM, int tid) {
    constexpr int NP = 32 / s, NOUT = NP * s * s, PER = (NOUT + 511) / 512, MS = s + 4;
    float res[PER];
#pragma unroll
    for (int u = 0; u < PER; ++u) { const int o = tid + 512 * u; res[u] = 0.f;
        if (o < NOUT) { const int pp = o / (s * s), r = (o / s) % s, c = o % s; const int R0 = 2 * s * pp + s, C0 = 2 * s * pp;
            const LAS float* ar = sA + (R0 + r) * 68 + C0; const LAS float* xc = sX + C0 * 68 + C0 + c; float acc = 0.f;
#pragma unroll
            for (int k4 = 0; k4 < s / 4; ++k4) { const f32x4 a = *(const LAS f32x4*)(ar + 4 * k4);
                acc += a.x * xc[(4 * k4) * 68] + a.y * xc[(4 * k4 + 1) * 68] + a.z * xc[(4 * k4 + 2) * 68] + a.w * xc[(4 * k4 + 3) * 68]; }
            sM[pp * (s * MS) + r * MS + c] = acc; } }
    __syncthreads();
#pragma unroll
    for (int u = 0; u < PER; ++u) { const int o = tid + 512 * u;
        if (o < NOUT) { const int pp = o / (s * s), r = (o / s) % s, c = o % s; const int R0 = 2 * s * pp + s, C0 = 2 * s * pp;
            const LAS float* xr = sX + (R0 + r) * 68 + R0; const LAS float* mc = sM + pp * (s * MS) + c; float acc = 0.f;
#pragma unroll
            for (int k4 = 0; k4 < s / 4; ++k4) { const f32x4 a = *(const LAS f32x4*)(xr + 4 * k4);
                acc += a.x * mc[(4 * k4) * MS] + a.y * mc[(4 * k4 + 1) * MS] + a.z * mc[(4 * k4 + 2) * MS] + a.w * mc[(4 * k4 + 3) * MS]; }
            sX[(R0 + r) * 68 + C0 + c] = -acc; } }
    __syncthreads();
}
template <int s> DI void tri_level_mfma(LAS float* sA, LAS float* sX, LAS float* sM, int tid) {
    constexpr int NP = 32 / s, T1 = s / 16, TPP = T1 * T1, MS = s + 4;
    const int wv = __builtin_amdgcn_readfirstlane(tid >> 6), l = tid & 63, li = l & 15, lk = l >> 4;
    const bool on = wv < NP * TPP;
    const int pp = wv / TPP, tt = wv % TPP, tr = tt / T1, tc = tt % T1;
    const int R0 = 2 * s * pp + s, C0 = 2 * s * pp;
    if (on) { f32x4 acc = (f32x4){0.f, 0.f, 0.f, 0.f};
#pragma unroll
        for (int ks = 0; ks < s / 4; ++ks) { const float a = sA[(R0 + 16 * tr + li) * 68 + C0 + 4 * ks + lk]; const float b = sX[(C0 + 4 * ks + lk) * 68 + C0 + 16 * tc + li];
            acc = __builtin_amdgcn_mfma_f32_16x16x4f32(a, b, acc, 0, 0, 0); }
#pragma unroll
        for (int reg = 0; reg < 4; ++reg) sM[pp * (s * MS) + (16 * tr + 4 * lk + reg) * MS + 16 * tc + li] = acc[reg]; }
    __syncthreads();
    if (on) { f32x4 acc = (f32x4){0.f, 0.f, 0.f, 0.f};
#pragma unroll
        for (int ks = 0; ks < s / 4; ++ks) { const float a = sX[(R0 + 16 * tr + li) * 68 + R0 + 4 * ks + lk]; const float b = sM[pp * (s * MS) + (4 * ks + lk) * MS + 16 * tc + li];
            acc = __builtin_amdgcn_mfma_f32_16x16x4f32(a, b, acc, 0, 0, 0); }
#pragma unroll
        for (int reg = 0; reg < 4; ++reg) sX[(R0 + 16 * tr + 4 * lk + reg) * 68 + C0 + 16 * tc + li] = -acc[reg]; }
    __syncthreads();
}
DI void tri_inverse(LAS float* sA, LAS float* sX, LAS float* sM, LAS bf16_t* sTi, int tid, int C) {
    if (tid < 64) { const int blk = tid >> 3, c = tid & 7; const LAS float* ab = sA + (8 * blk) * 68 + 8 * blk; float x[8];
        f32x4 a0[8], a1[8];
#pragma unroll
        for (int r = 1; r < 8; ++r) { a0[r] = *(const LAS f32x4*)(ab + r * 68); a1[r] = *(const LAS f32x4*)(ab + r * 68 + 4); }
#pragma unroll
        for (int r = 0; r < 8; ++r) { float sacc = (r == c) ? 1.f : 0.f;
#pragma unroll
            for (int m = 0; m < r; ++m) sacc -= ((m < 4) ? a0[r][m & 3] : a1[r][m & 3]) * x[m];
            x[r] = sacc; }
#pragma unroll
        for (int r = 0; r < 8; ++r) sX[(8 * blk + r) * 68 + 8 * blk + c] = x[r];
    }
    __syncthreads();
    if (C > 8) tri_level<8>(sA, sX, sM, tid);
    if (C > 16) tri_level_mfma<16>(sA, sX, sM, tid);
    if (C > 32) tri_level_mfma<32>(sA, sX, sM, tid);
    for (int idx = tid; idx < 64 * 32; idx += 512) { const int i = idx >> 5, j2 = (idx & 31) * 2; *(LAS unsigned*)(sTi + i * 72 + j2) = pk2(sX[i * 68 + j2], sX[i * 68 + j2 + 1]); }
}

template <int KS> DI void mma32_gBk(f32x16& acc, const LAS bf16_t* A, int lda, const float* B, int ldb, int lane) {
    const int r = lane & 31, hh = lane >> 5;
    const LAS bf16_t* pa = A + r * lda + 8 * hh; const float* pb = B + (size_t)(8 * hh) * ldb + r;
    float f[KS][8];
#pragma unroll
    for (int ks = 0; ks < KS; ++ks)
#pragma unroll
        for (int j = 0; j < 8; ++j) f[ks][j] = pb[(size_t)(16 * ks + j) * ldb];
    __builtin_amdgcn_sched_barrier(0);
#pragma unroll
    for (int ks = 0; ks < KS; ++ks) { const bf16x8 a = *(const LAS bf16x8*)(pa + 16 * ks);
        u32x4 bw; bw.x = pk2(f[ks][0], f[ks][1]); bw.y = pk2(f[ks][2], f[ks][3]); bw.z = pk2(f[ks][4], f[ks][5]); bw.w = pk2(f[ks][6], f[ks][7]);
        acc = __builtin_amdgcn_mfma_f32_32x32x16_bf16(a, __builtin_bit_cast(bf16x8, bw), acc, 0, 0, 0); }
}
DI void dn_item(const Params& p, LAS unsigned char* lds, int b, int h, int dvh, bool prompt) {
    const bool bat = !prompt;
    const int tid0 = otid(), w = __builtin_amdgcn_readfirstlane(tid0 >> 6);
    LAS bf16_t* sQ = (LAS bf16_t*)(lds);
    LAS bf16_t* sK = (LAS bf16_t*)(lds + 17408);
    LAS bf16_t* sKT = (LAS bf16_t*)(lds + 34816);
    LAS bf16_t* sV = (LAS bf16_t*)(lds + 53248);
    LAS bf16_t* sST = (LAS bf16_t*)(lds + 62464);
    LAS float* sA = (LAS float*)(lds + 79872);
    LAS bf16_t* sRT = (LAS bf16_t*)(lds + 79872);
    LAS bf16_t* sUT = (LAS bf16_t*)(lds + 79872 + 9216);
    LAS bf16_t* sUdT = (LAS bf16_t*)(lds + 79872 + 18432);
    LAS float* sX = (LAS float*)(lds + 97280);
    LAS float* sM = (LAS float*)(lds + 114688);
    LAS bf16_t* sTi = (LAS bf16_t*)(lds + 119296);
    LAS bf16_t* sAqk = (LAS bf16_t*)(lds + 128512);
    LAS float* sHalo = (LAS float*)(lds + 137728);
    LAS float* sG = (LAS float*)(lds + 145408);
    LAS float* sBeta = (LAS float*)(lds + 145664);
    LAS float* sCw = (LAS float*)(lds + 145920);
    const int T = prompt ? TP : 64, row0 = prompt ? b * TP : MPR + b * 64;
    const bf16_t* QKV = (const bf16_t*)(p.ws + WS_QKV);
    bf16_t* QKVo = (bf16_t*)(p.ws + WS_QKV);
    const float* GDN = (const float*)(p.ws + WS_GDN); const float* BETA = (const float*)(p.ws + WS_BETA);
    const int aS = w >> 1, tjS = w & 1;
    f32x16 accS;
    {
        const int lane = tid0 & 63, hh = lane >> 5;
        const float* st = p.in[3] + ((size_t)(b * 8 + h) * 128) * 128 + dvh * 64 + 32 * tjS + (lane & 31);
#pragma unroll
        for (int reg = 0; reg < 16; ++reg) accS[reg] = 0.f;
        (void)st;
#pragma unroll
        for (int g4 = 0; g4 < 4; ++g4) { u32x2 v; v.x = pk2(accS[4 * g4], accS[4 * g4 + 1]); v.y = pk2(accS[4 * g4 + 2], accS[4 * g4 + 3]);
            *(LAS u32x2*)(sST + (32 * tjS + (lane & 31)) * 136 + 32 * aS + 8 * g4 + 4 * hh) = v; }
    }
    const int run = w;
    for (int idx = tid0; idx < 960; idx += 512) {
        const int j = idx / 320, c = idx - j * 320; const int cgi = c >> 3, e = c & 7;
        int chh; if (cgi < 16) chh = h * 128 + cgi * 8; else if (cgi < 32) chh = 1024 + h * 128 + (cgi - 16) * 8; else chh = 2048 + h * 128 + dvh * 64 + (cgi - 32) * 8;
        sHalo[idx] = 0.f;
        sCw[idx] = p.in[9][(size_t)j * QKVW + chh + e];
    }
    if (tid0 < 320) { const int c = tid0, cgi = c >> 3, e = c & 7; int chh; if (cgi < 16) chh = h * 128 + cgi * 8; else if (cgi < 32) chh = 1024 + h * 128 + (cgi - 16) * 8; else chh = 2048 + h * 128 + dvh * 64 + (cgi - 32) * 8;
        sCw[960 + c] = p.in[9][(size_t)3 * QKVW + chh + e]; }
    __syncthreads();
    int hb = 0;
    const float* cw = p.in[9];
    u32x4 nraw[11];
#define DN_LOADRAW(T0N) do { const int l_ = otid() & 63; const int Cn_ = (T - (T0N)) < 64 ? (T - (T0N)) : 64; \
        if (l_ < 40 && run * 8 < Cn_) { int ch_; if (l_ < 16) ch_ = h * 128 + l_ * 8; else if (l_ < 32) ch_ = 1024 + h * 128 + (l_ - 16) * 8; else ch_ = 2048 + h * 128 + dvh * 64 + (l_ - 32) * 8; \
            const bf16_t* b_ = QKV + (size_t)(row0 + (T0N) + run * 8) * QKVW + ch_; \
            _Pragma("unroll") for (int q_ = 0; q_ < 8; ++q_) nraw[3 + q_] = *(const u32x4*)(b_ + (size_t)q_ * QKVW); \
            if (run > 0 && !bat) { _Pragma("unroll") for (int q_ = 0; q_ < 3; ++q_) nraw[q_] = *(const u32x4*)(b_ - (size_t)(3 - q_) * QKVW); } } } while (0)
    DN_LOADRAW(0);
    float ng = 0.f, nbe = 0.f;
    if (w == 0) { const int l_ = tid0 & 63; const int C0_ = T < 64 ? T : 64; if (l_ < C0_) { ng = GDN[(size_t)(row0 + l_) * 8 + h]; nbe = BETA[(size_t)(row0 + l_) * 8 + h]; } }
    for (int t0 = 0; t0 < T; t0 += 64) {
        const int C = (T - t0) < 64 ? (T - t0) : 64;
        const int tid = otid(), lane = tid & 63, hh = lane >> 5, cg_ = lane;
        const bool act = cg_ < 40;
        int ch = 0;
        if (cg_ < 16) ch = h * 128 + cg_ * 8; else if (cg_ < 32) ch = 1024 + h * 128 + (cg_ - 16) * 8; else ch = 2048 + h * 128 + dvh * 64 + (cg_ - 32) * 8;
        if (w == 0) { float g = ng, be = nbe; ng = 0.f; nbe = 0.f;
            if (t0 + 64 < T) { const int Cn = (T - t0 - 64) < 64 ? (T - t0 - 64) : 64; if (lane < Cn) { ng = GDN[(size_t)(row0 + t0 + 64 + lane) * 8 + h]; nbe = BETA[(size_t)(row0 + t0 + 64 + lane) * 8 + h]; } }
            {
                const int lp = lane & 7; float t_;
                t_ = __builtin_bit_cast(float, __builtin_amdgcn_update_dpp(0, __builtin_bit_cast(int, g), 0x111, 0xf, 0xf, false)); g += (!bat || lp >= 1) ? t_ : 0.f;
                t_ = __builtin_bit_cast(float, __builtin_amdgcn_update_dpp(0, __builtin_bit_cast(int, g), 0x112, 0xf, 0xf, false)); g += (!bat || lp >= 2) ? t_ : 0.f;
                t_ = __builtin_bit_cast(float, __builtin_amdgcn_update_dpp(0, __builtin_bit_cast(int, g), 0x114, 0xf, 0xf, false)); g += (!bat || lp >= 4) ? t_ : 0.f;
                if (!bat) { g = dpp_add<0x118, 0xf>(g); g = dpp_add<0x142, 0xa>(g); g = dpp_add<0x143, 0xc>(g); }
            }
            sG[lane] = g; sBeta[lane] = be; }
        float val[8][8];
        const bool mine = act && (run * 8 < C);
        if (mine) {
            float cwv[4][8];
#pragma unroll
            for (int j = 0; j < 4; ++j) { const f32x4 a = *(const LAS f32x4*)(sCw + j * 320 + cg_ * 8), bq = *(const LAS f32x4*)(sCw + j * 320 + cg_ * 8 + 4);
                cwv[j][0] = a.x; cwv[j][1] = a.y; cwv[j][2] = a.z; cwv[j][3] = a.w; cwv[j][4] = bq.x; cwv[j][5] = bq.y; cwv[j][6] = bq.z; cwv[j][7] = bq.w; }
            float r0[8], r1[8], r2[8], r3[8];
            if (bat) { const float* cs = p.in[2] + (size_t)(8 * b + run) * 3 * QKVW + ch;
#pragma unroll
                for (int e = 0; e < 8; ++e) { r0[e] = cs[e]; r1[e] = cs[QKVW + e]; r2[e] = cs[2 * QKVW + e]; }
            } else if (run == 0) {
#pragma unroll
                for (int e = 0; e < 8; ++e) { r0[e] = sHalo[hb * 960 + 0 * 320 + cg_ * 8 + e]; r1[e] = sHalo[hb * 960 + 320 + cg_ * 8 + e]; r2[e] = sHalo[hb * 960 + 640 + cg_ * 8 + e]; }
            } else {
                unpack8(nraw[0], r0); unpack8(nraw[1], r1); unpack8(nraw[2], r2);
            }
#pragma unroll
            for (int tt = 0; tt < 8; ++tt) {
                unpack8(nraw[3 + tt], r3);
#pragma unroll
                for (int e = 0; e < 8; ++e) { const float x = cwv[0][e] * r0[e] + cwv[1][e] * r1[e] + cwv[2][e] * r2[e] + cwv[3][e] * r3[e]; val[tt][e] = siluf_(x); }
#pragma unroll
                for (int e = 0; e < 8; ++e) { r0[e] = r1[e]; r1[e] = r2[e]; r2[e] = r3[e]; }
            }
            if (bat) { if (cg_ >= 32 || dvh == 0) { float* co = p.out + O_CONVS + (size_t)(8 * b + run) * 3 * QKVW + ch;
#pragma unroll
                    for (int e = 0; e < 8; ++e) { co[e] = r0[e]; co[QKVW + e] = r1[e]; co[2 * QKVW + e] = r2[e]; } }
            } else if (run * 8 + 8 == C) {
#pragma unroll
                for (int e = 0; e < 8; ++e) { sHalo[(hb ^ 1) * 960 + cg_ * 8 + e] = r0[e]; sHalo[(hb ^ 1) * 960 + 320 + cg_ * 8 + e] = r1[e]; sHalo[(hb ^ 1) * 960 + 640 + cg_ * 8 + e] = r2[e]; }
            }
        } else {
#pragma unroll
            for (int tt = 0; tt < 8; ++tt)
#pragma unroll
                for (int e = 0; e < 8; ++e) val[tt][e] = 0.f;
        }
        if (t0 + 64 < T) DN_LOADRAW(t0 + 64);
#pragma unroll
        for (int tt = 0; tt < 8; ++tt) {
            float ss = 0.f;
#pragma unroll
            for (int e = 0; e < 8; ++e) ss += val[tt][e] * val[tt][e];
            ss = red16(ss);
            float sc = 1.f;
            if (cg_ < 32) { sc = rsqrtf_(ss + 1e-6f); if (cg_ < 16) sc *= 0.08838834764831845f; }
#pragma unroll
            for (int e = 0; e < 8; ++e) val[tt][e] *= sc;
        }
        if (act) {
            if (cg_ < 16) {
#pragma unroll
                for (int tt = 0; tt < 8; ++tt) *(LAS u32x4*)(sQ + (run * 8 + tt) * 136 + cg_ * 8) = pack8(val[tt]);
            } else if (cg_ < 32) {
#pragma unroll
                for (int tt = 0; tt < 8; ++tt) *(LAS u32x4*)(sK + (run * 8 + tt) * 136 + (cg_ - 16) * 8) = pack8(val[tt]);
#pragma unroll
                for (int e = 0; e < 8; ++e) { float col[8];
#pragma unroll
                    for (int tt = 0; tt < 8; ++tt) col[tt] = val[tt][e];
                    *(LAS u32x4*)(sKT + ((cg_ - 16) * 8 + e) * 72 + run * 8) = pack8(col); }
            } else {
#pragma unroll
                for (int tt = 0; tt < 8; ++tt) *(LAS u32x4*)(sV + (run * 8 + tt) * 72 + (cg_ - 32) * 8) = pack8(val[tt]);
            }
        }
        hb ^= 1;
        __syncthreads();
        {
            for (int i = tid; i < 64 * 17; i += 512) ((LAS f32x4*)sX)[i] = (f32x4){0.f, 0.f, 0.f, 0.f};
            const int type = w >> 2, ti = (w >> 1) & 1, tj = w & 1;
            f32x16 acc;
#pragma unroll
            for (int reg = 0; reg < 16; ++reg) acc[reg] = 0.f;
            if (!(ti == 0 && tj == 1)) mma32<8>(acc, sK + 32 * tj * 136, 136, (type ? sQ : sK) + 32 * ti * 136, 136, lane);
            const int i = 32 * ti + (lane & 31); const float Gi = sG[i], bi = sBeta[i];
#pragma unroll
            for (int g4 = 0; g4 < 4; ++g4) { const int j0 = 32 * tj + 8 * g4 + 4 * hh; float o4[4];
#pragma unroll
                for (int e = 0; e < 4; ++e) { const int j = j0 + e; const float dec = __expf(fminf(Gi - sG[j], 0.f));
                    const bool same = !bat || ((i >> 3) == (j >> 3));
                    o4[e] = (type == 0) ? ((i > j && same) ? bi * acc[4 * g4 + e] * dec : 0.f) : ((i >= j && same) ? acc[4 * g4 + e] * dec : 0.f); }
                if (type == 0) *(LAS f32x4*)(sA + i * 68 + j0) = (f32x4){o4[0], o4[1], o4[2], o4[3]};
                else { u32x2 v; v.x = pk2(o4[0], o4[1]); v.y = pk2(o4[2], o4[3]); *(LAS u32x2*)(sAqk + i * 72 + j0) = v; } }
        }
        __syncthreads();
        tri_inverse(sA, sX, sM, sTi, tid, bat ? 8 : C);
        f32x16 accO;
        {
            const int ti = (w >> 1) & 1, tj = w & 1;
            f32x16 acc;
#pragma unroll
            for (int reg = 0; reg < 16; ++reg) acc[reg] = 0.f;
            if (!bat) mma32<8>(acc, ((w < 4) ? sK : sQ) + 32 * ti * 136, 136, sST + 32 * tj * 136, 136, lane);
            else {
#pragma unroll
                for (int q = 0; q < 4; ++q) { f32x16 aq;
#pragma unroll
                    for (int reg = 0; reg < 16; ++reg) aq[reg] = 0.f;
                    mma32_gBk<8>(aq, ((w < 4) ? sK : sQ) + 32 * ti * 136, 136, p.in[3] + (size_t)((8 * b + 4 * ti + q) * 8 + h) * 16384 + dvh * 64 + 32 * tj, 128, lane);
#pragma unroll
                    for (int e = 0; e < 4; ++e) acc[4 * q + e] = aq[4 * q + e]; }
            }
            const int j = 32 * tj + (lane & 31);
            if (w < 4) {
#pragma unroll
                for (int g4 = 0; g4 < 4; ++g4) { float rr[4];
#pragma unroll
                    for (int e = 0; e < 4; ++e) { const int i = 32 * ti + 8 * g4 + 4 * hh + e; rr[e] = sBeta[i] * (bflo((unsigned)sV[i * 72 + j]) - __expf(sG[i]) * acc[4 * g4 + e]); }
                    u32x2 v; v.x = pk2(rr[0], rr[1]); v.y = pk2(rr[2], rr[3]);
                    *(LAS u32x2*)(sRT + j * 72 + 32 * ti + 8 * g4 + 4 * hh) = v; }
            } else {
#pragma unroll
                for (int reg = 0; reg < 16; ++reg) { const int i = 32 * ti + crow(reg, hh); accO[reg] = __expf(sG[i]) * acc[reg]; }
            }
        }
        __syncthreads();
        if (w < 4) {
            const int ti = (w >> 1) & 1, tj = w & 1;
            f32x16 acc;
#pragma unroll
            for (int reg = 0; reg < 16; ++reg) acc[reg] = 0.f;
            mma32<4>(acc, sTi + 32 * ti * 72, 72, sRT + 32 * tj * 72, 72, lane);
            const int j = 32 * tj + (lane & 31);
#pragma unroll
            for (int g4 = 0; g4 < 4; ++g4) { float d[4];
#pragma unroll
                for (int e = 0; e < 4; ++e) { const int i = 32 * ti + 8 * g4 + 4 * hh + e; d[e] = acc[4 * g4 + e] * __expf(sG[bat ? (i | 7) : 63] - sG[i]); }
                u32x2 v; v.x = pk2(acc[4 * g4], acc[4 * g4 + 1]); v.y = pk2(acc[4 * g4 + 2], acc[4 * g4 + 3]);
                u32x2 vd; vd.x = pk2(d[0], d[1]); vd.y = pk2(d[2], d[3]);
                *(LAS u32x2*)(sUT + j * 72 + 32 * ti + 8 * g4 + 4 * hh) = v;
                *(LAS u32x2*)(sUdT + j * 72 + 32 * ti + 8 * g4 + 4 * hh) = vd; }
        }
        __syncthreads();
        if (w >= 4) {
            const int ti = (w >> 1) & 1, tj = w & 1;
            mma32<4>(accO, sAqk + 32 * ti * 72, 72, sUT + 32 * tj * 72, 72, lane);
            bf16_t* ob = QKVo + (size_t)(row0 + t0) * QKVW + 2048 + h * 128 + dvh * 64 + 32 * tj + (lane & 31);
#pragma unroll
            for (int reg = 0; reg < 16; ++reg) { const int i = 32 * ti + crow(reg, hh); if (i < C) ob[(size_t)i * QKVW] = (bf16_t)f2bf(accO[reg]); }
        }
        if (!bat) {
            const float gl = __expf(sG[63]);
#pragma unroll
            for (int reg = 0; reg < 16; ++reg) accS[reg] *= gl;
            mma32<4>(accS, sKT + 32 * aS * 72, 72, sUdT + 32 * tjS * 72, 72, lane);
#pragma unroll
            for (int g4 = 0; g4 < 4; ++g4) { u32x2 v; v.x = pk2(accS[4 * g4], accS[4 * g4 + 1]); v.y = pk2(accS[4 * g4 + 2], accS[4 * g4 + 3]);
                *(LAS u32x2*)(sST + (32 * tjS + (lane & 31)) * 136 + 32 * aS + 8 * g4 + 4 * hh) = v; }
        } else {
            const int sq = w, mk = sq >> 1; const bool minef = (hh == (sq & 1)); const float gl = __expf(sG[8 * sq + 7]);
            const float* st0 = p.in[3] + (size_t)((8 * b + sq) * 8 + h) * 16384 + dvh * 64; float* so0 = p.out + O_DNS + (size_t)((8 * b + sq) * 8 + h) * 16384 + dvh * 64;
#pragma unroll
            for (int a2_ = 0; a2_ < 4; ++a2_) { f32x16 ah0, ah1; const int v = lane & 31;
#pragma unroll
                for (int reg = 0; reg < 16; ++reg) { const float* sp = st0 + (size_t)(32 * a2_ + crow(reg, hh)) * 128 + v; ah0[reg] = sp[0]; ah1[reg] = sp[32]; }
                __builtin_amdgcn_sched_barrier(0);
                const u32x4 z4 = (u32x4){0u, 0u, 0u, 0u};
                const u32x4 ka = minef ? *(const LAS u32x4*)(sKT + (32 * a2_ + (lane & 31)) * 72 + 16 * mk + 8 * hh) : z4;
                const bf16x8 ub0 = *(const LAS bf16x8*)(sUdT + (lane & 31) * 72 + 16 * mk + 8 * hh), ub1 = *(const LAS bf16x8*)(sUdT + (32 + (lane & 31)) * 72 + 16 * mk + 8 * hh);
#pragma unroll
                for (int reg = 0; reg < 16; ++reg) { ah0[reg] *= gl; ah1[reg] *= gl; }
                ah0 = __builtin_amdgcn_mfma_f32_32x32x16_bf16(__builtin_bit_cast(bf16x8, ka), ub0, ah0, 0, 0, 0);
                ah1 = __builtin_amdgcn_mfma_f32_32x32x16_bf16(__builtin_bit_cast(bf16x8, ka), ub1, ah1, 0, 0, 0);
#pragma unroll
                for (int reg = 0; reg < 16; ++reg) { float* dp = so0 + (size_t)(32 * a2_ + crow(reg, hh)) * 128 + v; dp[0] = ah0[reg]; dp[32] = ah1[reg]; } }
        }
        __syncthreads();
    }
    if (prompt) {
        const int tid = otid(), lane = tid & 63, hh = lane >> 5;
        float* so = p.out + (prompt ? O_DNP : O_DNS) + ((size_t)(b * 8 + h) * 128) * 128 + dvh * 64 + 32 * tjS + (lane & 31);
#pragma unroll
        for (int reg = 0; reg < 16; ++reg) so[(size_t)(32 * aS + crow(reg, hh)) * 128] = accS[reg];
    }
    float* co = p.out + (prompt ? O_CONVP : O_CONVS) + (size_t)b * 3 * QKVW;
    for (int idx = otid(); idx < 960; idx += 512) {
        if (!prompt) break;
        const int j = idx / 320, c = idx - j * 320; const int cgi = c >> 3, e = c & 7;
        if (cgi < 32 && dvh != 0) continue;
        int chh; if (cgi < 16) chh = h * 128 + cgi * 8; else if (cgi < 32) chh = 1024 + h * 128 + (cgi - 16) * 8; else chh = 2048 + h * 128 + dvh * 64 + (cgi - 32) * 8;
        co[(size_t)j * QKVW + chh + e] = sHalo[hb * 960 + idx];
    }
    __syncthreads();
}

template <int KS> DI void mma32_gB(f32x16& acc, const LAS bf16_t* A, int lda, const float* Bt, int ldb, int lane) {
    const int r = lane & 31, hh = lane >> 5;
    const LAS bf16_t* pa = A + r * lda + 8 * hh; const float* pb = Bt + (size_t)r * ldb + 8 * hh;
    f32x4 b0[KS], b1[KS];
#pragma unroll
    for (int ks = 0; ks < KS; ++ks) { b0[ks] = *(const f32x4*)(pb + 16 * ks); b1[ks] = *(const f32x4*)(pb + 16 * ks + 4); }
    __builtin_amdgcn_sched_barrier(0);
#pragma unroll
    for (int ks = 0; ks < KS; ++ks) { const bf16x8 a = *(const LAS bf16x8*)(pa + 16 * ks);
        u32x4 bw; bw.x = pk2(b0[ks].x, b0[ks].y); bw.y = pk2(b0[ks].z, b0[ks].w); bw.z = pk2(b1[ks].x, b1[ks].y); bw.w = pk2(b1[ks].z, b1[ks].w);
        acc = __builtin_amdgcn_mfma_f32_32x32x16_bf16(a, __builtin_bit_cast(bf16x8, bw), acc, 0, 0, 0); }
}
DI void rw_item(const Params& p, LAS unsigned char* lds, int b, int h, bool prompt) {
    const bool bat = !prompt;
    const int tid0 = otid(), w = __builtin_amdgcn_readfirstlane(tid0 >> 6);
    LAS bf16_t* sAt = (LAS bf16_t*)(lds);
    LAS bf16_t* sRt = (LAS bf16_t*)(lds + 9216);
    LAS bf16_t* sKt = (LAS bf16_t*)(lds + 18432);
    LAS bf16_t* sRT = sKt;
    LAS bf16_t* sBt = (LAS bf16_t*)(lds + 27648);
    LAS bf16_t* sYT = sBt;
    LAS bf16_t* sW2T = (LAS bf16_t*)(lds + 36864);
    LAS bf16_t* sKdT = (LAS bf16_t*)(lds + 128000);
    LAS bf16_t* sA2T = (LAS bf16_t*)(lds + 46080);
    LAS bf16_t* sNBdT = (LAS bf16_t*)(lds + 137216);
    LAS bf16_t* sVT = (LAS bf16_t*)(lds + 55296);
    LAS bf16_t* sAak = (LAS bf16_t*)(lds + 64512);
    LAS bf16_t* sArk = (LAS bf16_t*)(lds + 73728);
    LAS bf16_t* sNArb = (LAS bf16_t*)(lds + 82944);
    LAS bf16_t* sTi = (LAS bf16_t*)(lds + 92160);
    LAS bf16_t* sST = (LAS bf16_t*)(lds + 101376);
    LAS float* sA = (LAS float*)(lds + 110592);
    LAS float* sO = sA; LAS float* sLw = sA;
    LAS bf16_t* sTWb = sAak; LAS bf16_t* sALb = sArk;
    LAS float* sX = (LAS float*)(lds + 128000);
    LAS float* sLa = sX; LAS float* sL = sX;
    LAS float* sM = (LAS float*)(lds + 145408);
    LAS float* sPrev = (LAS float*)(lds + 150016);
    LAS float* sPC = (LAS float*)(lds + 153600);
    LAS float* sBonus = (LAS float*)(lds + 153856);
    LAS float* sPCb = (LAS float*)(lds + 154112);
    LAS float* sCst = (LAS float*)(lds + 156160);
    const int T = prompt ? TP : 64, row0 = prompt ? b * TP : MPR + b * 64;
    bf16_t* RW = (bf16_t*)(p.ws + WS_RW);
    const float* mu = p.in[13];
    const int aS = (w >> 1) & 1, tjS = w & 1;
    f32x16 accH;
    {
        const int lane = tid0 & 63, hh = lane >> 5;
#pragma unroll
        for (int reg = 0; reg < 16; ++reg) accH[reg] = 0.f;
        if (w < 4) {
#pragma unroll
            for (int g4 = 0; g4 < 4; ++g4) { u32x2 v; v.x = pk2(accH[4 * g4], accH[4 * g4 + 1]); v.y = pk2(accH[4 * g4 + 2], accH[4 * g4 + 3]);
                *(LAS u32x2*)(sST + (32 * tjS + (lane & 31)) * 72 + 32 * aS + 8 * g4 + 4 * hh) = v; }
        }
    }
    for (int idx = tid0; idx < 768; idx += 512) { const int k = idx >> 6, c = idx & 63; float v;
        if (k < 3) v = p.in[13][k * 1024 + h * 64 + c]; else if (k == 3) v = p.in[13][3072 + c]; else if (k == 4) v = p.in[13][3136 + c];
        else { const int ii = (k == 5) ? 14 : (k == 6) ? 16 : (k == 7) ? 19 : (k == 8) ? 20 : (k == 9) ? 21 : (k == 10) ? 22 : 23; v = p.in[ii][h * 64 + c]; }
        sCst[idx] = v; }
    for (int idx = tid0; idx < 4096; idx += 512) { const int j = idx >> 6, c = idx & 63;
        sW2T[c * 72 + j] = (bf16_t)f2bf(p.in[15][(size_t)j * 1024 + h * 64 + c]); sA2T[c * 72 + j] = (bf16_t)f2bf(p.in[17][(size_t)j * 1024 + h * 64 + c]); }
    for (int i = tid0; i < 448; i += 512) {
        int col; if (i < 64) col = h * 64 + i; else if (i < 128) col = 1024 + h * 64 + (i - 64); else if (i < 192) col = 2048 + h * 64 + (i - 128); else col = 3072 + (i - 192);
        sPrev[i] = 0.f;
    }
    __syncthreads();
    int pb = 0;
    u32x4 ncu[5], npv[5];
#define RW_LOADRAW(T0N) do { const int ti_ = otid(); const int t_ = ti_ >> 3, pa_ = ti_ & 7; const int Cn_ = (T - (T0N)) < 64 ? (T - (T0N)) : 64; \
        if (t_ < Cn_) { const size_t r_ = (size_t)(row0 + (T0N) + t_); const int cb_[5] = {h * 64 + 8 * pa_, 1024 + h * 64 + 8 * pa_, 2048 + h * 64 + 8 * pa_, 3072 + 8 * pa_, 3136 + 8 * pa_}; \
            _Pragma("unroll") for (int s_ = 0; s_ < 5; ++s_) { ncu[s_] = *(const u32x4*)(RW + r_ * RWW + cb_[s_]); \
                if (t_ > 0 && !(bat && (t_ & 7) == 0)) npv[s_] = *(const u32x4*)(RW + (r_ - 1) * RWW + cb_[s_]); } } } while (0)
    RW_LOADRAW(0);
    for (int t0 = 0; t0 < T; t0 += 64) {
        const int C = (T - t0) < 64 ? (T - t0) : 64;
        const int tid = otid(), lane = tid & 63, hh = lane >> 5;
        const int t = tid >> 3, part = tid & 7;
        const int cb[5] = {h * 64 + 8 * part, 1024 + h * 64 + 8 * part, 2048 + h * 64 + 8 * part, 3072 + 8 * part, 3136 + 8 * part};
        const bool actv = t < C;
        const size_t row = (size_t)(row0 + t0 + t);
        float xr[8], kr[8], vv[8];
#pragma unroll
        for (int e = 0; e < 8; ++e) { xr[e] = 0.f; kr[e] = 0.f; vv[e] = 0.f; }
        if (actv) {
#pragma unroll
            for (int s = 0; s < 5; ++s) {
                float cur[8], prv[8];
                unpack8(ncu[s], cur);
                if (t > 0 && !(bat && (t & 7) == 0)) unpack8(npv[s], prv);
                else if (bat) { const float* sp = p.in[4] + (size_t)(8 * b + (t >> 3)) * RWW + cb[s]; const f32x4 q0 = *(const f32x4*)sp, q1 = *(const f32x4*)(sp + 4);
                    prv[0] = q0.x; prv[1] = q0.y; prv[2] = q0.z; prv[3] = q0.w; prv[4] = q1.x; prv[5] = q1.y; prv[6] = q1.z; prv[7] = q1.w; }
                else {
#pragma unroll
                    for (int e = 0; e < 8; ++e) prv[e] = sPrev[pb * 448 + s * 64 + 8 * part + e];
                }
                if (bat) { if ((t & 7) == 7 && (s < 3 || h == 0)) { float* so = p.out + O_SHIFTS + (size_t)(8 * b + (t >> 3)) * RWW + cb[s];
                        *(f32x4*)so = (f32x4){cur[0], cur[1], cur[2], cur[3]}; *(f32x4*)(so + 4) = (f32x4){cur[4], cur[5], cur[6], cur[7]}; } }
                else if (t == C - 1) {
#pragma unroll
                    for (int e = 0; e < 8; ++e) sPrev[(pb ^ 1) * 448 + s * 64 + 8 * part + e] = cur[e];
                }
                const f32x4 m0 = *(const LAS f32x4*)(sCst + s * 64 + 8 * part), m1 = *(const LAS f32x4*)(sCst + s * 64 + 8 * part + 4);
                const float mm[8] = {m0.x, m0.y, m0.z, m0.w, m1.x, m1.y, m1.z, m1.w};
                float xm[8];
#pragma unroll
                for (int e = 0; e < 8; ++e) xm[e] = cur[e] + (prv[e] - cur[e]) * mm[e];
                if (s == 0) {
#pragma unroll
                    for (int e = 0; e < 8; ++e) xr[e] = xm[e];
                } else if (s == 1) {
#pragma unroll
                    for (int e = 0; e < 8; ++e) kr[e] = xm[e];
                } else if (s == 2) {
#pragma unroll
                    for (int e = 0; e < 8; ++e) vv[e] = xm[e];
                } else if (s == 3) {
#pragma unroll
                    for (int e = 0; e < 8; ++e) xm[e] = tanhf_(xm[e]);
                    *(LAS u32x4*)(sTWb + t * 72 + 8 * part) = pack8(xm);
                } else {
                    *(LAS u32x4*)(sALb + t * 72 + 8 * part) = pack8(xm);
                }
            }
        }
        if (t0 + 64 < T) RW_LOADRAW(t0 + 64);
        if (!actv) { const u32x4 z = (u32x4){0u, 0u, 0u, 0u}; *(LAS u32x4*)(sTWb + t * 72 + 8 * part) = z; *(LAS u32x4*)(sALb + t * 72 + 8 * part) = z; }
        __syncthreads();
        {
            const int mat = w >> 2, ti = (w >> 1) & 1, tj = w & 1;
            f32x16 acc;
#pragma unroll
            for (int reg = 0; reg < 16; ++reg) acc[reg] = 0.f;
            mma32<4>(acc, (mat ? sALb : sTWb) + 32 * ti * 72, 72, (mat ? sA2T : sW2T) + 32 * tj * 72, 72, lane);
            LAS float* dstl = mat ? sLa : sLw; const int j = 32 * tj + (lane & 31);
#pragma unroll
            for (int reg = 0; reg < 16; ++reg) dstl[(32 * ti + crow(reg, hh)) * 65 + j] = acc[reg];
        }
        __syncthreads();
        float lw[8], kk[8], bb[8], kn[8]; float bonus = 0.f;
        {
            float n2 = 0.f, a_[8], kkr[8];
            if (actv) {
                float ws_[8], as_[8];
#pragma unroll
                for (int e = 0; e < 8; ++e) { ws_[e] = sLw[t * 65 + 8 * part + e]; as_[e] = sLa[t * 65 + 8 * part + e]; }
                const int c0 = h * 64 + 8 * part;
#pragma unroll
                for (int e = 0; e < 8; ++e) {
                    lw[e] = -0.6065306597126334f * sigmoidf_(sCst[5 * 64 + 8 * part + e] + ws_[e]);
                    a_[e] = sigmoidf_(sCst[6 * 64 + 8 * part + e] + as_[e]);
                    kkr[e] = kr[e] * sCst[7 * 64 + 8 * part + e]; n2 += kkr[e] * kkr[e];
                    kn[e] = kr[e] * (1.f + (a_[e] - 1.f) * sCst[8 * 64 + 8 * part + e]);
                    bonus += xr[e] * kn[e] * sCst[9 * 64 + 8 * part + e];
                }
            } else {
#pragma unroll
                for (int e = 0; e < 8; ++e) { lw[e] = 0.f; a_[e] = 0.f; kkr[e] = 0.f; kn[e] = 0.f; }
            }
            n2 = red8(n2); bonus = red8(bonus);
            const float rn = rsqrtf_(n2 + 1e-6f);
#pragma unroll
            for (int e = 0; e < 8; ++e) { kk[e] = kkr[e] * rn; bb[e] = kk[e] * a_[e]; }
        }
#pragma unroll
        for (int e = 0; e < 8; ++e) sL[t * 65 + 8 * part + e] = lw[e];
        __syncthreads();
        {
            float x[8];
#pragma unroll
            for (int e = 0; e < 8; ++e) x[e] = sL[lane * 65 + 8 * w + e];
#define DPP_ADD(ctrl, rmask) do { _Pragma("unroll") for (int e = 0; e < 8; ++e) { \
                const float t_ = __builtin_bit_cast(float, __builtin_amdgcn_update_dpp(0, __builtin_bit_cast(int, x[e]), (ctrl), (rmask), 0xf, false)); x[e] += keep ? t_ : 0.f; } } while (0)
            { bool keep = !bat || (lane & 7) >= 1; DPP_ADD(0x111, 0xf); }
            { bool keep = !bat || (lane & 7) >= 2; DPP_ADD(0x112, 0xf); }
            { bool keep = !bat || (lane & 7) >= 4; DPP_ADD(0x114, 0xf); }
            if (!bat) { const bool keep = true; DPP_ADD(0x118, 0xf); DPP_ADD(0x142, 0xa); DPP_ADD(0x143, 0xc); }
#undef DPP_ADD
#pragma unroll
            for (int e = 0; e < 8; ++e) sL[lane * 65 + 8 * w + e] = x[e];
        }
        __syncthreads();
        float kd[8], nbd[8];
        {
            float at[8], rt[8], kt[8], bt[8];
#pragma unroll
            for (int e = 0; e < 8; ++e) {
                const int c = 8 * part + e;
                const float Lt = sL[t * 65 + c], Lp = ((bat ? (t & 7) : t) > 0) ? sL[(t - 1) * 65 + c] : 0.f, Lc = sL[(bat ? (t | 7) : 63) * 65 + c];
                const float ep = __expf(Lp), et = __expf(Lt), ei = __expf(-Lt), ec = __expf(Lc - Lt);
                at[e] = kk[e] * ep; rt[e] = xr[e] * et; kt[e] = kn[e] * ei; bt[e] = bb[e] * ei;
                kd[e] = kn[e] * ec; nbd[e] = -bb[e] * ec; sVT[c * 72 + t] = (bf16_t)f2bf(vv[e]);
                if (t == 0) sPC[c] = __expf(Lc);
                if (bat && (t & 7) == 0) sPCb[(t >> 3) * 64 + c] = __expf(Lc);
            }
            *(LAS u32x4*)(sAt + t * 72 + 8 * part) = pack8(at); *(LAS u32x4*)(sRt + t * 72 + 8 * part) = pack8(rt);
            *(LAS u32x4*)(sKt + t * 72 + 8 * part) = pack8(kt); *(LAS u32x4*)(sBt + t * 72 + 8 * part) = pack8(bt);
            if (part == 0) sBonus[t] = bonus;
        }
        pb ^= 1;
        __syncthreads();
        {
            for (int i = tid; i < 64 * 17; i += 512) ((LAS f32x4*)sX)[i] = (f32x4){0.f, 0.f, 0.f, 0.f};
            const int m = w >> 1, q = w & 1;
            const LAS bf16_t* Aop = (m < 2) ? sAt : sRt; const LAS bf16_t* Bop = (m == 0 || m == 3) ? sBt : sKt;
            LAS bf16_t* dst = (m == 1) ? sAak : (m == 2 ? sArk : sNArb);
#pragma unroll
            for (int rep = 0; rep < 2; ++rep) {
                int ti, tj; bool zero = false;
                if (q == 0) { ti = rep; tj = rep; } else { ti = 1 - rep; tj = rep; if (rep == 1) { ti = 0; tj = 1; zero = true; } }
                f32x16 acc;
#pragma unroll
                for (int reg = 0; reg < 16; ++reg) acc[reg] = 0.f;
                if (!zero) mma32<4>(acc, Bop + 32 * tj * 72, 72, Aop + 32 * ti * 72, 72, lane);
                const int i = 32 * ti + (lane & 31);
#pragma unroll
                for (int g4 = 0; g4 < 4; ++g4) { const int j0 = 32 * tj + 8 * g4 + 4 * hh; float o4[4];
#pragma unroll
                    for (int e = 0; e < 4; ++e) { const int j = j0 + e; const float a = acc[4 * g4 + e];
                        const bool same = !bat || ((i >> 3) == (j >> 3));
                        o4[e] = (m < 2) ? ((i > j && same) ? a : 0.f) : ((i >= j && same) ? (m == 2 ? a : -a) : 0.f); }
                    if (m == 0) { if (!zero) *(LAS f32x4*)(sA + i * 68 + j0) = (f32x4){o4[0], o4[1], o4[2], o4[3]}; }
                    else { u32x2 v; v.x = pk2(o4[0], o4[1]); v.y = pk2(o4[2], o4[3]); *(LAS u32x2*)(dst + i * 72 + j0) = v; } }
            }
        }
        __syncthreads();
        tri_inverse(sA, sX, sM, sTi, tid, bat ? 8 : C);
        f32x16 accO;
        {
            const int ti = (w >> 1) & 1, tj = w & 1;
            f32x16 acc;
#pragma unroll
            for (int reg = 0; reg < 16; ++reg) acc[reg] = 0.f;
            if (!bat) mma32<4>(acc, ((w < 4) ? sAt : sRt) + 32 * ti * 72, 72, sST + 32 * tj * 72, 72, lane);
            else {
#pragma unroll
                for (int q = 0; q < 4; ++q) { f32x16 aq;
#pragma unroll
                    for (int reg = 0; reg < 16; ++reg) aq[reg] = 0.f;
                    mma32_gB<4>(aq, ((w < 4) ? sAt : sRt) + 32 * ti * 72, 72, p.in[5] + ((size_t)((8 * b + 4 * ti + q) * 16 + h) * 64 + 32 * tj) * 64, 64, lane);
#pragma unroll
                    for (int e = 0; e < 4; ++e) acc[4 * q + e] = aq[4 * q + e]; }
            }
            mma32<4>(acc, ((w < 4) ? sAak : sArk) + 32 * ti * 72, 72, sVT + 32 * tj * 72, 72, lane);
            if (w < 4) {
                const int j = 32 * tj + (lane & 31);
#pragma unroll
                for (int g4 = 0; g4 < 4; ++g4) { u32x2 v; v.x = pk2(acc[4 * g4], acc[4 * g4 + 1]); v.y = pk2(acc[4 * g4 + 2], acc[4 * g4 + 3]);
                    *(LAS u32x2*)(sRT + j * 72 + 32 * ti + 8 * g4 + 4 * hh) = v; }
            } else accO = acc;
        }
        __syncthreads();
#pragma unroll
        for (int e = 0; e < 8; ++e) { const int c = 8 * part + e; sKdT[c * 72 + t] = (bf16_t)f2bf(kd[e]); sNBdT[c * 72 + t] = (bf16_t)f2bf(nbd[e]); }
        if (w < 4) {
            const int ti = (w >> 1) & 1, tj = w & 1;
            f32x16 acc;
#pragma unroll
            for (int reg = 0; reg < 16; ++reg) acc[reg] = 0.f;
            mma32<4>(acc, sTi + 32 * ti * 72, 72, sRT + 32 * tj * 72, 72, lane);
            const int j = 32 * tj + (lane & 31);
#pragma unroll
            for (int g4 = 0; g4 < 4; ++g4) { u32x2 v; v.x = pk2(acc[4 * g4], acc[4 * g4 + 1]); v.y = pk2(acc[4 * g4 + 2], acc[4 * g4 + 3]);
                *(LAS u32x2*)(sYT + j * 72 + 32 * ti + 8 * g4 + 4 * hh) = v; }
        }
        __syncthreads();
        if (w >= 4) {
            const int ti = (w >> 1) & 1, tj = w & 1;
            mma32<4>(accO, sNArb + 32 * ti * 72, 72, sYT + 32 * tj * 72, 72, lane);
            const int j = 32 * tj + (lane & 31);
#pragma unroll
            for (int reg = 0; reg < 16; ++reg) sO[(32 * ti + crow(reg, hh)) * 65 + j] = accO[reg];
        } else if (!bat) {
#pragma unroll
            for (int reg = 0; reg < 16; ++reg) accH[reg] *= sPC[32 * aS + crow(reg, hh)];
            mma32<4>(accH, sKdT + 32 * aS * 72, 72, sVT + 32 * tjS * 72, 72, lane);
            mma32<4>(accH, sNBdT + 32 * aS * 72, 72, sYT + 32 * tjS * 72, 72, lane);
#pragma unroll
            for (int g4 = 0; g4 < 4; ++g4) { u32x2 v; v.x = pk2(accH[4 * g4], accH[4 * g4 + 1]); v.y = pk2(accH[4 * g4 + 2], accH[4 * g4 + 3]);
                *(LAS u32x2*)(sST + (32 * tjS + (lane & 31)) * 72 + 32 * aS + 8 * g4 + 4 * hh) = v; }
        }
        if (bat) {
            const int sq = w, mk = sq >> 1; const bool mine = (hh == (sq & 1));
            const float* st0 = p.in[5] + (size_t)((8 * b + sq) * 16 + h) * 4096; float* so0 = p.out + O_RWS + (size_t)((8 * b + sq) * 16 + h) * 4096;
#pragma unroll
            for (int a2_ = 0; a2_ < 2; ++a2_)
#pragma unroll
                for (int tj2 = 0; tj2 < 2; ++tj2) { f32x16 ah; const int v = 32 * tj2 + (lane & 31);
#pragma unroll
                    for (int reg = 0; reg < 16; ++reg) { const int k = 32 * a2_ + crow(reg, hh); ah[reg] = sPCb[sq * 64 + k] * st0[v * 64 + k]; }
                    const u32x4 z4 = (u32x4){0u, 0u, 0u, 0u};
                    const u32x4 ka = mine ? *(const LAS u32x4*)(sKdT + (32 * a2_ + (lane & 31)) * 72 + 16 * mk + 8 * hh) : z4;
                    const u32x4 na = mine ? *(const LAS u32x4*)(sNBdT + (32 * a2_ + (lane & 31)) * 72 + 16 * mk + 8 * hh) : z4;
                    const bf16x8 vb = *(const LAS bf16x8*)(sVT + (32 * tj2 + (lane & 31)) * 72 + 16 * mk + 8 * hh);
                    const bf16x8 yb = *(const LAS bf16x8*)(sYT + (32 * tj2 + (lane & 31)) * 72 + 16 * mk + 8 * hh);
                    ah = __builtin_amdgcn_mfma_f32_32x32x16_bf16(__builtin_bit_cast(bf16x8, ka), vb, ah, 0, 0, 0);
                    ah = __builtin_amdgcn_mfma_f32_32x32x16_bf16(__builtin_bit_cast(bf16x8, na), yb, ah, 0, 0, 0);
#pragma unroll
                    for (int reg = 0; reg < 16; ++reg) { const int k = 32 * a2_ + crow(reg, hh); so0[v * 64 + k] = ah[reg]; } }
        }
        __syncthreads();
        {
            float o[8]; float sm = 0.f;
#pragma unroll
            for (int e = 0; e < 8; ++e) { o[e] = actv ? sO[t * 65 + 8 * part + e] : 0.f; sm += o[e]; }
            sm = red8(sm);
            const float mean = sm * (1.f / 64.f); float vs = 0.f;
#pragma unroll
            for (int e = 0; e < 8; ++e) { o[e] -= mean; vs += o[e] * o[e]; }
            vs = red8(vs);
            const float rs = rsqrtf_(vs * (1.f / 64.f) + 64e-5f);
            if (actv) { const int c0 = h * 64 + 8 * part; const float bo = sBonus[t]; float y[8];
#pragma unroll
                for (int e = 0; e < 8; ++e) y[e] = o[e] * rs * sCst[10 * 64 + 8 * part + e] + sCst[11 * 64 + 8 * part + e] + bo * vv[e];
                *(u32x4*)(RW + row * RWW + 2048 + c0) = pack8(y); }
        }
        __syncthreads();
    }
    if (w < 4 && prompt) {
        const int tid = otid(), lane = tid & 63, hh = lane >> 5;
        float* so = p.out + (prompt ? O_RWP : O_RWS) + ((size_t)(b * 16 + h) * 64 + 32 * tjS + (lane & 31)) * 64 + 32 * aS;
#pragma unroll
        for (int reg = 0; reg < 16; ++reg) so[crow(reg, hh)] = accH[reg];
    }
    float* sh = p.out + (prompt ? O_SHIFTP : O_SHIFTS) + (size_t)b * RWW;
    if (h == 0) {
        const int ti_ = otid();
        if (prompt) { if (ti_ < 128) p.out[O_SHIFTP + (size_t)b * RWW + 3200 + ti_] = bflo((unsigned)RW[(size_t)(row0 + T - 1) * RWW + 3200 + ti_]); }
        else { for (int i = ti_; i < 8 * 128; i += 512) { const int sq = i >> 7, c = i & 127; p.out[O_SHIFTS + (size_t)(8 * b + sq) * RWW + 3200 + c] = bflo((unsigned)RW[(size_t)(row0 + 8 * sq + 7) * RWW + 3200 + c]); } }
    }
    for (int i = otid(); i < 448; i += 512) {
        if (!prompt) break;
        if (i >= 320) continue;
        if (i >= 192 && h != 0) continue;
        int col; if (i < 64) col = h * 64 + i; else if (i < 128) col = 1024 + h * 64 + (i - 64); else if (i < 192) col = 2048 + h * 64 + (i - 128); else col = 3072 + (i - 192);
        sh[col] = sPrev[pb * 448 + i];
    }
    __syncthreads();
}

DI void gate_item(const Params& p, int j) {
    const int tid = otid(), t = tid >> 3, part = tid & 7;
    const bf16_t* RW = (const bf16_t*)(p.ws + WS_RW); bf16_t* GA = (bf16_t*)(p.ws + WS_GA);
    const int row = 64 * j + t; if (row >= M) return;
    bool first; const float* sp = nullptr;
    if (row < MPR) first = (row % TP) == 0; else { first = ((row - MPR) & 7) == 0; sp = p.in[4] + (size_t)((row - MPR) >> 3) * RWW; }
    float g[16];
#pragma unroll
    for (int q = 0; q < 2; ++q) { const int c0 = 3200 + 16 * part + 8 * q; float cur[8], prv[8];
        load8bf(RW + (size_t)row * RWW + c0, cur);
        if (!first) load8bf(RW + (size_t)(row - 1) * RWW + c0, prv);
        else {
#pragma unroll
            for (int e = 0; e < 8; ++e) prv[e] = sp ? sp[c0 + e] : 0.f; }
#pragma unroll
        for (int e = 0; e < 8; ++e) g[8 * q + e] = sigmoidf_(cur[e] + (prv[e] - cur[e]) * p.in[13][c0 + e]); }
    *(u32x4*)(GA + (size_t)row * 128 + 16 * part) = pack8(g); *(u32x4*)(GA + (size_t)row * 128 + 16 * part + 8) = pack8(g + 8);
}
DI void phase_scan(const Params& p, LAS unsigned char* lds, unsigned long long* tfirst) {
    unsigned* ctr = (unsigned*)(p.ws + WS_CTL);
    LAS int* sItem = (LAS int*)(lds + LDS_BYTES - 16);
    const bool stat = gridDim.x >= 256;
    for (int it = 0;; ++it) {
        if (threadIdx.x == 0) *sItem = (stat && it == 0 && blockIdx.x < 256) ? (int)blockIdx.x : (stat ? 256 : 0) + (int)atomicAdd(ctr, 1u);
        __syncthreads();
        const int item = __builtin_amdgcn_readfirstlane(*sItem);
        __syncthreads();
#if PROBE_ITEM_BLOCK >= 0
        if (it == 1 && blockIdx.x == PROBE_ITEM_BLOCK) tfirst[1] = rtc();
#endif
        if (item >= 768 + 274) break;
        if (item >= 768) { gate_item(p, item - 768); continue; }
        bool prompt; int typ, j;
        if (item < 128) { typ = 0; j = item; prompt = true; } else if (item < 256) { typ = 1; j = item - 128; prompt = true; }
        else if (item < 512) { typ = 0; j = item - 256; prompt = false; } else { typ = 1; j = item - 512; prompt = false; }
        if (typ == 0) dn_item(p, lds, j >> 4, (j >> 1) & 7, j & 1, prompt);
        else rw_item(p, lds, j >> 4, j & 15, prompt);
    }
}

DI void phase_merge(const Params& p) {
    const bf16_t* QKV = (const bf16_t*)(p.ws + WS_QKV); const bf16_t* RW = (const bf16_t*)(p.ws + WS_RW);
    bf16_t* MIX = (bf16_t*)((unsigned char*)p.out + DO_H);
    const int gt = blockIdx.x * 512 + otid(), NT = gridDim.x * 512;
    for (int u = gt; u < M * 128; u += NT) {
        const int row = u >> 7, c = (u & 127) * 8;
        float o[8], z[8], ga[8], gb[8], orw[8], gate[8];
        load8bf(QKV + (size_t)row * QKVW + 2048 + c, o); load8bf(QKV + (size_t)row * QKVW + c, z); load8bf(QKV + (size_t)row * QKVW + 1024 + c, ga);
        load8bf(RW + (size_t)row * RWW + c, gb); load8bf(RW + (size_t)row * RWW + 2048 + c, orw); load8bf(RW + (size_t)row * RWW + 1024 + c, gate);
        float ss = 0.f;
#pragma unroll
        for (int e = 0; e < 8; ++e) ss += o[e] * o[e];
        ss = red16(ss);
        const float rs = rsqrtf_(ss * (1.f / 128.f) + 1e-6f);
        float mix[8];
#pragma unroll
        for (int e = 0; e < 8; ++e) { const float odn = o[e] * rs * p.in[12][(c & 127) + e] * siluf_(z[e]); mix[e] = sigmoidf_(ga[e]) * odn + sigmoidf_(gb[e]) * (orw[e] * gate[e]); }
        *(u32x4*)(MIX + (size_t)row * D + c) = pack8(mix);
    }
}
DI void build_slots(LAS int* sSlot, int tid) {
    for (int i = tid; i < 69 * 4; i += 512) sSlot[i] = -1;
    __syncthreads();
    pg8::StaticOrder S; S.init(MP, D, gridDim.x, 0, 16, 1);
    if (S.split && tid < S.nwg - S.G) { S.c = 4 * tid; pg8::Unit u; if (S.next(1, u)) sSlot[u.pm * 4 + u.pn] = tid; }
    __syncthreads();
}
DI void phase_norm2(const Params& p, LAS unsigned char* lds) {
    const int tid_ = otid(); const int lane = tid_ & 63, gw = blockIdx.x * 8 + (tid_ >> 6), NGW = gridDim.x * 8;
    const float* X1 = (const float*)(p.ws + WS_X1); bf16_t* H = (bf16_t*)((unsigned char*)p.out + DO_H);
    LAS int* sSlot = (LAS int*)lds; build_slots(sSlot, tid_);
    const float* part = (const float*)(p.ws + WS_PART);
    bf16_t* x1a = (bf16_t*)((unsigned char*)p.out + DO_X1B); bf16_t* x1b = (bf16_t*)(p.ws + WS_X1B2);
    auto x1row = [&](int m) { return m < X1B_SPLIT ? x1a + (size_t)m * D : x1b + (size_t)(m - X1B_SPLIT) * D; };
    unsigned long long nr[4];
    if (gw < M) { const bf16_t* r = x1row(gw);
#pragma unroll
        for (int j = 0; j < 4; ++j) nr[j] = *(const unsigned long long*)(r + 4 * lane + 256 * j); }
    for (int m = gw; m < M; m += NGW) { f32x4 v[4];
#pragma unroll
        for (int j = 0; j < 4; ++j) { const unsigned lo = (unsigned)nr[j], hi = (unsigned)(nr[j] >> 32); v[j] = (f32x4){bflo(lo), bfhi(lo), bflo(hi), bfhi(hi)}; }
        if (m + NGW < M) { const bf16_t* r = x1row(m + NGW);
#pragma unroll
            for (int j = 0; j < 4; ++j) nr[j] = *(const unsigned long long*)(r + 4 * lane + 256 * j); }
        rms_row(nullptr, p.in[25], H + (size_t)m * D, lane, v, part, sSlot + (m >> 8) * 4, m & 255, nullptr, true, x1row(m)); }
}
DI void phase_final(const Params& p, LAS unsigned char* lds) {
    const int tid_ = otid(); const int lane = tid_ & 63, gw = blockIdx.x * 8 + (tid_ >> 6), NGW = gridDim.x * 8;
    const float* X1 = (const float*)(p.ws + WS_X1);
    LAS int* sSlot = (LAS int*)lds; build_slots(sSlot, tid_);
    const float* part = (const float*)(p.ws + WS_PART);
    constexpr int NOUT = NBP * 2048 + NBS * TS;
    auto row_of = [](int o) { return o < NBP * 2048 ? (o >> 11) * TP + (o & 2047) + 16 : MPR + (o - NBP * 2048); };
    f32x4 nv[4];
    if (gw < NOUT) load_row(X1 + (size_t)row_of(gw) * D, lane, nv);
    for (int o = gw; o < NOUT; o += NGW) {
        const int m = row_of(o);
        float* orow = p.out + (size_t)o * D;
        f32x4 v[4];
#pragma unroll
        for (int j = 0; j < 4; ++j) v[j] = nv[j];
        if (o + NGW < NOUT) load_row(X1 + (size_t)row_of(o + NGW) * D, lane, nv);
        rms_row(nullptr, p.in[28], nullptr, lane, v, part, sSlot + (m >> 8) * 4, m & 255, nullptr, true);
#pragma unroll
        for (int j = 0; j < 4; ++j) *(f32x4*)(orow + 4 * lane + 256 * j) = v[j];
    }
}


#define XB_TMO      128
#define XB_XCNT(j)  (256  + 64 * (j))
#define XB_XSUB(j)  (1280 + 64 * (j))
#define XB_XGEN(j)  (2304 + 64 * (j))
#define XB_TOP      3328
#define XB_TOPGEN   3392
#define XCD_BAR_WORDS 3456
#define XB_SPIN_CAP (1u << 18)

__device__ __forceinline__ unsigned xb_ld(unsigned* p)              { return __hip_atomic_load(p, __ATOMIC_RELAXED, __HIP_MEMORY_SCOPE_AGENT); }
__device__ __forceinline__ unsigned xb_add(unsigned* p, unsigned v) { return __hip_atomic_fetch_add(p, v, __ATOMIC_RELAXED, __HIP_MEMORY_SCOPE_AGENT); }
__device__ __forceinline__ unsigned xb_xcc_id() { return (unsigned)__builtin_amdgcn_s_getreg((3 << 11) | 20) & 0xFu; }
#define XB_SPIN(cond, bar) do { unsigned _sp = 0; while (cond) { __builtin_amdgcn_s_sleep(1); \
    if ((++_sp & 255u) == 0u) { if (xb_ld(&(bar)[XB_TMO])) break; if (_sp > XB_SPIN_CAP) { atomicAdd(&(bar)[XB_TMO], 1u); break; } } } } while (0)

struct XcdBarrier {
    unsigned* bar; unsigned x;
    volatile LAS unsigned* st;
};

__device__ __forceinline__ XcdBarrier xcd_barrier_post(unsigned* bar, volatile LAS unsigned* st) {
    XcdBarrier b; b.bar = bar; b.x = xb_xcc_id(); b.st = st;
    if (threadIdx.x == 0) (void)xb_add(&bar[XB_XCNT(b.x)], 1u);
    return b;
}
__device__ __forceinline__ void xcd_barrier_complete(unsigned* bar, unsigned x, unsigned& nloc, unsigned& nx) {
    const unsigned G = gridDim.x * gridDim.y * gridDim.z;
    unsigned sum, cnt, mine, sp = 0u;
    for (;;) {
        sum = 0u; cnt = 0u; mine = 0u;
#pragma unroll
        for (unsigned j = 0; j < 16; ++j) { const unsigned c = xb_ld(&bar[XB_XCNT(j)]); sum += c; cnt += (c > 0u) ? 1u : 0u; mine = (j == x) ? c : mine; }
        if (sum == G) break;
        __builtin_amdgcn_s_sleep(1);
        if ((++sp & 255u) == 0u) { if (xb_ld(&bar[XB_TMO])) break; if (sp > XB_SPIN_CAP) { atomicAdd(&bar[XB_TMO], 1u); break; } }
    }
    nloc = mine > 0u ? mine : 1u; nx = cnt > 0u ? cnt : 1u;
}

__device__ __forceinline__ void xcd_barrier(const XcdBarrier& b) {
    asm volatile("s_waitcnt vmcnt(0)" ::: "memory");
    __syncthreads();
    if (threadIdx.x == 0) {
        unsigned* bar = b.bar;
        __builtin_amdgcn_s_waitcnt(0);
        unsigned nloc = b.st[0], nx = b.st[1];
        if (nloc == 0u) { xcd_barrier_complete(bar, b.x, nloc, nx); b.st[0] = nloc; b.st[1] = nx; }
        const unsigned old = xb_add(&bar[XB_XSUB(b.x)], 1u);
        const unsigned gen = old / nloc;
        if (old + 1u == (gen + 1u) * nloc) {
            __builtin_amdgcn_fence(__ATOMIC_RELEASE, "agent");
            asm volatile("s_waitcnt vmcnt(0)" ::: "memory");
            const unsigned og = xb_add(&bar[XB_TOP], 1u);
            const unsigned tg = og / nx;
            if (og + 1u == (tg + 1u) * nx) xb_add(&bar[XB_TOPGEN], 1u);
            else XB_SPIN(xb_ld(&bar[XB_TOPGEN]) == tg, bar);
            __builtin_amdgcn_fence(__ATOMIC_ACQUIRE, "agent");
            xb_add(&bar[XB_XGEN(b.x)], 1u);
            asm volatile("s_waitcnt vmcnt(0)" ::: "memory");
        } else {
            XB_SPIN(xb_ld(&bar[XB_XGEN(b.x)]) == gen, bar);
            __builtin_amdgcn_fence(__ATOMIC_ACQUIRE, "agent");
            asm volatile("s_waitcnt vmcnt(0)" ::: "memory");
        }
    }
    __syncthreads();
}


#if PROBE_MASK
#define TS_(i) ts_[i] = rtc()
#else
#define TS_(i) (void)ts_
#endif
__global__ void __launch_bounds__(512, 2) fwd_megakernel(Params p) {
    extern __shared__ __attribute__((aligned(16))) unsigned char lds_raw[];
    LAS unsigned char* lds = (LAS unsigned char*)lds_raw;
    unsigned long long ts_[11];
    cg::grid_group grid = cg::this_grid();
    const int G = gridDim.x, c = blockIdx.x;
    bf16_t* H = (bf16_t*)((unsigned char*)p.out + DO_H);
    bf16_t* WIN = (bf16_t*)((unsigned char*)p.out + DO_WIN);
    bf16_t* QKV = (bf16_t*)(p.ws + WS_QKV); bf16_t* RW = (bf16_t*)(p.ws + WS_RW);
    float* X1 = (float*)(p.ws + WS_X1); bf16_t* ACT = (bf16_t*)(p.ws + WS_ACT);

    {   volatile LAS unsigned* st_ = (volatile LAS unsigned*)(lds + LDS_BYTES - 64); if (threadIdx.x == 0) { st_[0] = 0u; st_[1] = 0u; } }
    __syncthreads();
    const XcdBarrier xbar = xcd_barrier_post((unsigned*)(p.ws + WS_CTL) + 1024, (volatile LAS unsigned*)(lds + LDS_BYTES - 64));
    if (p.ws == nullptr) grid.sync();
    TS_(0); phase0(p, lds);
    xcd_barrier(xbar); TS_(1);
    {
        pg8::Gemm g{H, D, WIN, MP, N1A, D, WIN + (size_t)N1A * D}; pg8::StaticOrder S; S.init(MP, N1A, G, c);
        const bool borrow = (G == 256);
        if (borrow) { S.bor_n = BOR_N; S.bor_first = BOR_FIRST; S.bor_nN = N1B / 256; S.bor_nwg = (MP / 256) * (N1B / 256); }
        pg8::EpiSeg<0> E{QKV, QKVW, 3072, RW, RWW, (bf16_t*)((unsigned char*)p.out + DO_TMP)};
        pg8::gemm_phase<1024, 1024, GEMM_ALIGN>(lds, g, S, E);
    }
    xcd_barrier(xbar); TS_(2);
    unsigned long long tfirst[2] = {0ull, 0ull};
#if PROBE_ITEM_BLOCK >= 0
    tfirst[0] = rtc();
#endif
    phase_scan(p, lds, tfirst);
    xcd_barrier(xbar); TS_(3);
    {
        pg8::Gemm g{H, D, WIN + (size_t)N1A * D, MP, N1B, D}; pg8::StaticOrder S; S.init(MP, N1B, G, c);
        if (G == 256) {
            S.limit = BOR_FIRST;
            const bf16_t* TMP = (const bf16_t*)((unsigned char*)p.out + DO_TMP);
            for (int idx = c * 512 + otid(); idx < BOR_N * 8192; idx += G * 512) { const int sl = idx >> 13, r = (idx >> 5) & 255, c16 = idx & 31; int pm, pn; pg8::map_tile(BOR_FIRST + sl, MP / 256, N1B / 256, S.nwg, pm, pn);
                const int col = pn * 256 + c16 * 8; const size_t row = (size_t)pm * 256 + r;
                bf16_t* dst = col < 2048 ? QKV + row * QKVW + col : RW + row * RWW + (col - 2048);
                *(u32x4*)dst = *(const u32x4*)(TMP + (size_t)sl * 65536 + r * 256 + c16 * 8); }
        }
        pg8::EpiSeg<0> E{QKV, QKVW, 2048, RW, RWW};
        pg8::gemm_phase<1024, 1024, GEMM_ALIGN>(lds, g, S, E);
        pg8::Gemm g2{(const bf16_t*)(p.ws + WS_GA), 128, (const bf16_t*)(p.ws + WS_WG2), MP, 1024, 128}; const int nw1 = (G == 256) ? BOR_FIRST : (MP / 256) * (N1B / 256), rem1 = nw1 % G, G2 = (rem1 > 0 && rem1 < G / 2) ? G - rem1 : G, c2 = (G2 == G) ? c : c - rem1;
        pg8::StaticOrder S2; S2.init(MP, 1024, G2, c2 < 0 ? (1 << 28) : c2, 2);
        pg8::EpiSeg<0> E2{RW + 1024, RWW, 1 << 30, RW, RWW};
        pg8::gemm_phase<128, 128, GEMM_ALIGN>(lds, g2, S2, E2);
    }
    xcd_barrier(xbar); TS_(4);
    phase_merge(p);
    xcd_barrier(xbar); TS_(5);
    {
        pg8::Gemm g{H, D, (const bf16_t*)(p.ws + WS_WOUT), MP, D, D}; pg8::StaticOrder S; S.init(MP, D, G, c, 16, 1);
        pg8::EpiRes<0> E{X1, p.in[0], p.in[1], p.in[6], (float*)(p.ws + WS_PART), (bf16_t*)((unsigned char*)p.out + DO_X1B), (bf16_t*)(p.ws + WS_X1B2)};
        pg8::gemm_phase<1024, 1024, GEMM_ALIGN>(lds, g, S, E);
    }
    xcd_barrier(xbar); TS_(6);
    phase_norm2(p, lds);
    xcd_barrier(xbar); TS_(7);
    {
        pg8::Gemm g{H, D, (const bf16_t*)(p.ws + WS_WFF1), MP, FF, D}; pg8::StaticOrder S; S.init(MP, FF, G, c);
        pg8::EpiSeg<1> E{ACT, FF, 1 << 30, ACT, FF};
        pg8::gemm_phase<1024, 1024, GEMM_ALIGN>(lds, g, S, E);
    }
    xcd_barrier(xbar); TS_(8);
    {
        pg8::Gemm g{ACT, FF, (const bf16_t*)(p.ws + WS_WFF2), MP, D, FF}; pg8::StaticOrder S; S.init(MP, D, G, c, 64, 1);
        pg8::EpiRes<1> E{X1, nullptr, nullptr, nullptr, (float*)(p.ws + WS_PART), (bf16_t*)((unsigned char*)p.out + DO_X1B), (bf16_t*)(p.ws + WS_X1B2)};
        pg8::gemm_phase<4096, 4096, GEMM_ALIGN>(lds, g, S, E);
    }
    xcd_barrier(xbar); TS_(9);
    phase_final(p, lds);
    TS_(10);
#if PROBE_ITEM_BLOCK >= 0
    if (blockIdx.x == PROBE_ITEM_BLOCK && threadIdx.x == 0) { const unsigned long long t9 = rtc(); const unsigned long long d = tfirst[1] - tfirst[0]; while (rtc() - t9 < d) __builtin_amdgcn_s_sleep(8); }
#endif
#if PROBE_MASK
    if (blockIdx.x == 0 && threadIdx.x == 0) { unsigned long long d = 0;
#pragma unroll
        for (int i = 0; i < 10; ++i) if ((PROBE_MASK >> i) & 1) d += ts_[i + 1] - ts_[i];
        while (rtc() - ts_[10] < d) __builtin_amdgcn_s_sleep(8); }
#endif
}

extern "C" void kernel_launch(void* const* d_in, const int* in_sizes, int n_in, void* d_out, int out_size, void* d_ws, size_t ws_size, hipStream_t stream) {
    static int grid = 0;
    if (grid == 0) {
        int dev = 0, cus = 0, per_cu = 0;
        hipGetDevice(&dev);
        hipDeviceGetAttribute(&cus, hipDeviceAttributeMultiprocessorCount, dev);
        if (hipFuncSetAttribute((const void*)fwd_megakernel, hipFuncAttributeMaxDynamicSharedMemorySize, LDS_BYTES) != hipSuccess) fprintf(stderr, "hipFuncSetAttribute failed\n");
        hipOccupancyMaxActiveBlocksPerMultiprocessor(&per_cu, (const void*)fwd_megakernel, 512, LDS_BYTES);
        if (per_cu < 1) { fprintf(stderr, "occupancy query says %d blocks per CU\n", per_cu); per_cu = 1; }
        grid = cus;
        if (n_in != 29 || ws_size < 256 * MiB) fprintf(stderr, "unexpected n_in %d / ws %zu\n", n_in, ws_size);
    }
    hipMemsetAsync((char*)d_ws + WS_CTL, 0, 32768, stream);
    Params p{};
    for (int i = 0; i < 29; ++i) p.in[i] = (const float*)d_in[i];
    p.out = (float*)d_out; p.ws = (unsigned char*)d_ws;
    void* args[] = {&p};
    hipError_t e = hipLaunchCooperativeKernel((const void*)fwd_megakernel, dim3(grid), dim3(512), args, LDS_BYTES, stream);
    if (e != hipSuccess) fprintf(stderr, "cooperative launch failed: %s (grid %d)\n", hipGetErrorString(e), grid);
}
```

```cpp
#include <hip/hip_runtime.h>
#include <hip/hip_cooperative_groups.h>
#include <cstdio>
#include <cstdint>
namespace cg = cooperative_groups;
#define PROBE_ITEM_BLOCK -1
#define PROBE_MASK 0

#define DI __device__ __forceinline__
#define LAS __attribute__((address_space(3)))
typedef unsigned short bf16_t;
typedef short bf16x8 __attribute__((ext_vector_type(8)));
typedef float f32x4 __attribute__((ext_vector_type(4)));
typedef unsigned u32x4 __attribute__((ext_vector_type(4)));

constexpr int D = 1024, TP = 2064, NBP = 8, NBS = 128, TS = 8;
constexpr int MPR = NBP * TP;
constexpr int M = MPR + NBS * TS;
constexpr int MP = 17664;
constexpr int QKVW = 3072, RWW = 3328, PROJW = 9488, FF = 4096;
constexpr int N1A = 6400, N1B = 3072;
constexpr size_t MiB = 1u << 20;
constexpr size_t WS_CTL = 0;
constexpr size_t WS_WOUT = 1 * MiB, WS_WFF1 = 3 * MiB, WS_WFF2 = 11 * MiB, WS_WG2 = 19 * MiB;
constexpr size_t WS_GDN = 19 * MiB + 512 * 1024, WS_BETA = 20 * MiB + 512 * 1024;
constexpr size_t WS_QKV = 22 * MiB, WS_RW = 126 * MiB;
constexpr size_t WS_X1 = WS_QKV, WS_ACT = 92 * MiB;
constexpr size_t WS_GA = 246 * MiB;
constexpr size_t WS_PART = 231 * MiB;
constexpr size_t DO_H = 0, DO_WIN = 35 * MiB;
constexpr size_t DO_X1B = 35 * MiB, WS_X1B2 = 250 * MiB + 512 * 1024;
constexpr int X1B_SPLIT = 16384;
constexpr size_t O_YP = 0, O_YS = 16777216, O_CONVP = 17825792, O_DNP = 17899520, O_SHIFTP = 18948096, O_RWP = 18974720,
                 O_CONVS = 19499008, O_DNS = 20678656, O_SHIFTS = 37455872, O_RWS = 37881856;
constexpr int LDS_BYTES = 163840;
constexpr bool GEMM_ALIGN = true;

struct Params { const float* in[29]; float* out; unsigned char* ws; };

typedef __bf16 bf16v2 __attribute__((ext_vector_type(2)));
typedef float f32x2 __attribute__((ext_vector_type(2)));
DI unsigned pk2(float lo, float hi) { const f32x2 v = {lo, hi}; return __builtin_bit_cast(unsigned, __builtin_convertvector(v, bf16v2)); }
DI unsigned f2bf(float f) { return pk2(f, 0.f) & 0xffffu; }
DI float bflo(unsigned u) { return __builtin_bit_cast(float, u << 16); }
DI float bfhi(unsigned u) { return __builtin_bit_cast(float, u & 0xffff0000u); }
DI void unpack8(const u32x4 v, float* o) { o[0] = bflo(v.x); o[1] = bfhi(v.x); o[2] = bflo(v.y); o[3] = bfhi(v.y); o[4] = bflo(v.z); o[5] = bfhi(v.z); o[6] = bflo(v.w); o[7] = bfhi(v.w); }
DI u32x4 pack8(const float* o) { u32x4 v; v.x = pk2(o[0], o[1]); v.y = pk2(o[2], o[3]); v.z = pk2(o[4], o[5]); v.w = pk2(o[6], o[7]); return v; }
DI void load8bf(const bf16_t* p, float* o) { unpack8(*(const u32x4*)p, o); }
template <int CTRL, int RMASK> DI float dpp_add(float x) { return x + __builtin_bit_cast(float, __builtin_amdgcn_update_dpp(0, __builtin_bit_cast(int, x), CTRL, RMASK, 0xf, false)); }
DI float red8(float x) { x = dpp_add<0xB1, 0xf>(x); x = dpp_add<0x4E, 0xf>(x); return dpp_add<0x141, 0xf>(x); }
DI float red16(float x) { return dpp_add<0x140, 0xf>(red8(x)); }
DI float wave_sum(float v) {
    v = red16(v); v = dpp_add<0x142, 0xa>(v); v = dpp_add<0x143, 0xc>(v);
    return __builtin_bit_cast(float, __builtin_amdgcn_readlane(__builtin_bit_cast(int, v), 63));
}
DI float sigmoidf_(float x) { return __builtin_amdgcn_rcpf(1.f + __expf(-x)); }
DI float tanhf_(float x) { return 1.f - 2.f * __builtin_amdgcn_rcpf(__expf(2.f * x) + 1.f); }
DI float rsqrtf_(float x) { return __builtin_amdgcn_rsqf(x); }
DI float softplusf_(float x) { return fmaxf(x, 0.f) + __logf(1.f + __expf(-fabsf(x))); }
DI float siluf_(float x) { return x * sigmoidf_(x); }
DI unsigned long long rtc() { unsigned long long t; asm volatile("s_memrealtime %0\n\ts_waitcnt lgkmcnt(0)" : "=s"(t) :: "memory"); return t; }
DI int otid() { int t = threadIdx.x; asm volatile("" : "+v"(t)); return t; }
#define LDS_WAIT() asm volatile("s_waitcnt lgkmcnt(0)" ::: "memory")

DI const float* xrow3(const float* xp, const float* xs, const float* xm, int r) {
    if (r < MPR) { const int b = r / TP, t = r - b * TP; return t < 16 ? xm + (size_t)t * D : xp + ((size_t)b * 2048 + (t - 16)) * D; }
    return xs + (size_t)(r - MPR) * D;
}
DI const float* xrow(const Params& p, int r) {
    if (r < MPR) { const int b = r / TP, t = r - b * TP; return t < 16 ? p.in[6] + (size_t)t * D : p.in[0] + ((size_t)b * 2048 + (t - 16)) * D; }
    return p.in[1] + (size_t)(r - MPR) * D;
}

namespace pg8 {
constexpr int BM = 256, BK = 64, HALF = 128, HTB = HALF * BK * 2, STAGE_BYTES = 8 * HTB, NXCD = 8, WGM = 8;
DI int lds_byte(int r, int c) { const int st = (r >> 4) * 2 + (c >> 5), rr = r & 15, cc = c & 31, ob = rr * 64 + cc * 2; return st * 1024 + (ob ^ (((ob >> 9) & 1) << 5)); }
DI void stage_rc(int b, int& R, int& C) { const int st = b / 1024, sb = b % 1024, swz = sb ^ (((sb >> 9) & 1) << 5); R = (st >> 1) * 16 + swz / 64; C = (st & 1) * 32 + (swz % 64) / 2; }
DI int perm32(int rho) { const int n = rho >> 4, i = rho & 15; return 8 * (i >> 2) + 4 * n + (i & 3); }
struct Unit { int pm, pn, k0, nt, part, slot; };
struct Gemm { const bf16_t* A; int lda; const bf16_t* Bt; int M, N, K; };
struct StaticOrder {
    int nM, nN, nwg, G, c, ntf, split;
    DI void init(int M_, int N_, int G_, int c_, int ntf_ = 16, int split_ = 0) { nM = M_ / BM; nN = N_ / BM; nwg = nM * nN; G = G_; c = c_; ntf = ntf_;
        split = (split_ && nwg > G && nwg <= 2 * G && (nwg - G) * 4 <= G && (nwg - G) <= 20) ? 1 : 0; }
    DI bool next(int i, Unit& u) const {
        long L = (long)i * G + c; u.k0 = 0; u.nt = ntf; u.part = 0; u.slot = -1;
        if (split && i >= 1) { if (i > 1 || c >= 4 * (nwg - G)) return false; L = G + (c >> 2); u.part = c & 3; u.nt = ntf >> 2; u.k0 = u.part * u.nt; u.slot = c >> 2; }
        if (L >= nwg) return false;
        int wgid = (int)L; { const int q = nwg / NXCD, r = nwg % NXCD, xcd = wgid % NXCD, off = wgid / NXCD; wgid = (xcd < r ? xcd * (q + 1) : r * (q + 1) + (xcd - r) * q) + off; }
        const int nig = WGM * nN, gid = wgid / nig, fm = gid * WGM, gsz = (nM - fm) < WGM ? (nM - fm) : WGM;
        u.pm = fm + ((wgid % nig) % gsz); u.pn = (wgid % nig) / gsz; return true;
    }
};
DI unsigned cvt_pk_bf16(float lo, float hi) { return pk2(lo, hi); }

template <int ACT> struct EpiSeg {
    bf16_t* d0; int ld0; int split; bf16_t* d1; int ld1;
    DI void operator()(const f32x4 (&acc)[2][2][4][2], const Unit& u, int wr, int wc, int fr, int fq) const {
        const int row0 = u.pm * BM + wr * 64 + fr; int colt = u.pn * BM; bf16_t* base = d0; int ld = ld0;
        if (colt >= split) { base = d1; ld = ld1; colt -= split; }
        const int col0 = colt + wc * 32 + 8 * fq;
#pragma unroll
        for (int ai = 0; ai < 2; ++ai)
#pragma unroll
            for (int m = 0; m < 4; ++m) { bf16_t* rowp = base + (size_t)(row0 + ai * HALF + m * 16) * ld + col0;
#pragma unroll
                for (int bj = 0; bj < 2; ++bj) { f32x4 v0 = acc[ai][bj][m][0], v1 = acc[ai][bj][m][1];
                    if (ACT == 1) {
#pragma unroll
                        for (int e = 0; e < 4; ++e) { float a = fmaxf(v0[e], 0.f), b = fmaxf(v1[e], 0.f); v0[e] = a * a; v1[e] = b * b; } }
                    u32x4 w; w.x = cvt_pk_bf16(v0[0], v0[1]); w.y = cvt_pk_bf16(v0[2], v0[3]); w.z = cvt_pk_bf16(v1[0], v1[1]); w.w = cvt_pk_bf16(v1[2], v1[3]);
                    *(u32x4*)(rowp + bj * HALF) = w; } }
    }
};
template <int MODE> struct EpiRes {
    float* X1; const float* xp; const float* xs; const float* xm; float* part; bf16_t* x1a; bf16_t* x1b;
    DI void operator()(const f32x4 (&acc)[2][2][4][2], const Unit& u, int wr, int wc, int fr, int fq) const {
        const int row0 = u.pm * BM + wr * 64 + fr; const int col0 = u.pn * BM + wc * 32 + 8 * fq;
        if (u.part > 0) {
            float* pb = part + (size_t)((u.part - 1) * 20 + u.slot) * 65536 + (size_t)(wr * 64 + fr) * 256 + wc * 32 + 8 * fq;
#pragma unroll
            for (int ai = 0; ai < 2; ++ai)
#pragma unroll
                for (int m = 0; m < 4; ++m)
#pragma unroll
                    for (int bj = 0; bj < 2; ++bj) { float* o = pb + (size_t)(ai * HALF + m * 16) * 256 + bj * HALF; *(f32x4*)o = acc[ai][bj][m][0]; *(f32x4*)(o + 4) = acc[ai][bj][m][1]; }
            return;
        }
#pragma unroll
        for (int ai = 0; ai < 2; ++ai)
#pragma unroll
            for (int m = 0; m < 4; ++m) { const int row = row0 + ai * HALF + m * 16;
                bf16_t* xb = (row < X1B_SPLIT ? x1a + (size_t)row * D : x1b + (size_t)(row - X1B_SPLIT) * D) + col0;
                if (MODE == 0) {
                    const float* bp = row < M ? xrow3(xp, xs, xm, row) + col0 : nullptr;
#pragma unroll
                    for (int bj = 0; bj < 2; ++bj) { f32x4 b0 = (f32x4){0.f, 0.f, 0.f, 0.f}, b1 = b0;
                        if (bp) { b0 = *(const f32x4*)(bp + bj * HALF); b1 = *(const f32x4*)(bp + bj * HALF + 4); }
                        const f32x4 v0 = acc[ai][bj][m][0] + b0, v1 = acc[ai][bj][m][1] + b1;
                        u32x4 w; w.x = pk2(v0[0], v0[1]); w.y = pk2(v0[2], v0[3]); w.z = pk2(v1[0], v1[1]); w.w = pk2(v1[2], v1[3]);
                        *(u32x4*)(xb + bj * HALF) = w; }
                } else {
                    float* op = X1 + (size_t)row * D + col0;
#pragma unroll
                    for (int bj = 0; bj < 2; ++bj) { float b[8]; unpack8(*(const u32x4*)(xb + bj * HALF), b);
                        *(f32x4*)(op + bj * HALF) = acc[ai][bj][m][0] + (f32x4){b[0], b[1], b[2], b[3]}; *(f32x4*)(op + bj * HALF + 4) = acc[ai][bj][m][1] + (f32x4){b[4], b[5], b[6], b[7]}; }
                } }
    }
};

template <int K, int lda, bool ALIGN_EPI, class Epi>
DI void gemm_phase(LAS unsigned char* lds, const Gemm g, const StaticOrder& S, const Epi& E) {
    const int tid = otid(), wid = __builtin_amdgcn_readfirstlane(tid >> 6), lane = tid & 63, wr = wid >> 2, wc = wid & 3, fr = lane & 15, fq = lane >> 4;
    unsigned voffA[2], voffB[2];
#pragma unroll
    for (int i = 0; i < 2; ++i) { int R, C; stage_rc(tid * 16 + i * 8192, R, C); const int Rb = (R & ~31) + perm32(R & 31);
        voffA[i] = (unsigned)(R * lda + C) * 2u; voffB[i] = (unsigned)(Rb * K + C) * 2u; }
    const size_t kstep = (size_t)(BK * 2);
    const size_t hA = (size_t)HALF * lda * 2, hB = (size_t)HALF * K * 2;
    const size_t tA = 2 * hA, tB = 2 * hB;
    const unsigned ldsw = (unsigned)wid * 1024u;
    const int aoff = lds_byte(wr * 64 + fr, fq * 8), boff = lds_byte(wc * 32 + fr, fq * 8);
#define PG8_SA(b, h) (((b) * 2 + (h)) * HTB)
#define PG8_SB(b, h) ((4 + (b) * 2 + (h)) * HTB)
#define PG8_STAGE(bufoff, gbase, voff) do { _Pragma("unroll") for (int _i = 0; _i < 2; ++_i) \
        __builtin_amdgcn_global_load_lds((const unsigned*)((const char*)(gbase) + (voff)[_i]), (LAS unsigned*)(lds + (bufoff) + ldsw + _i * 8192), 16, 0, 0); } while (0)
#define PG8_LDA(dst, b, h) do { _Pragma("unroll") for (int m = 0; m < 4; ++m) _Pragma("unroll") for (int k = 0; k < 2; ++k) dst[m][k] = *(const LAS bf16x8*)(lds + PG8_SA(b, h) + aoff + m * 2048 + k * 1024); } while (0)
#define PG8_LDB(dst, b, h) do { _Pragma("unroll") for (int n = 0; n < 2; ++n) _Pragma("unroll") for (int k = 0; k < 2; ++k) dst[n][k] = *(const LAS bf16x8*)(lds + PG8_SB(b, h) + boff + n * 2048 + k * 1024); } while (0)
#define PG8_MMA(ai, bj, At, Bt) do { __builtin_amdgcn_s_setprio(1); _Pragma("unroll") for (int m = 0; m < 4; ++m) _Pragma("unroll") for (int n = 0; n < 2; ++n) _Pragma("unroll") for (int k = 0; k < 2; ++k) \
        acc[ai][bj][m][n] = __builtin_amdgcn_mfma_f32_16x16x32_bf16(Bt[n][k], At[m][k], acc[ai][bj][m][n], 0, 0, 0); __builtin_amdgcn_s_setprio(0); } while (0)
#define PG8_WAIT_V(n) asm volatile("s_waitcnt vmcnt(" #n ")" ::: "memory")
#define PG8_WAIT_L(n) asm volatile("s_waitcnt lgkmcnt(" #n ")" ::: "memory")
#define PG8_BAR __builtin_amdgcn_s_barrier()
#define PG8_SCHED __builtin_amdgcn_sched_barrier(0)
    Unit cur, nxt; int ui = 0;
    if (!S.next(0, cur)) return;
    f32x4 acc[2][2][4][2];
#pragma unroll
    for (int a = 0; a < 2; ++a)
#pragma unroll
        for (int b = 0; b < 2; ++b)
#pragma unroll
            for (int m = 0; m < 4; ++m)
#pragma unroll
                for (int n = 0; n < 2; ++n) acc[a][b][m][n] = (f32x4){0.f, 0.f, 0.f, 0.f};
    bf16x8 At[4][2], B0[2][2], B1[2][2];
    const char* cA = (const char*)g.A + (size_t)cur.pm * tA + (size_t)cur.k0 * kstep; const char* cB = (const char*)g.Bt + (size_t)cur.pn * tB + (size_t)cur.k0 * kstep;
    PG8_STAGE(PG8_SB(0, 0), cB, voffB); PG8_STAGE(PG8_SB(0, 1), cB + hB, voffB); PG8_STAGE(PG8_SA(0, 0), cA, voffA); PG8_STAGE(PG8_SA(0, 1), cA + hA, voffA);
    if (wr == 1) PG8_BAR;
    PG8_WAIT_V(2); PG8_BAR;
    PG8_STAGE(PG8_SB(1, 0), cB + kstep, voffB); PG8_STAGE(PG8_SA(1, 0), cA + kstep, voffA); PG8_STAGE(PG8_SB(1, 1), cB + hB + kstep, voffB);
    PG8_WAIT_V(6); PG8_BAR;
    for (;;) {
        const bool has_next = S.next(ui + 1, nxt);
        const char* nA = has_next ? (const char*)g.A + (size_t)nxt.pm * tA + (size_t)nxt.k0 * kstep : cA; const char* nB = has_next ? (const char*)g.Bt + (size_t)nxt.pn * tB + (size_t)nxt.k0 * kstep : cB;
        const int nt = cur.nt;
        for (int t = 0; t < nt; t += 2) {
            const bool last = (t == nt - 2);
            const char* a1 = cA + (size_t)(t + 1) * kstep;
            const char* a2 = last ? nA : cA + (size_t)(t + 2) * kstep; const char* b2 = last ? nB : cB + (size_t)(t + 2) * kstep;
            const char* a3 = a2 + kstep; const char* b3 = b2 + kstep;
            PG8_LDB(B0, 0, 0); PG8_LDB(B1, 0, 1); PG8_SCHED; PG8_LDA(At, 0, 0); PG8_STAGE(PG8_SA(1, 1), a1 + hA, voffA);
            PG8_WAIT_V(8); PG8_WAIT_L(0); PG8_BAR; PG8_MMA(0, 0, At, B0); PG8_MMA(0, 1, At, B1); PG8_BAR; PG8_SCHED;
            PG8_LDA(At, 0, 1); PG8_STAGE(PG8_SB(0, 0), b2, voffB); PG8_STAGE(PG8_SB(0, 1), b2 + hB, voffB); PG8_STAGE(PG8_SA(0, 0), a2, voffA);
            PG8_WAIT_V(8); PG8_WAIT_L(0); PG8_BAR; PG8_MMA(1, 0, At, B0); PG8_MMA(1, 1, At, B1); PG8_BAR; PG8_SCHED;
            PG8_LDB(B0, 1, 0); PG8_LDB(B1, 1, 1); PG8_SCHED; PG8_LDA(At, 1, 0); PG8_STAGE(PG8_SA(0, 1), a2 + hA, voffA);
            PG8_WAIT_V(8); PG8_WAIT_L(0); PG8_BAR; PG8_MMA(0, 0, At, B0); PG8_MMA(0, 1, At, B1); PG8_BAR; PG8_SCHED;
            PG8_LDA(At, 1, 1); PG8_STAGE(PG8_SB(1, 0), b3, voffB); PG8_STAGE(PG8_SB(1, 1), b3 + hB, voffB); PG8_STAGE(PG8_SA(1, 0), a3, voffA);
            PG8_WAIT_V(8); PG8_WAIT_L(0); PG8_BAR; PG8_MMA(1, 0, At, B0); PG8_MMA(1, 1, At, B1); PG8_BAR; PG8_SCHED;
        }
        if constexpr (ALIGN_EPI) { if (wr == 0) PG8_BAR; }
        E(acc, cur, wr, wc, fr, fq);
        if (!has_next) break;
#pragma unroll
        for (int a = 0; a < 2; ++a)
#pragma unroll
            for (int b = 0; b < 2; ++b)
#pragma unroll
                for (int m = 0; m < 4; ++m)
#pragma unroll
                    for (int n = 0; n < 2; ++n) acc[a][b][m][n] = (f32x4){0.f, 0.f, 0.f, 0.f};
        cur = nxt; cA = nA; cB = nB; ++ui;
        if constexpr (ALIGN_EPI) { if (wr == 1) PG8_BAR; }
    }
    PG8_WAIT_V(0);
    if constexpr (!ALIGN_EPI) { if (wr == 0) PG8_BAR; }
    PG8_BAR;
#undef PG8_SA
#undef PG8_SB
#undef PG8_STAGE
#undef PG8_LDA
#undef PG8_LDB
#undef PG8_MMA
#undef PG8_WAIT_V
#undef PG8_WAIT_L
#undef PG8_BAR
#undef PG8_SCHED
}
}

DI void transpose_item(const float* W, int ldw, int nblk, bf16_t* WT, int K, int row_off, LAS float* scr, int item, int lane) {
    const int kb = item / nblk, nb = item - kb * nblk, k0 = 64 * kb, n0 = 32 * nb;
#pragma unroll 8
    for (int i = 0; i < 32; ++i) { const int kk = 2 * i + (lane >> 5); scr[kk * 33 + (lane & 31)] = __builtin_nontemporal_load(W + (size_t)(k0 + kk) * ldw + n0 + (lane & 31)); }
    LDS_WAIT();
    const int c = lane & 7;
#pragma unroll
    for (int j = 0; j < 4; ++j) { const int n = (lane >> 3) + 8 * j; const LAS float* s = scr + (8 * c) * 33 + n;
        u32x4 o; o.x = pk2(s[0 * 33], s[1 * 33]); o.y = pk2(s[2 * 33], s[3 * 33]); o.z = pk2(s[4 * 33], s[5 * 33]); o.w = pk2(s[6 * 33], s[7 * 33]);
        *(u32x4*)(WT + (size_t)(row_off + n0 + n) * K + k0 + 8 * c) = o; }
    LDS_WAIT();
}

DI void load_row(const float* xr, int lane, f32x4 (&v)[4]) {
#pragma unroll
    for (int j = 0; j < 4; ++j) v[j] = *(const f32x4*)(xr + 4 * lane + 256 * j);
}
DI void load_row_nt(const float* xr, int lane, f32x4 (&v)[4]) {
#pragma unroll
    for (int j = 0; j < 4; ++j) v[j] = __builtin_nontemporal_load((const f32x4*)(xr + 4 * lane + 256 * j));
}
DI void rms_row(const float* xr, const float* g, bf16_t* orow, int lane, f32x4 (&v)[4], const float* part = nullptr, const LAS int* slots = nullptr, int prow = 0, float* wb = nullptr, bool pre = false, bf16_t* wbb = nullptr) {
    float s = 0.f;
#pragma unroll
    for (int j = 0; j < 4; ++j) { if (!pre) v[j] = *(const f32x4*)(xr + 4 * lane + 256 * j);
        if (part) { const int sl = slots[j]; if (sl >= 0) { const float* pp = part + (size_t)sl * 65536 + (size_t)prow * 256 + 4 * lane;
                v[j] = v[j] + *(const f32x4*)pp + *(const f32x4*)(pp + (size_t)20 * 65536) + *(const f32x4*)(pp + (size_t)40 * 65536);
                if (wb) *(f32x4*)(wb + 4 * lane + 256 * j) = v[j];
                if (wbb) { const unsigned long long o = (unsigned long long)pk2(v[j].x, v[j].y) | ((unsigned long long)pk2(v[j].z, v[j].w) << 32); *(unsigned long long*)(wbb + 4 * lane + 256 * j) = o; } } }
        s += (v[j].x * v[j].x + v[j].y * v[j].y) + (v[j].z * v[j].z + v[j].w * v[j].w); }
    const float rstd = 1.f / sqrtf(wave_sum(s) * (1.f / D) + 1e-6f);
#pragma unroll
    for (int j = 0; j < 4; ++j) { const f32x4 gg = *(const f32x4*)(g + 4 * lane + 256 * j); v[j] = v[j] * rstd * gg;
        if (orow) { unsigned long long o = (unsigned long long)pk2(v[j].x, v[j].y) | ((unsigned long long)pk2(v[j].z, v[j].w) << 32); *(unsigned long long*)(orow + 4 * lane + 256 * j) = o; } }
}

DI void phase0(const Params& p, LAS unsigned char* lds) {
    const int tid = otid(), lane = tid & 63, wave = __builtin_amdgcn_readfirstlane(tid >> 6);
    LAS float* scr = (LAS float*)(lds + wave * 16384);
    const int gw = blockIdx.x * 8 + wave, NGW = gridDim.x * 8;
    bf16_t* WIN = (bf16_t*)((unsigned char*)p.out + DO_WIN);
    bf16_t* WOUT = (bf16_t*)(p.ws + WS_WOUT); bf16_t* WF1 = (bf16_t*)(p.ws + WS_WFF1); bf16_t* WF2 = (bf16_t*)(p.ws + WS_WFF2); bf16_t* WG2 = (bf16_t*)(p.ws + WS_WG2);
    const float* w_in = p.in[8];
    constexpr int I0 = 16 * 96, I1 = 16 * 104, I2 = 16 * 32, I3 = 16 * 64, I4 = 16 * 32, I5 = 16 * 128, I6 = 64 * 32, I7 = 2 * 32;
    constexpr int NIT = I0 + I1 + I2 + I3 + I4 + I5 + I6 + I7;
    for (int it = gw; it < NIT; it += NGW) {
        int r = it;
        if (r < I0) { transpose_item(w_in, PROJW, 96, WIN, 1024, 0, scr, r, lane); continue; } r -= I0;
        if (r < I1) { transpose_item(w_in + 4112, PROJW, 104, WIN, 1024, 3072, scr, r, lane); continue; } r -= I1;
        if (r < I2) { transpose_item(w_in + 3072, PROJW, 32, WIN, 1024, 6400, scr, r, lane); continue; } r -= I2;
        if (r < I3) { transpose_item(w_in + 7440, PROJW, 64, WIN, 1024, 7424, scr, r, lane); continue; } r -= I3;
        if (r < I4) { transpose_item(p.in[24], 1024, 32, WOUT, 1024, 0, scr, r, lane); continue; } r -= I4;
        if (r < I5) { transpose_item(p.in[26], 4096, 128, WF1, 1024, 0, scr, r, lane); continue; } r -= I5;
        if (r < I6) { transpose_item(p.in[27], 1024, 32, WF2, 4096, 0, scr, r, lane); continue; } r -= I6;
        transpose_item(p.in[18], 1024, 32, WG2, 128, 0, scr, r, lane);
    }
    bf16_t* H = (bf16_t*)((unsigned char*)p.out + DO_H);
    float* GDN = (float*)(p.ws + WS_GDN); float* BETA = (float*)(p.ws + WS_BETA);
    __syncthreads();
    LAS float* sWab = (LAS float*)lds;
    for (int idx = tid; idx < 16384; idx += 512) { const int k = idx >> 4, i = idx & 15; sWab[i * 1028 + k] = w_in[(size_t)k * PROJW + 4096 + i]; }
    __syncthreads();
    f32x4 nv[4];
    if (gw < M) load_row_nt(xrow(p, gw), lane, nv);
    for (int m = gw; m < MP; m += NGW) {
        bf16_t* hr = H + (size_t)m * D;
        if (m >= M) {
#pragma unroll
            for (int j = 0; j < 4; ++j) *(unsigned long long*)(hr + 4 * lane + 256 * j) = 0ull;
            continue;
        }
        f32x4 v[4];
#pragma unroll
        for (int j = 0; j < 4; ++j) v[j] = nv[j];
        if (m + NGW < M) load_row_nt(xrow(p, m + NGW), lane, nv);
        rms_row(nullptr, p.in[7], hr, lane, v, nullptr, nullptr, 0, nullptr, true);
        float s[16];
#pragma unroll
        for (int i = 0; i < 16; ++i) { float a = 0.f;
#pragma unroll
            for (int j = 0; j < 4; ++j) { const f32x4 w4 = *(const LAS f32x4*)(sWab + i * 1028 + 256 * j + 4 * lane); a += v[j].x * w4.x + v[j].y * w4.y + v[j].z * w4.z + v[j].w * w4.w; }
            s[i] = a; }
        float mine = 0.f;
#pragma unroll
        for (int i = 0; i < 16; ++i) { const float t = wave_sum(s[i]); if (lane == i) mine = t; }
        if (lane < 8) GDN[(size_t)m * 8 + lane] = -__expf(p.in[10][lane]) * softplusf_(mine + p.in[11][lane]);
        else if (lane < 16) BETA[(size_t)m * 8 + lane - 8] = sigmoidf_(mine);
    }
}

typedef float f32x16 __attribute__((ext_vector_type(16)));
typedef unsigned u32x2 __attribute__((ext_vector_type(2)));
DI int crow(int reg, int hh) { return (reg & 3) + 8 * (reg >> 2) + 4 * hh; }
template <int KS> DI void mma32(f32x16& acc, const LAS bf16_t* A, int lda, const LAS bf16_t* Bt, int ldb, int lane) {
    const int r = lane & 31, hh = lane >> 5;
    const LAS bf16_t* pa = A + r * lda + 8 * hh; const LAS bf16_t* pb = Bt + r * ldb + 8 * hh;
#pragma unroll
    for (int ks = 0; ks < KS; ++ks) { const bf16x8 a = *(const LAS bf16x8*)(pa + 16 * ks); const bf16x8 b = *(const LAS bf16x8*)(pb + 16 * ks);
        acc = __builtin_amdgcn_mfma_f32_32x32x16_bf16(a, b, acc, 0, 0, 0); }
}
template <int s> DI void tri_level(LAS float* sA, LAS float* sX, LAS float* sM, int tid) {
    constexpr int NP = 32 / s, NOUT = NP * s * s, PER = (NOUT + 511) / 512, MS = s + 4;
    float res[PER];
#pragma unroll
    for (int u = 0; u < PER; ++u) { const int o = tid + 512 * u; res[u] = 0.f;
        if (o < NOUT) { const int pp = o / (s * s), r = (o / s) % s, c = o % s; const int R0 = 2 * s * pp + s, C0 = 2 * s * pp;
            const LAS float* ar = sA + (R0 + r) * 68 + C0; const LAS float* xc = sX + C0 * 68 + C0 + c; float acc = 0.f;
#pragma unroll
            for (int k4 = 0; k4 < s / 4; ++k4) { const f32x4 a = *(const LAS f32x4*)(ar + 4 * k4);
                acc += a.x * xc[(4 * k4) * 68] + a.y * xc[(4 * k4 + 1) * 68] + a.z * xc[(4 * k4 + 2) * 68] + a.w * xc[(4 * k4 + 3) * 68]; }
            sM[pp * (s * MS) + r * MS + c] = acc; } }
    __syncthreads();
#pragma unroll
    for (int u = 0; u < PER; ++u) { const int o = tid + 512 * u;
        if (o < NOUT) { const int pp = o / (s * s), r = (o / s) % s, c = o % s; const int R0 = 2 * s * pp + s, C0 = 2 * s * pp;
            const LAS float* xr = sX + (R0 + r) * 68 + R0; const LAS float* mc = sM + pp * (s * MS) + c; float acc = 0.f;
#pragma unroll
            for (int k4 = 0; k4 < s / 4; ++k4) { const f32x4 a = *(const LAS f32x4*)(xr + 4 * k4);
                acc += a.x * mc[(4 * k4) * MS] + a.y * mc[(4 * k4 + 1) * MS] + a.z * mc[(4 * k4 + 2) * MS] + a.w * mc[(4 * k4 + 3) * MS]; }
            sX[(R0 + r) * 68 + C0 + c] = -acc; } }
    __syncthreads();
}
template <int s> DI void tri_level_mfma(LAS float* sA, LAS float* sX, LAS float* sM, int tid) {
    constexpr int NP = 32 / s, T1 = s / 16, TPP = T1 * T1, MS = s + 4;
    const int wv = __builtin_amdgcn_readfirstlane(tid >> 6), l = tid & 63, li = l & 15, lk = l >> 4;
    const bool on = wv < NP * TPP;
    const int pp = wv / TPP, tt = wv % TPP, tr = tt / T1, tc = tt % T1;
    const int R0 = 2 * s * pp + s, C0 = 2 * s * pp;
    if (on) { f32x4 acc = (f32x4){0.f, 0.f, 0.f, 0.f};
#pragma unroll
        for (int ks = 0; ks < s / 4; ++ks) { const float a = sA[(R0 + 16 * tr + li) * 68 + C0 + 4 * ks + lk]; const float b = sX[(C0 + 4 * ks + lk) * 68 + C0 + 16 * tc + li];
            acc = __builtin_amdgcn_mfma_f32_16x16x4f32(a, b, acc, 0, 0, 0); }
#pragma unroll
        for (int reg = 0; reg < 4; ++reg) sM[pp * (s * MS) + (16 * tr + 4 * lk + reg) * MS + 16 * tc + li] = acc[reg]; }
    __syncthreads();
    if (on) { f32x4 acc = (f32x4){0.f, 0.f, 0.f, 0.f};
#pragma unroll
        for (int ks = 0; ks < s / 4; ++ks) { const float a = sX[(R0 + 16 * tr + li) * 68 + R0 + 4 * ks + lk]; const float b = sM[pp * (s * MS) + (4 * ks + lk) * MS + 16 * tc + li];
            acc = __builtin_amdgcn_mfma_f32_16x16x4f32(a, b, acc, 0, 0, 0); }
#pragma unroll
        for (int reg = 0; reg < 4; ++reg) sX[(R0 + 16 * tr + 4 * lk + reg) * 68 + C0 + 16 * tc + li] = -acc[reg]; }
    __syncthreads();
}
DI void tri_inverse(LAS float* sA, LAS float* sX, LAS float* sM, LAS bf16_t* sTi, int tid, int C) {
    if (tid < 64) { const int blk = tid >> 3, c = tid & 7; const LAS float* ab = sA + (8 * blk) * 68 + 8 * blk; float x[8];
        f32x4 a0[8], a1[8];
#pragma unroll
        for (int r = 1; r < 8; ++r) { a0[r] = *(const LAS f32x4*)(ab + r * 68); a1[r] = *(const LAS f32x4*)(ab + r * 68 + 4); }
#pragma unroll
        for (int r = 0; r < 8; ++r) { float sacc = (r == c) ? 1.f : 0.f;
#pragma unroll
            for (int m = 0; m < r; ++m) sacc -= ((m < 4) ? a0[r][m & 3] : a1[r][m & 3]) * x[m];
            x[r] = sacc; }
#pragma unroll
        for (int r = 0; r < 8; ++r) sX[(8 * blk + r) * 68 + 8 * blk + c] = x[r];
    }
    __syncthreads();
    if (C > 8) tri_level<8>(sA, sX, sM, tid);
    if (C > 16) tri_level_mfma<16>(sA, sX, sM, tid);
    if (C > 32) tri_level_mfma<32>(sA, sX, sM, tid);
    for (int idx = tid; idx < 64 * 32; idx += 512) { const int i = idx >> 5, j2 = (idx & 31) * 2; *(LAS unsigned*)(sTi + i * 72 + j2) = pk2(sX[i * 68 + j2], sX[i * 68 + j2 + 1]); }
}

template <int KS> DI void mma32_gBk(f32x16& acc, const LAS bf16_t* A, int lda, const float* B, int ldb, int lane) {
    const int r = lane & 31, hh = lane >> 5;
    const LAS bf16_t* pa = A + r * lda + 8 * hh; const float* pb = B + (size_t)(8 * hh) * ldb + r;
    float f[KS][8];
#pragma unroll
    for (int ks = 0; ks < KS; ++ks)
#pragma unroll
        for (int j = 0; j < 8; ++j) f[ks][j] = pb[(size_t)(16 * ks + j) * ldb];
    __builtin_amdgcn_sched_barrier(0);
#pragma unroll
    for (int ks = 0; ks < KS; ++ks) { const bf16x8 a = *(const LAS bf16x8*)(pa + 16 * ks);
        u32x4 bw; bw.x = pk2(f[ks][0], f[ks][1]); bw.y = pk2(f[ks][2], f[ks][3]); bw.z = pk2(f[ks][4], f[ks][5]); bw.w = pk2(f[ks][6], f[ks][7]);
        acc = __builtin_amdgcn_mfma_f32_32x32x16_bf16(a, __builtin_bit_cast(bf16x8, bw), acc, 0, 0, 0); }
}
DI void dn_item(const Params& p, LAS unsigned char* lds, int b, int h, int dvh, bool prompt) {
    const bool bat = !prompt;
    const int tid0 = otid(), w = __builtin_amdgcn_readfirstlane(tid0 >> 6);
    LAS bf16_t* sQ = (LAS bf16_t*)(lds);
    LAS bf16_t* sK = (LAS bf16_t*)(lds + 17408);
    LAS bf16_t* sKT = (LAS bf16_t*)(lds + 34816);
    LAS bf16_t* sV = (LAS bf16_t*)(lds + 53248);
    LAS bf16_t* sST = (LAS bf16_t*)(lds + 62464);
    LAS float* sA = (LAS float*)(lds + 79872);
    LAS bf16_t* sRT = (LAS bf16_t*)(lds + 79872);
    LAS bf16_t* sUT = (LAS bf16_t*)(lds + 79872 + 9216);
    LAS bf16_t* sUdT = (LAS bf16_t*)(lds + 79872 + 18432);
    LAS float* sX = (LAS float*)(lds + 97280);
    LAS float* sM = (LAS float*)(lds + 114688);
    LAS bf16_t* sTi = (LAS bf16_t*)(lds + 119296);
    LAS bf16_t* sAqk = (LAS bf16_t*)(lds + 128512);
    LAS float* sHalo = (LAS float*)(lds + 137728);
    LAS float* sG = (LAS float*)(lds + 145408);
    LAS float* sBeta = (LAS float*)(lds + 145664);
    LAS float* sCw = (LAS float*)(lds + 145920);
    const int T = prompt ? TP : 64, row0 = prompt ? b * TP : MPR + b * 64;
    const bf16_t* QKV = (const bf16_t*)(p.ws + WS_QKV);
    bf16_t* QKVo = (bf16_t*)(p.ws + WS_QKV);
    const float* GDN = (const float*)(p.ws + WS_GDN); const float* BETA = (const float*)(p.ws + WS_BETA);
    const int aS = w >> 1, tjS = w & 1;
    f32x16 accS;
    {
        const int lane = tid0 & 63, hh = lane >> 5;
        const float* st = p.in[3] + ((size_t)(b * 8 + h) * 128) * 128 + dvh * 64 + 32 * tjS + (lane & 31);
#pragma unroll
        for (int reg = 0; reg < 16; ++reg) accS[reg] = 0.f;
        (void)st;
#pragma unroll
        for (int g4 = 0; g4 < 4; ++g4) { u32x2 v; v.x = pk2(accS[4 * g4], accS[4 * g4 + 1]); v.y = pk2(accS[4 * g4 + 2], accS[4 * g4 + 3]);
            *(LAS u32x2*)(sST + (32 * tjS + (lane & 31)) * 136 + 32 * aS + 8 * g4 + 4 * hh) = v; }
    }
    const int run = w;
    for (int idx = tid0; idx < 960; idx += 512) {
        const int j = idx / 320, c = idx - j * 320; const int cgi = c >> 3, e = c & 7;
        int chh; if (cgi < 16) chh = h * 128 + cgi * 8; else if (cgi < 32) chh = 1024 + h * 128 + (cgi - 16) * 8; else chh = 2048 + h * 128 + dvh * 64 + (cgi - 32) * 8;
        sHalo[idx] = 0.f;
        sCw[idx] = p.in[9][(size_t)j * QKVW + chh + e];
    }
    if (tid0 < 320) { const int c = tid0, cgi = c >> 3, e = c & 7; int chh; if (cgi < 16) chh = h * 128 + cgi * 8; else if (cgi < 32) chh = 1024 + h * 128 + (cgi - 16) * 8; else chh = 2048 + h * 128 + dvh * 64 + (cgi - 32) * 8;
        sCw[960 + c] = p.in[9][(size_t)3 * QKVW + chh + e]; }
    __syncthreads();
    int hb = 0;
    const float* cw = p.in[9];
    u32x4 nraw[11];
#define DN_LOADRAW(T0N) do { const int l_ = otid() & 63; const int Cn_ = (T - (T0N)) < 64 ? (T - (T0N)) : 64; \
        if (l_ < 40 && run * 8 < Cn_) { int ch_; if (l_ < 16) ch_ = h * 128 + l_ * 8; else if (l_ < 32) ch_ = 1024 + h * 128 + (l_ - 16) * 8; else ch_ = 2048 + h * 128 + dvh * 64 + (l_ - 32) * 8; \
            const bf16_t* b_ = QKV + (size_t)(row0 + (T0N) + run * 8) * QKVW + ch_; \
            _Pragma("unroll") for (int q_ = 0; q_ < 8; ++q_) nraw[3 + q_] = *(const u32x4*)(b_ + (size_t)q_ * QKVW); \
            if (run > 0 && !bat) { _Pragma("unroll") for (int q_ = 0; q_ < 3; ++q_) nraw[q_] = *(const u32x4*)(b_ - (size_t)(3 - q_) * QKVW); } } } while (0)
    DN_LOADRAW(0);
    float ng = 0.f, nbe = 0.f;
    if (w == 0) { const int l_ = tid0 & 63; const int C0_ = T < 64 ? T : 64; if (l_ < C0_) { ng = GDN[(size_t)(row0 + l_) * 8 + h]; nbe = BETA[(size_t)(row0 + l_) * 8 + h]; } }
    for (int t0 = 0; t0 < T; t0 += 64) {
        const int C = (T - t0) < 64 ? (T - t0) : 64;
        const int tid = otid(), lane = tid & 63, hh = lane >> 5, cg_ = lane;
        const bool act = cg_ < 40;
        int ch = 0;
        if (cg_ < 16) ch = h * 128 + cg_ * 8; else if (cg_ < 32) ch = 1024 + h * 128 + (cg_ - 16) * 8; else ch = 2048 + h * 128 + dvh * 64 + (cg_ - 32) * 8;
        if (w == 0) { float g = ng, be = nbe; ng = 0.f; nbe = 0.f;
            if (t0 + 64 < T) { const int Cn = (T - t0 - 64) < 64 ? (T - t0 - 64) : 64; if (lane < Cn) { ng = GDN[(size_t)(row0 + t0 + 64 + lane) * 8 + h]; nbe = BETA[(size_t)(row0 + t0 + 64 + lane) * 8 + h]; } }
            {
                const int lp = lane & 7; float t_;
                t_ = __builtin_bit_cast(float, __builtin_amdgcn_update_dpp(0, __builtin_bit_cast(int, g), 0x111, 0xf, 0xf, false)); g += (!bat || lp >= 1) ? t_ : 0.f;
                t_ = __builtin_bit_cast(float, __builtin_amdgcn_update_dpp(0, __builtin_bit_cast(int, g), 0x112, 0xf, 0xf, false)); g += (!bat || lp >= 2) ? t_ : 0.f;
                t_ = __builtin_bit_cast(float, __builtin_amdgcn_update_dpp(0, __builtin_bit_cast(int, g), 0x114, 0xf, 0xf, false)); g += (!bat || lp >= 4) ? t_ : 0.f;
                if (!bat) { g = dpp_add<0x118, 0xf>(g); g = dpp_add<0x142, 0xa>(g); g = dpp_add<0x143, 0xc>(g); }
            }
            sG[lane] = g; sBeta[lane] = be; }
        float val[8][8];
        const bool mine = act && (run * 8 < C);
        if (mine) {
            float cwv[4][8];
#pragma unroll
            for (int j = 0; j < 4; ++j) { const f32x4 a = *(const LAS f32x4*)(sCw + j * 320 + cg_ * 8), bq = *(const LAS f32x4*)(sCw + j * 320 + cg_ * 8 + 4);
                cwv[j][0] = a.x; cwv[j][1] = a.y; cwv[j][2] = a.z; cwv[j][3] = a.w; cwv[j][4] = bq.x; cwv[j][5] = bq.y; cwv[j][6] = bq.z; cwv[j][7] = bq.w; }
            float r0[8], r1[8], r2[8], r3[8];
            if (bat) { const float* cs = p.in[2] + (size_t)(8 * b + run) * 3 * QKVW + ch;
#pragma unroll
                for (int e = 0; e < 8; ++e) { r0[e] = cs[e]; r1[e] = cs[QKVW + e]; r2[e] = cs[2 * QKVW + e]; }
            } else if (run == 0) {
#pragma unroll
                for (int e = 0; e < 8; ++e) { r0[e] = sHalo[hb * 960 + 0 * 320 + cg_ * 8 + e]; r1[e] = sHalo[hb * 960 + 320 + cg_ * 8 + e]; r2[e] = sHalo[hb * 960 + 640 + cg_ * 8 + e]; }
            } else {
                unpack8(nraw[0], r0); unpack8(nraw[1], r1); unpack8(nraw[2], r2);
            }
#pragma unroll
            for (int tt = 0; tt < 8; ++tt) {
                unpack8(nraw[3 + tt], r3);
#pragma unroll
                for (int e = 0; e < 8; ++e) { const float x = cwv[0][e] * r0[e] + cwv[1][e] * r1[e] + cwv[2][e] * r2[e] + cwv[3][e] * r3[e]; val[tt][e] = siluf_(x); }
#pragma unroll
                for (int e = 0; e < 8; ++e) { r0[e] = r1[e]; r1[e] = r2[e]; r2[e] = r3[e]; }
            }
            if (bat) { if (cg_ >= 32 || dvh == 0) { float* co = p.out + O_CONVS + (size_t)(8 * b + run) * 3 * QKVW + ch;
#pragma unroll
                    for (int e = 0; e < 8; ++e) { co[e] = r0[e]; co[QKVW + e] = r1[e]; co[2 * QKVW + e] = r2[e]; } }
            } else if (run * 8 + 8 == C) {
#pragma unroll
                for (int e = 0; e < 8; ++e) { sHalo[(hb ^ 1) * 960 + cg_ * 8 + e] = r0[e]; sHalo[(hb ^ 1) * 960 + 320 + cg_ * 8 + e] = r1[e]; sHalo[(hb ^ 1) * 960 + 640 + cg_ * 8 + e] = r2[e]; }
            }
        } else {
#pragma unroll
            for (int tt = 0; tt < 8; ++tt)
#pragma unroll
                for (int e = 0; e < 8; ++e) val[tt][e] = 0.f;
        }
        if (t0 + 64 < T) DN_LOADRAW(t0 + 64);
#pragma unroll
        for (int tt = 0; tt < 8; ++tt) {
            float ss = 0.f;
#pragma unroll
            for (int e = 0; e < 8; ++e) ss += val[tt][e] * val[tt][e];
            ss = red16(ss);
            float sc = 1.f;
            if (cg_ < 32) { sc = rsqrtf_(ss + 1e-6f); if (cg_ < 16) sc *= 0.08838834764831845f; }
#pragma unroll
            for (int e = 0; e < 8; ++e) val[tt][e] *= sc;
        }
        if (act) {
            if (cg_ < 16) {
#pragma unroll
                for (int tt = 0; tt < 8; ++tt) *(LAS u32x4*)(sQ + (run * 8 + tt) * 136 + cg_ * 8) = pack8(val[tt]);
            } else if (cg_ < 32) {
#pragma unroll
                for (int tt = 0; tt < 8; ++tt) *(LAS u32x4*)(sK + (run * 8 + tt) * 136 + (cg_ - 16) * 8) = pack8(val[tt]);
#pragma unroll
                for (int e = 0; e < 8; ++e) { float col[8];
#pragma unroll
                    for (int tt = 0; tt < 8; ++tt) col[tt] = val[tt][e];
                    *(LAS u32x4*)(sKT + ((cg_ - 16) * 8 + e) * 72 + run * 8) = pack8(col); }
            } else {
#pragma unroll
                for (int tt = 0; tt < 8; ++tt) *(LAS u32x4*)(sV + (run * 8 + tt) * 72 + (cg_ - 32) * 8) = pack8(val[tt]);
            }
        }
        hb ^= 1;
        __syncthreads();
        {
            for (int i = tid; i < 64 * 17; i += 512) ((LAS f32x4*)sX)[i] = (f32x4){0.f, 0.f, 0.f, 0.f};
            const int type = w >> 2, ti = (w >> 1) & 1, tj = w & 1;
            f32x16 acc;
#pragma unroll
            for (int reg = 0; reg < 16; ++reg) acc[reg] = 0.f;
            if (!(ti == 0 && tj == 1)) mma32<8>(acc, sK + 32 * tj * 136, 136, (type ? sQ : sK) + 32 * ti * 136, 136, lane);
            const int i = 32 * ti + (lane & 31); const float Gi = sG[i], bi = sBeta[i];
#pragma unroll
            for (int g4 = 0; g4 < 4; ++g4) { const int j0 = 32 * tj + 8 * g4 + 4 * hh; float o4[4];
#pragma unroll
                for (int e = 0; e < 4; ++e) { const int j = j0 + e; const float dec = __expf(fminf(Gi - sG[j], 0.f));
                    const bool same = !bat || ((i >> 3) == (j >> 3));
                    o4[e] = (type == 0) ? ((i > j && same) ? bi * acc[4 * g4 + e] * dec : 0.f) : ((i >= j && same) ? acc[4 * g4 + e] * dec : 0.f); }
                if (type == 0) *(LAS f32x4*)(sA + i * 68 + j0) = (f32x4){o4[0], o4[1], o4[2], o4[3]};
                else { u32x2 v; v.x = pk2(o4[0], o4[1]); v.y = pk2(o4[2], o4[3]); *(LAS u32x2*)(sAqk + i * 72 + j0) = v; } }
        }
        __syncthreads();
        tri_inverse(sA, sX, sM, sTi, tid, bat ? 8 : C);
        f32x16 accO;
        {
            const int ti = (w >> 1) & 1, tj = w & 1;
            f32x16 acc;
#pragma unroll
            for (int reg = 0; reg < 16; ++reg) acc[reg] = 0.f;
            if (!bat) mma32<8>(acc, ((w < 4) ? sK : sQ) + 32 * ti * 136, 136, sST + 32 * tj * 136, 136, lane);
            else {
#pragma unroll
                for (int q = 0; q < 4; ++q) { f32x16 aq;
#pragma unroll
                    for (int reg = 0; reg < 16; ++reg) aq[reg] = 0.f;
                    mma32_gBk<8>(aq, ((w < 4) ? sK : sQ) + 32 * ti * 136, 136, p.in[3] + (size_t)((8 * b + 4 * ti + q) * 8 + h) * 16384 + dvh * 64 + 32 * tj, 128, lane);
#pragma unroll
                    for (int e = 0; e < 4; ++e) acc[4 * q + e] = aq[4 * q + e]; }
            }
            const int j = 32 * tj + (lane & 31);
            if (w < 4) {
#pragma unroll
                for (int g4 = 0; g4 < 4; ++g4) { float rr[4];
#pragma unroll
                    for (int e = 0; e < 4; ++e) { const int i = 32 * ti + 8 * g4 + 4 * hh + e; rr[e] = sBeta[i] * (bflo((unsigned)sV[i * 72 + j]) - __expf(sG[i]) * acc[4 * g4 + e]); }
                    u32x2 v; v.x = pk2(rr[0], rr[1]); v.y = pk2(rr[2], rr[3]);
                    *(LAS u32x2*)(sRT + j * 72 + 32 * ti + 8 * g4 + 4 * hh) = v; }
            } else {
#pragma unroll
                for (int reg = 0; reg < 16; ++reg) { const int i = 32 * ti + crow(reg, hh); accO[reg] = __expf(sG[i]) * acc[reg]; }
            }
        }
        __syncthreads();
        if (w < 4) {
            const int ti = (w >> 1) & 1, tj = w & 1;
            f32x16 acc;
#pragma unroll
            for (int reg = 0; reg < 16; ++reg) acc[reg] = 0.f;
            mma32<4>(acc, sTi + 32 * ti * 72, 72, sRT + 32 * tj * 72, 72, lane);
            const int j = 32 * tj + (lane & 31);
#pragma unroll
            for (int g4 = 0; g4 < 4; ++g4) { float d[4];
#pragma unroll
                for (int e = 0; e < 4; ++e) { const int i = 32 * ti + 8 * g4 + 4 * hh + e; d[e] = acc[4 * g4 + e] * __expf(sG[bat ? (i | 7) : 63] - sG[i]); }
                u32x2 v; v.x = pk2(acc[4 * g4], acc[4 * g4 + 1]); v.y = pk2(acc[4 * g4 + 2], acc[4 * g4 + 3]);
                u32x2 vd; vd.x = pk2(d[0], d[1]); vd.y = pk2(d[2], d[3]);
                *(LAS u32x2*)(sUT + j * 72 + 32 * ti + 8 * g4 + 4 * hh) = v;
                *(LAS u32x2*)(sUdT + j * 72 + 32 * ti + 8 * g4 + 4 * hh) = vd; }
        }
        __syncthreads();
        if (w >= 4) {
            const int ti = (w >> 1) & 1, tj = w & 1;
            mma32<4>(accO, sAqk + 32 * ti * 72, 72, sUT + 32 * tj * 72, 72, lane);
            bf16_t* ob = QKVo + (size_t)(row0 + t0) * QKVW + 2048 + h * 128 + dvh * 64 + 32 * tj + (lane & 31);
#pragma unroll
            for (int reg = 0; reg < 16; ++reg) { const int i = 32 * ti + crow(reg, hh); if (i < C) ob[(size_t)i * QKVW] = (bf16_t)f2bf(accO[reg]); }
        }
        if (!bat) {
            const float gl = __expf(sG[63]);
#pragma unroll
            for (int reg = 0; reg < 16; ++reg) accS[reg] *= gl;
            mma32<4>(accS, sKT + 32 * aS * 72, 72, sUdT + 32 * tjS * 72, 72, lane);
#pragma unroll
            for (int g4 = 0; g4 < 4; ++g4) { u32x2 v; v.x = pk2(accS[4 * g4], accS[4 * g4 + 1]); v.y = pk2(accS[4 * g4 + 2], accS[4 * g4 + 3]);
                *(LAS u32x2*)(sST + (32 * tjS + (lane & 31)) * 136 + 32 * aS + 8 * g4 + 4 * hh) = v; }
        } else {
            const int sq = w, mk = sq >> 1; const bool minef = (hh == (sq & 1)); const float gl = __expf(sG[8 * sq + 7]);
            const float* st0 = p.in[3] + (size_t)((8 * b + sq) * 8 + h) * 16384 + dvh * 64; float* so0 = p.out + O_DNS + (size_t)((8 * b + sq) * 8 + h) * 16384 + dvh * 64;
#pragma unroll
            for (int a2_ = 0; a2_ < 4; ++a2_) { f32x16 ah0, ah1; const int v = lane & 31;
#pragma unroll
                for (int reg = 0; reg < 16; ++reg) { const float* sp = st0 + (size_t)(32 * a2_ + crow(reg, hh)) * 128 + v; ah0[reg] = sp[0]; ah1[reg] = sp[32]; }
                __builtin_amdgcn_sched_barrier(0);
                const u32x4 z4 = (u32x4){0u, 0u, 0u, 0u};
                const u32x4 ka = minef ? *(const LAS u32x4*)(sKT + (32 * a2_ + (lane & 31)) * 72 + 16 * mk + 8 * hh) : z4;
                const bf16x8 ub0 = *(const LAS bf16x8*)(sUdT + (lane & 31) * 72 + 16 * mk + 8 * hh), ub1 = *(const LAS bf16x8*)(sUdT + (32 + (lane & 31)) * 72 + 16 * mk + 8 * hh);
#pragma unroll
                for (int reg = 0; reg < 16; ++reg) { ah0[reg] *= gl; ah1[reg] *= gl; }
                ah0 = __builtin_amdgcn_mfma_f32_32x32x16_bf16(__builtin_bit_cast(bf16x8, ka), ub0, ah0, 0, 0, 0);
                ah1 = __builtin_amdgcn_mfma_f32_32x32x16_bf16(__builtin_bit_cast(bf16x8, ka), ub1, ah1, 0, 0, 0);
#pragma unroll
                for (int reg = 0; reg < 16; ++reg) { float* dp = so0 + (size_t)(32 * a2_ + crow(reg, hh)) * 128 + v; dp[0] = ah0[reg]; dp[32] = ah1[reg]; } }
        }
        __syncthreads();
    }
    if (prompt) {
        const int tid = otid(), lane = tid & 63, hh = lane >> 5;
        float* so = p.out + (prompt ? O_DNP : O_DNS) + ((size_t)(b * 8 + h) * 128) * 128 + dvh * 64 + 32 * tjS + (lane & 31);
#pragma unroll
        for (int reg = 0; reg < 16; ++reg) so[(size_t)(32 * aS + crow(reg, hh)) * 128] = accS[reg];
    }
    float* co = p.out + (prompt ? O_CONVP : O_CONVS) + (size_t)b * 3 * QKVW;
    for (int idx = otid(); idx < 960; idx += 512) {
        if (!prompt) break;
        const int j = idx / 320, c = idx - j * 320; const int cgi = c >> 3, e = c & 7;
        if (cgi < 32 && dvh != 0) continue;
        int chh; if (cgi < 16) chh = h * 128 + cgi * 8; else if (cgi < 32) chh = 1024 + h * 128 + (cgi - 16) * 8; else chh = 2048 + h * 128 + dvh * 64 + (cgi - 32) * 8;
        co[(size_t)j * QKVW + chh + e] = sHalo[hb * 960 + idx];
    }
    __syncthreads();
}

template <int KS> DI void mma32_gB(f32x16& acc, const LAS bf16_t* A, int lda, const float* Bt, int ldb, int lane) {
    const int r = lane & 31, hh = lane >> 5;
    const LAS bf16_t* pa = A + r * lda + 8 * hh; const float* pb = Bt + (size_t)r * ldb + 8 * hh;
    f32x4 b0[KS], b1[KS];
#pragma unroll
    for (int ks = 0; ks < KS; ++ks) { b0[ks] = *(const f32x4*)(pb + 16 * ks); b1[ks] = *(const f32x4*)(pb + 16 * ks + 4); }
    __builtin_amdgcn_sched_barrier(0);
#pragma unroll
    for (int ks = 0; ks < KS; ++ks) { const bf16x8 a = *(const LAS bf16x8*)(pa + 16 * ks);
        u32x4 bw; bw.x = pk2(b0[ks].x, b0[ks].y); bw.y = pk2(b0[ks].z, b0[ks].w); bw.z = pk2(b1[ks].x, b1[ks].y); bw.w = pk2(b1[ks].z, b1[ks].w);
        acc = __builtin_amdgcn_mfma_f32_32x32x16_bf16(a, __builtin_bit_cast(bf16x8, bw), acc, 0, 0, 0); }
}
DI void rw_item(const Params& p, LAS unsigned char* lds, int b, int h, bool prompt) {
    const bool bat = !prompt;
    const int tid0 = otid(), w = __builtin_amdgcn_readfirstlane(tid0 >> 6);
    LAS bf16_t* sAt = (LAS bf16_t*)(lds);
    LAS bf16_t* sRt = (LAS bf16_t*)(lds + 9216);
    LAS bf16_t* sKt = (LAS bf16_t*)(lds + 18432);
    LAS bf16_t* sRT = sKt;
    LAS bf16_t* sBt = (LAS bf16_t*)(lds + 27648);
    LAS bf16_t* sYT = sBt;
    LAS bf16_t* sW2T = (LAS bf16_t*)(lds + 36864);
    LAS bf16_t* sKdT = (LAS bf16_t*)(lds + 128000);
    LAS bf16_t* sA2T = (LAS bf16_t*)(lds + 46080);
    LAS bf16_t* sNBdT = (LAS bf16_t*)(lds + 137216);
    LAS bf16_t* sVT = (LAS bf16_t*)(lds + 55296);
    LAS bf16_t* sAak = (LAS bf16_t*)(lds + 64512);
    LAS bf16_t* sArk = (LAS bf16_t*)(lds + 73728);
    LAS bf16_t* sNArb = (LAS bf16_t*)(lds + 82944);
    LAS bf16_t* sTi = (LAS bf16_t*)(lds + 92160);
    LAS bf16_t* sST = (LAS bf16_t*)(lds + 101376);
    LAS float* sA = (LAS float*)(lds + 110592);
    LAS float* sO = sA; LAS float* sLw = sA;
    LAS bf16_t* sTWb = sAak; LAS bf16_t* sALb = sArk;
    LAS float* sX = (LAS float*)(lds + 128000);
    LAS float* sLa = sX; LAS float* sL = sX;
    LAS float* sM = (LAS float*)(lds + 145408);
    LAS float* sPrev = (LAS float*)(lds + 150016);
    LAS float* sPC = (LAS float*)(lds + 153600);
    LAS float* sBonus = (LAS float*)(lds + 153856);
    LAS float* sPCb = (LAS float*)(lds + 154112);
    LAS float* sCst = (LAS float*)(lds + 156160);
    const int T = prompt ? TP : 64, row0 = prompt ? b * TP : MPR + b * 64;
    bf16_t* RW = (bf16_t*)(p.ws + WS_RW);
    const float* mu = p.in[13];
    const int aS = (w >> 1) & 1, tjS = w & 1;
    f32x16 accH;
    {
        const int lane = tid0 & 63, hh = lane >> 5;
#pragma unroll
        for (int reg = 0; reg < 16; ++reg) accH[reg] = 0.f;
        if (w < 4) {
#pragma unroll
            for (int g4 = 0; g4 < 4; ++g4) { u32x2 v; v.x = pk2(accH[4 * g4], accH[4 * g4 + 1]); v.y = pk2(accH[4 * g4 + 2], accH[4 * g4 + 3]);
                *(LAS u32x2*)(sST + (32 * tjS + (lane & 31)) * 72 + 32 * aS + 8 * g4 + 4 * hh) = v; }
        }
    }
    for (int idx = tid0; idx < 768; idx += 512) { const int k = idx >> 6, c = idx & 63; float v;
        if (k < 3) v = p.in[13][k * 1024 + h * 64 + c]; else if (k == 3) v = p.in[13][3072 + c]; else if (k == 4) v = p.in[13][3136 + c];
        else { const int ii = (k == 5) ? 14 : (k == 6) ? 16 : (k == 7) ? 19 : (k == 8) ? 20 : (k == 9) ? 21 : (k == 10) ? 22 : 23; v = p.in[ii][h * 64 + c]; }
        sCst[idx] = v; }
    for (int idx = tid0; idx < 4096; idx += 512) { const int j = idx >> 6, c = idx & 63;
        sW2T[c * 72 + j] = (bf16_t)f2bf(p.in[15][(size_t)j * 1024 + h * 64 + c]); sA2T[c * 72 + j] = (bf16_t)f2bf(p.in[17][(size_t)j * 1024 + h * 64 + c]); }
    for (int i = tid0; i < 448; i += 512) {
        int col; if (i < 64) col = h * 64 + i; else if (i < 128) col = 1024 + h * 64 + (i - 64); else if (i < 192) col = 2048 + h * 64 + (i - 128); else col = 3072 + (i - 192);
        sPrev[i] = 0.f;
    }
    __syncthreads();
    int pb = 0;
    u32x4 ncu[5], npv[5];
#define RW_LOADRAW(T0N) do { const int ti_ = otid(); const int t_ = ti_ >> 3, pa_ = ti_ & 7; const int Cn_ = (T - (T0N)) < 64 ? (T - (T0N)) : 64; \
        if (t_ < Cn_) { const size_t r_ = (size_t)(row0 + (T0N) + t_); const int cb_[5] = {h * 64 + 8 * pa_, 1024 + h * 64 + 8 * pa_, 2048 + h * 64 + 8 * pa_, 3072 + 8 * pa_, 3136 + 8 * pa_}; \
            _Pragma("unroll") for (int s_ = 0; s_ < 5; ++s_) { ncu[s_] = *(const u32x4*)(RW + r_ * RWW + cb_[s_]); \
                if (t_ > 0 && !(bat && (t_ & 7) == 0)) npv[s_] = *(const u32x4*)(RW + (r_ - 1) * RWW + cb_[s_]); } } } while (0)
    RW_LOADRAW(0);
    for (int t0 = 0; t0 < T; t0 += 64) {
        const int C = (T - t0) < 64 ? (T - t0) : 64;
        const int tid = otid(), lane = tid & 63, hh = lane >> 5;
        const int t = tid >> 3, part = tid & 7;
        const int cb[5] = {h * 64 + 8 * part, 1024 + h * 64 + 8 * part, 2048 + h * 64 + 8 * part, 3072 + 8 * part, 3136 + 8 * part};
        const bool actv = t < C;
        const size_t row = (size_t)(row0 + t0 + t);
        float xr[8], kr[8], vv[8];
#pragma unroll
        for (int e = 0; e < 8; ++e) { xr[e] = 0.f; kr[e] = 0.f; vv[e] = 0.f; }
        if (actv) {
#pragma unroll
            for (int s = 0; s < 5; ++s) {
                float cur[8], prv[8];
                unpack8(ncu[s], cur);
                if (t > 0 && !(bat && (t & 7) == 0)) unpack8(npv[s], prv);
                else if (bat) { const float* sp = p.in[4] + (size_t)(8 * b + (t >> 3)) * RWW + cb[s]; const f32x4 q0 = *(const f32x4*)sp, q1 = *(const f32x4*)(sp + 4);
                    prv[0] = q0.x; prv[1] = q0.y; prv[2] = q0.z; prv[3] = q0.w; prv[4] = q1.x; prv[5] = q1.y; prv[6] = q1.z; prv[7] = q1.w; }
                else {
#pragma unroll
                    for (int e = 0; e < 8; ++e) prv[e] = sPrev[pb * 448 + s * 64 + 8 * part + e];
                }
                if (bat) { if ((t & 7) == 7 && (s < 3 || h == 0)) { float* so = p.out + O_SHIFTS + (size_t)(8 * b + (t >> 3)) * RWW + cb[s];
                        *(f32x4*)so = (f32x4){cur[0], cur[1], cur[2], cur[3]}; *(f32x4*)(so + 4) = (f32x4){cur[4], cur[5], cur[6], cur[7]}; } }
                else if (t == C - 1) {
#pragma unroll
                    for (int e = 0; e < 8; ++e) sPrev[(pb ^ 1) * 448 + s * 64 + 8 * part + e] = cur[e];
                }
                const f32x4 m0 = *(const LAS f32x4*)(sCst + s * 64 + 8 * part), m1 = *(const LAS f32x4*)(sCst + s * 64 + 8 * part + 4);
                const float mm[8] = {m0.x, m0.y, m0.z, m0.w, m1.x, m1.y, m1.z, m1.w};
                float xm[8];
#pragma unroll
                for (int e = 0; e < 8; ++e) xm[e] = cur[e] + (prv[e] - cur[e]) * mm[e];
                if (s == 0) {
#pragma unroll
                    for (int e = 0; e < 8; ++e) xr[e] = xm[e];
                } else if (s == 1) {
#pragma unroll
                    for (int e = 0; e < 8; ++e) kr[e] = xm[e];
                } else if (s == 2) {
#pragma unroll
                    for (int e = 0; e < 8; ++e) vv[e] = xm[e];
                } else if (s == 3) {
#pragma unroll
                    for (int e = 0; e < 8; ++e) xm[e] = tanhf_(xm[e]);
                    *(LAS u32x4*)(sTWb + t * 72 + 8 * part) = pack8(xm);
                } else {
                    *(LAS u32x4*)(sALb + t * 72 + 8 * part) = pack8(xm);
                }
            }
        }
        if (t0 + 64 < T) RW_LOADRAW(t0 + 64);
        if (!actv) { const u32x4 z = (u32x4){0u, 0u, 0u, 0u}; *(LAS u32x4*)(sTWb + t * 72 + 8 * part) = z; *(LAS u32x4*)(sALb + t * 72 + 8 * part) = z; }
        __syncthreads();
        {
            const int mat = w >> 2, ti = (w >> 1) & 1, tj = w & 1;
            f32x16 acc;
#pragma unroll
            for (int reg = 0; reg < 16; ++reg) acc[reg] = 0.f;
            mma32<4>(acc, (mat ? sALb : sTWb) + 32 * ti * 72, 72, (mat ? sA2T : sW2T) + 32 * tj * 72, 72, lane);
            LAS float* dstl = mat ? sLa : sLw; const int j = 32 * tj + (lane & 31);
#pragma unroll
            for (int reg = 0; reg < 16; ++reg) dstl[(32 * ti + crow(reg, hh)) * 65 + j] = acc[reg];
        }
        __syncthreads();
        float lw[8], kk[8], bb[8], kn[8]; float bonus = 0.f;
        {
            float n2 = 0.f, a_[8], kkr[8];
            if (actv) {
                float ws_[8], as_[8];
#pragma unroll
                for (int e = 0; e < 8; ++e) { ws_[e] = sLw[t * 65 + 8 * part + e]; as_[e] = sLa[t * 65 + 8 * part + e]; }
                const int c0 = h * 64 + 8 * part;
#pragma unroll
                for (int e = 0; e < 8; ++e) {
                    lw[e] = -0.6065306597126334f * sigmoidf_(sCst[5 * 64 + 8 * part + e] + ws_[e]);
                    a_[e] = sigmoidf_(sCst[6 * 64 + 8 * part + e] + as_[e]);
                    kkr[e] = kr[e] * sCst[7 * 64 + 8 * part + e]; n2 += kkr[e] * kkr[e];
                    kn[e] = kr[e] * (1.f + (a_[e] - 1.f) * sCst[8 * 64 + 8 * part + e]);
                    bonus += xr[e] * kn[e] * sCst[9 * 64 + 8 * part + e];
                }
            } else {
#pragma unroll
                for (int e = 0; e < 8; ++e) { lw[e] = 0.f; a_[e] = 0.f; kkr[e] = 0.f; kn[e] = 0.f; }
            }
            n2 = red8(n2); bonus = red8(bonus);
            const float rn = rsqrtf_(n2 + 1e-6f);
#pragma unroll
            for (int e = 0; e < 8; ++e) { kk[e] = kkr[e] * rn; bb[e] = kk[e] * a_[e]; }
        }
#pragma unroll
        for (int e = 0; e < 8; ++e) sL[t * 65 + 8 * part + e] = lw[e];
        __syncthreads();
        {
            float x[8];
#pragma unroll
            for (int e = 0; e < 8; ++e) x[e] = sL[lane * 65 + 8 * w + e];
#define DPP_ADD(ctrl, rmask) do { _Pragma("unroll") for (int e = 0; e < 8; ++e) { \
                const float t_ = __builtin_bit_cast(float, __builtin_amdgcn_update_dpp(0, __builtin_bit_cast(int, x[e]), (ctrl), (rmask), 0xf, false)); x[e] += keep ? t_ : 0.f; } } while (0)
            { bool keep = !bat || (lane & 7) >= 1; DPP_ADD(0x111, 0xf); }
            { bool keep = !bat || (lane & 7) >= 2; DPP_ADD(0x112, 0xf); }
            { bool keep = !bat || (lane & 7) >= 4; DPP_ADD(0x114, 0xf); }
            if (!bat) { const bool keep = true; DPP_ADD(0x118, 0xf); DPP_ADD(0x142, 0xa); DPP_ADD(0x143, 0xc); }
#undef DPP_ADD
#pragma unroll
            for (int e = 0; e < 8; ++e) sL[lane * 65 + 8 * w + e] = x[e];
        }
        __syncthreads();
        float kd[8], nbd[8];
        {
            float at[8], rt[8], kt[8], bt[8];
#pragma unroll
            for (int e = 0; e < 8; ++e) {
                const int c = 8 * part + e;
                const float Lt = sL[t * 65 + c], Lp = ((bat ? (t & 7) : t) > 0) ? sL[(t - 1) * 65 + c] : 0.f, Lc = sL[(bat ? (t | 7) : 63) * 65 + c];
                const float ep = __expf(Lp), et = __expf(Lt), ei = __expf(-Lt), ec = __expf(Lc - Lt);
                at[e] = kk[e] * ep; rt[e] = xr[e] * et; kt[e] = kn[e] * ei; bt[e] = bb[e] * ei;
                kd[e] = kn[e] * ec; nbd[e] = -bb[e] * ec; sVT[c * 72 + t] = (bf16_t)f2bf(vv[e]);
                if (t == 0) sPC[c] = __expf(Lc);
                if (bat && (t & 7) == 0) sPCb[(t >> 3) * 64 + c] = __expf(Lc);
            }
            *(LAS u32x4*)(sAt + t * 72 + 8 * part) = pack8(at); *(LAS u32x4*)(sRt + t * 72 + 8 * part) = pack8(rt);
            *(LAS u32x4*)(sKt + t * 72 + 8 * part) = pack8(kt); *(LAS u32x4*)(sBt + t * 72 + 8 * part) = pack8(bt);
            if (part == 0) sBonus[t] = bonus;
        }
        pb ^= 1;
        __syncthreads();
        {
            for (int i = tid; i < 64 * 17; i += 512) ((LAS f32x4*)sX)[i] = (f32x4){0.f, 0.f, 0.f, 0.f};
            const int m = w >> 1, q = w & 1;
            const LAS bf16_t* Aop = (m < 2) ? sAt : sRt; const LAS bf16_t* Bop = (m == 0 || m == 3) ? sBt : sKt;
            LAS bf16_t* dst = (m == 1) ? sAak : (m == 2 ? sArk : sNArb);
#pragma unroll
            for (int rep = 0; rep < 2; ++rep) {
                int ti, tj; bool zero = false;
                if (q == 0) { ti = rep; tj = rep; } else { ti = 1 - rep; tj = rep; if (rep == 1) { ti = 0; tj = 1; zero = true; } }
                f32x16 acc;
#pragma unroll
                for (int reg = 0; reg < 16; ++reg) acc[reg] = 0.f;
                if (!zero) mma32<4>(acc, Bop + 32 * tj * 72, 72, Aop + 32 * ti * 72, 72, lane);
                const int i = 32 * ti + (lane & 31);
#pragma unroll
                for (int g4 = 0; g4 < 4; ++g4) { const int j0 = 32 * tj + 8 * g4 + 4 * hh; float o4[4];
#pragma unroll
                    for (int e = 0; e < 4; ++e) { const int j = j0 + e; const float a = acc[4 * g4 + e];
                        const bool same = !bat || ((i >> 3) == (j >> 3));
                        o4[e] = (m < 2) ? ((i > j && same) ? a : 0.f) : ((i >= j && same) ? (m == 2 ? a : -a) : 0.f); }
                    if (m == 0) { if (!zero) *(LAS f32x4*)(sA + i * 68 + j0) = (f32x4){o4[0], o4[1], o4[2], o4[3]}; }
                    else { u32x2 v; v.x = pk2(o4[0], o4[1]); v.y = pk2(o4[2], o4[3]); *(LAS u32x2*)(dst + i * 72 + j0) = v; } }
            }
        }
        __syncthreads();
        tri_inverse(sA, sX, sM, sTi, tid, bat ? 8 : C);
        f32x16 accO;
        {
            const int ti = (w >> 1) & 1, tj = w & 1;
            f32x16 acc;
#pragma unroll
            for (int reg = 0; reg < 16; ++reg) acc[reg] = 0.f;
            if (!bat) mma32<4>(acc, ((w < 4) ? sAt : sRt) + 32 * ti * 72, 72, sST + 32 * tj * 72, 72, lane);
            else {
#pragma unroll
                for (int q = 0; q < 4; ++q) { f32x16 aq;
#pragma unroll
                    for (int reg = 0; reg < 16; ++reg) aq[reg] = 0.f;
                    mma32_gB<4>(aq, ((w < 4) ? sAt : sRt) + 32 * ti * 72, 72, p.in[5] + ((size_t)((8 * b + 4 * ti + q) * 16 + h) * 64 + 32 * tj) * 64, 64, lane);
#pragma unroll
                    for (int e = 0; e < 4; ++e) acc[4 * q + e] = aq[4 * q + e]; }
            }
            mma32<4>(acc, ((w < 4) ? sAak : sArk) + 32 * ti * 72, 72, sVT + 32 * tj * 72, 72, lane);
            if (w < 4) {
                const int j = 32 * tj + (lane & 31);
#pragma unroll
                for (int g4 = 0; g4 < 4; ++g4) { u32x2 v; v.x = pk2(acc[4 * g4], acc[4 * g4 + 1]); v.y = pk2(acc[4 * g4 + 2], acc[4 * g4 + 3]);
                    *(LAS u32x2*)(sRT + j * 72 + 32 * ti + 8 * g4 + 4 * hh) = v; }
            } else accO = acc;
        }
        __syncthreads();
#pragma unroll
        for (int e = 0; e < 8; ++e) { const int c = 8 * part + e; sKdT[c * 72 + t] = (bf16_t)f2bf(kd[e]); sNBdT[c * 72 + t] = (bf16_t)f2bf(nbd[e]); }
        if (w < 4) {
            const int ti = (w >> 1) & 1, tj = w & 1;
            f32x16 acc;
#pragma unroll
            for (int reg = 0; reg < 16; ++reg) acc[reg] = 0.f;
            mma32<4>(acc, sTi + 32 * ti * 72, 72, sRT + 32 * tj * 72, 72, lane);
            const int j = 32 * tj + (lane & 31);
#pragma unroll
            for (int g4 = 0; g4 < 4; ++g4) { u32x2 v; v.x = pk2(acc[4 * g4], acc[4 * g4 + 1]); v.y = pk2(acc[4 * g4 + 2], acc[4 * g4 + 3]);
                *(LAS u32x2*)(sYT + j * 72 + 32 * ti + 8 * g4 + 4 * hh) = v; }
        }
        __syncthreads();
        if (w >= 4) {
            const int ti = (w >> 1) & 1, tj = w & 1;
            mma32<4>(accO, sNArb + 32 * ti * 72, 72, sYT + 32 * tj * 72, 72, lane);
            const int j = 32 * tj + (lane & 31);
#pragma unroll
            for (int reg = 0; reg < 16; ++reg) sO[(32 * ti + crow(reg, hh)) * 65 + j] = accO[reg];
        } else if (!bat) {
#pragma unroll
            for (int reg = 0; reg < 16; ++reg) accH[reg] *= sPC[32 * aS + crow(reg, hh)];
            mma32<4>(accH, sKdT + 32 * aS * 72, 72, sVT + 32 * tjS * 72, 72, lane);
            mma32<4>(accH, sNBdT + 32 * aS * 72, 72, sYT + 32 * tjS * 72, 72, lane);
#pragma unroll
            for (int g4 = 0; g4 < 4; ++g4) { u32x2 v; v.x = pk2(accH[4 * g4], accH[4 * g4 + 1]); v.y = pk2(accH[4 * g4 + 2], accH[4 * g4 + 3]);
                *(LAS u32x2*)(sST + (32 * tjS + (lane & 31)) * 72 + 32 * aS + 8 * g4 + 4 * hh) = v; }
        }
        if (bat) {
            const int sq = w, mk = sq >> 1; const bool mine = (hh == (sq & 1));
            const float* st0 = p.in[5] + (size_t)((8 * b + sq) * 16 + h) * 4096; float* so0 = p.out + O_RWS + (size_t)((8 * b + sq) * 16 + h) * 4096;
#pragma unroll
            for (int a2_ = 0; a2_ < 2; ++a2_)
#pragma unroll
                for (int tj2 = 0; tj2 < 2; ++tj2) { f32x16 ah; const int v = 32 * tj2 + (lane & 31);
#pragma unroll
                    for (int reg = 0; reg < 16; ++reg) { const int k = 32 * a2_ + crow(reg, hh); ah[reg] = sPCb[sq * 64 + k] * st0[v * 64 + k]; }
                    const u32x4 z4 = (u32x4){0u, 0u, 0u, 0u};
                    const u32x4 ka = mine ? *(const LAS u32x4*)(sKdT + (32 * a2_ + (lane & 31)) * 72 + 16 * mk + 8 * hh) : z4;
                    const u32x4 na = mine ? *(const LAS u32x4*)(sNBdT + (32 * a2_ + (lane & 31)) * 72 + 16 * mk + 8 * hh) : z4;
                    const bf16x8 vb = *(const LAS bf16x8*)(sVT + (32 * tj2 + (lane & 31)) * 72 + 16 * mk + 8 * hh);
                    const bf16x8 yb = *(const LAS bf16x8*)(sYT + (32 * tj2 + (lane & 31)) * 72 + 16 * mk + 8 * hh);
                    ah = __builtin_amdgcn_mfma_f32_32x32x16_bf16(__builtin_bit_cast(bf16x8, ka), vb, ah, 0, 0, 0);
                    ah = __builtin_amdgcn_mfma_f32_32x32x16_bf16(__builtin_bit_cast(bf16x8, na), yb, ah, 0, 0, 0);
#pragma unroll
                    for (int reg = 0; reg < 16; ++reg) { const int k = 32 * a2_ + crow(reg, hh); so0[v * 64 + k] = ah[reg]; } }
        }
        __syncthreads();
        {
            float o[8]; float sm = 0.f;
#pragma unroll
            for (int e = 0; e < 8; ++e) { o[e] = actv ? sO[t * 65 + 8 * part + e] : 0.f; sm += o[e]; }
            sm = red8(sm);
            const float mean = sm * (1.f / 64.f); float vs = 0.f;
#pragma unroll
            for (int e = 0; e < 8; ++e) { o[e] -= mean; vs += o[e] * o[e]; }
            vs = red8(vs);
            const float rs = rsqrtf_(vs * (1.f / 64.f) + 64e-5f);
            if (actv) { const int c0 = h * 64 + 8 * part; const float bo = sBonus[t]; float y[8];
#pragma unroll
                for (int e = 0; e < 8; ++e) y[e] = o[e] * rs * sCst[10 * 64 + 8 * part + e] + sCst[11 * 64 + 8 * part + e] + bo * vv[e];
                *(u32x4*)(RW + row * RWW + 2048 + c0) = pack8(y); }
        }
        __syncthreads();
    }
    if (w < 4 && prompt) {
        const int tid = otid(), lane = tid & 63, hh = lane >> 5;
        float* so = p.out + (prompt ? O_RWP : O_RWS) + ((size_t)(b * 16 + h) * 64 + 32 * tjS + (lane & 31)) * 64 + 32 * aS;
#pragma unroll
        for (int reg = 0; reg < 16; ++reg) so[crow(reg, hh)] = accH[reg];
    }
    float* sh = p.out + (prompt ? O_SHIFTP : O_SHIFTS) + (size_t)b * RWW;
    if (h == 0) {
        const int ti_ = otid();
        if (prompt) { if (ti_ < 128) p.out[O_SHIFTP + (size_t)b * RWW + 3200 + ti_] = bflo((unsigned)RW[(size_t)(row0 + T - 1) * RWW + 3200 + ti_]); }
        else { for (int i = ti_; i < 8 * 128; i += 512) { const int sq = i >> 7, c = i & 127; p.out[O_SHIFTS + (size_t)(8 * b + sq) * RWW + 3200 + c] = bflo((unsigned)RW[(size_t)(row0 + 8 * sq + 7) * RWW + 3200 + c]); } }
    }
    for (int i = otid(); i < 448; i += 512) {
        if (!prompt) break;
        if (i >= 320) continue;
        if (i >= 192 && h != 0) continue;
        int col; if (i < 64) col = h * 64 + i; else if (i < 128) col = 1024 + h * 64 + (i - 64); else if (i < 192) col = 2048 + h * 64 + (i - 128); else col = 3072 + (i - 192);
        sh[col] = sPrev[pb * 448 + i];
    }
    __syncthreads();
}

DI void gate_item(const Params& p, int j) {
    const int tid = otid(), t = tid >> 3, part = tid & 7;
    const bf16_t* RW = (const bf16_t*)(p.ws + WS_RW); bf16_t* GA = (bf16_t*)(p.ws + WS_GA);
    const int row = 64 * j + t; if (row >= M) return;
    bool first; const float* sp = nullptr;
    if (row < MPR) first = (row % TP) == 0; else { first = ((row - MPR) & 7) == 0; sp = p.in[4] + (size_t)((row - MPR) >> 3) * RWW; }
    float g[16];
#pragma unroll
    for (int q = 0; q < 2; ++q) { const int c0 = 3200 + 16 * part + 8 * q; float cur[8], prv[8];
        load8bf(RW + (size_t)row * RWW + c0, cur);
        if (!first) load8bf(RW + (size_t)(row - 1) * RWW + c0, prv);
        else {
#pragma unroll
            for (int e = 0; e < 8; ++e) prv[e] = sp ? sp[c0 + e] : 0.f; }
#pragma unroll
        for (int e = 0; e < 8; ++e) g[8 * q + e] = sigmoidf_(cur[e] + (prv[e] - cur[e]) * p.in[13][c0 + e]); }
    *(u32x4*)(GA + (size_t)row * 128 + 16 * part) = pack8(g); *(u32x4*)(GA + (size_t)row * 128 + 16 * part + 8) = pack8(g + 8);
}
DI void phase_scan(const Params& p, LAS unsigned char* lds, unsigned long long* tfirst) {
    unsigned* ctr = (unsigned*)(p.ws + WS_CTL);
    LAS int* sItem = (LAS int*)(lds + LDS_BYTES - 16);
    const bool stat = gridDim.x >= 256;
    for (int it = 0;; ++it) {
        if (threadIdx.x == 0) *sItem = (stat && it == 0 && blockIdx.x < 256) ? (int)blockIdx.x : (stat ? 256 : 0) + (int)atomicAdd(ctr, 1u);
        __syncthreads();
        const int item = __builtin_amdgcn_readfirstlane(*sItem);
        __syncthreads();
#if PROBE_ITEM_BLOCK >= 0
        if (it == 1 && blockIdx.x == PROBE_ITEM_BLOCK) tfirst[1] = rtc();
#endif
        if (item >= 768 + 274) break;
        if (item >= 768) { gate_item(p, item - 768); continue; }
        bool prompt; int typ, j;
        if (item < 128) { typ = 0; j = item; prompt = true; } else if (item < 256) { typ = 1; j = item - 128; prompt = true; }
        else if (item < 512) { typ = 0; j = item - 256; prompt = false; } else { typ = 1; j = item - 512; prompt = false; }
        if (typ == 0) dn_item(p, lds, j >> 4, (j >> 1) & 7, j & 1, prompt);
        else rw_item(p, lds, j >> 4, j & 15, prompt);
    }
}

DI void phase_merge(const Params& p) {
    const bf16_t* QKV = (const bf16_t*)(p.ws + WS_QKV); const bf16_t* RW = (const bf16_t*)(p.ws + WS_RW);
    bf16_t* MIX = (bf16_t*)((unsigned char*)p.out + DO_H);
    const int gt = blockIdx.x * 512 + otid(), NT = gridDim.x * 512;
    for (int u = gt; u < M * 128; u += NT) {
        const int row = u >> 7, c = (u & 127) * 8;
        float o[8], z[8], ga[8], gb[8], orw[8], gate[8];
        load8bf(QKV + (size_t)row * QKVW + 2048 + c, o); load8bf(QKV + (size_t)row * QKVW + c, z); load8bf(QKV + (size_t)row * QKVW + 1024 + c, ga);
        load8bf(RW + (size_t)row * RWW + c, gb); load8bf(RW + (size_t)row * RWW + 2048 + c, orw); load8bf(RW + (size_t)row * RWW + 1024 + c, gate);
        float ss = 0.f;
#pragma unroll
        for (int e = 0; e < 8; ++e) ss += o[e] * o[e];
        ss = red16(ss);
        const float rs = rsqrtf_(ss * (1.f / 128.f) + 1e-6f);
        float mix[8];
#pragma unroll
        for (int e = 0; e < 8; ++e) { const float odn = o[e] * rs * p.in[12][(c & 127) + e] * siluf_(z[e]); mix[e] = sigmoidf_(ga[e]) * odn + sigmoidf_(gb[e]) * (orw[e] * gate[e]); }
        *(u32x4*)(MIX + (size_t)row * D + c) = pack8(mix);
    }
}
DI void build_slots(LAS int* sSlot, int tid) {
    for (int i = tid; i < 69 * 4; i += 512) sSlot[i] = -1;
    __syncthreads();
    pg8::StaticOrder S; S.init(MP, D, gridDim.x, 0, 16, 1);
    if (S.split && tid < S.nwg - S.G) { S.c = 4 * tid; pg8::Unit u; if (S.next(1, u)) sSlot[u.pm * 4 + u.pn] = tid; }
    __syncthreads();
}
DI void phase_norm2(const Params& p, LAS unsigned char* lds) {
    const int tid_ = otid(); const int lane = tid_ & 63, gw = blockIdx.x * 8 + (tid_ >> 6), NGW = gridDim.x * 8;
    const float* X1 = (const float*)(p.ws + WS_X1); bf16_t* H = (bf16_t*)((unsigned char*)p.out + DO_H);
    LAS int* sSlot = (LAS int*)lds; build_slots(sSlot, tid_);
    const float* part = (const float*)(p.ws + WS_PART);
    bf16_t* x1a = (bf16_t*)((unsigned char*)p.out + DO_X1B); bf16_t* x1b = (bf16_t*)(p.ws + WS_X1B2);
    auto x1row = [&](int m) { return m < X1B_SPLIT ? x1a + (size_t)m * D : x1b + (size_t)(m - X1B_SPLIT) * D; };
    unsigned long long nr[4];
    if (gw < M) { const bf16_t* r = x1row(gw);
#pragma unroll
        for (int j = 0; j < 4; ++j) nr[j] = *(const unsigned long long*)(r + 4 * lane + 256 * j); }
    for (int m = gw; m < M; m += NGW) { f32x4 v[4];
#pragma unroll
        for (int j = 0; j < 4; ++j) { const unsigned lo = (unsigned)nr[j], hi = (unsigned)(nr[j] >> 32); v[j] = (f32x4){bflo(lo), bfhi(lo), bflo(hi), bfhi(hi)}; }
        if (m + NGW < M) { const bf16_t* r = x1row(m + NGW);
#pragma unroll
            for (int j = 0; j < 4; ++j) nr[j] = *(const unsigned long long*)(r + 4 * lane + 256 * j); }
        rms_row(nullptr, p.in[25], H + (size_t)m * D, lane, v, part, sSlot + (m >> 8) * 4, m & 255, nullptr, true, x1row(m)); }
}
DI void phase_final(const Params& p, LAS unsigned char* lds) {
    const int tid_ = otid(); const int lane = tid_ & 63, gw = blockIdx.x * 8 + (tid_ >> 6), NGW = gridDim.x * 8;
    const float* X1 = (const float*)(p.ws + WS_X1);
    LAS int* sSlot = (LAS int*)lds; build_slots(sSlot, tid_);
    const float* part = (const float*)(p.ws + WS_PART);
    constexpr int NOUT = NBP * 2048 + NBS * TS;
    auto row_of = [](int o) { return o < NBP * 2048 ? (o >> 11) * TP + (o & 2047) + 16 : MPR + (o - NBP * 2048); };
    f32x4 nv[4];
    if (gw < NOUT) load_row(X1 + (size_t)row_of(gw) * D, lane, nv);
    for (int o = gw; o < NOUT; o += NGW) {
        const int m = row_of(o);
        float* orow = p.out + (size_t)o * D;
        f32x4 v[4];
#pragma unroll
        for (int j = 0; j < 4; ++j) v[j] = nv[j];
        if (o + NGW < NOUT) load_row(X1 + (size_t)row_of(o + NGW) * D, lane, nv);
        rms_row(nullptr, p.in[28], nullptr, lane, v, part, sSlot + (m >> 8) * 4, m & 255, nullptr, true);
#pragma unroll
        for (int j = 0; j < 4; ++j) *(f32x4*)(orow + 4 * lane + 256 * j) = v[j];
    }
}


#define XB_TMO      128
#define XB_XCNT(j)  (256  + 64 * (j))
#define XB_XSUB(j)  (1280 + 64 * (j))
#define XB_XGEN(j)  (2304 + 64 * (j))
#define XB_TOP      3328
#define XB_TOPGEN   3392
#define XCD_BAR_WORDS 3456
#define XB_SPIN_CAP (1u << 18)

__device__ __forceinline__ unsigned xb_ld(unsigned* p)              { return __hip_atomic_load(p, __ATOMIC_RELAXED, __HIP_MEMORY_SCOPE_AGENT); }
__device__ __forceinline__ unsigned xb_add(unsigned* p, unsigned v) { return __hip_atomic_fetch_add(p, v, __ATOMIC_RELAXED, __HIP_MEMORY_SCOPE_AGENT); }
__device__ __forceinline__ unsigned xb_xcc_id() { return (unsigned)__builtin_amdgcn_s_getreg((3 << 11) | 20) & 0xFu; }
#define XB_SPIN(cond, bar) do { unsigned _sp = 0; while (cond) { __builtin_amdgcn_s_sleep(1); \
    if ((++_sp & 255u) == 0u) { if (xb_ld(&(bar)[XB_TMO])) break; if (_sp > XB_SPIN_CAP) { atomicAdd(&(bar)[XB_TMO], 1u); break; } } } } while (0)

struct XcdBarrier {
    unsigned* bar; unsigned x;
    volatile LAS unsigned* st;
};

__device__ __forceinline__ XcdBarrier xcd_barrier_post(unsigned* bar, volatile LAS unsigned* st) {
    XcdBarrier b; b.bar = bar; b.x = xb_xcc_id(); b.st = st;
    if (threadIdx.x == 0) (void)xb_add(&bar[XB_XCNT(b.x)], 1u);
    return b;
}
__device__ __forceinline__ void xcd_barrier_complete(unsigned* bar, unsigned x, unsigned& nloc, unsigned& nx) {
    const unsigned G = gridDim.x * gridDim.y * gridDim.z;
    unsigned sum, cnt, mine, sp = 0u;
    for (;;) {
        sum = 0u; cnt = 0u; mine = 0u;
#pragma unroll
        for (unsigned j = 0; j < 16; ++j) { const unsigned c = xb_ld(&bar[XB_XCNT(j)]); sum += c; cnt += (c > 0u) ? 1u : 0u; mine = (j == x) ? c : mine; }
        if (sum == G) break;
        __builtin_amdgcn_s_sleep(1);
        if ((++sp & 255u) == 0u) { if (xb_ld(&bar[XB_TMO])) break; if (sp > XB_SPIN_CAP) { atomicAdd(&bar[XB_TMO], 1u); break; } }
    }
    nloc = mine > 0u ? mine : 1u; nx = cnt > 0u ? cnt : 1u;
}

__device__ __forceinline__ void xcd_barrier(const XcdBarrier& b) {
    asm volatile("s_waitcnt vmcnt(0)" ::: "memory");
    __syncthreads();
    if (threadIdx.x == 0) {
        unsigned* bar = b.bar;
        __builtin_amdgcn_s_waitcnt(0);
        unsigned nloc = b.st[0], nx = b.st[1];
        if (nloc == 0u) { xcd_barrier_complete(bar, b.x, nloc, nx); b.st[0] = nloc; b.st[1] = nx; }
        const unsigned old = xb_add(&bar[XB_XSUB(b.x)], 1u);
        const unsigned gen = old / nloc;
        if (old + 1u == (gen + 1u) * nloc) {
            __builtin_amdgcn_fence(__ATOMIC_RELEASE, "agent");
            asm volatile("s_waitcnt vmcnt(0)" ::: "memory");
            const unsigned og = xb_add(&bar[XB_TOP], 1u);
            const unsigned tg = og / nx;
            if (og + 1u == (tg + 1u) * nx) xb_add(&bar[XB_TOPGEN], 1u);
            else XB_SPIN(xb_ld(&bar[XB_TOPGEN]) == tg, bar);
            __builtin_amdgcn_fence(__ATOMIC_ACQUIRE, "agent");
            xb_add(&bar[XB_XGEN(b.x)], 1u);
            asm volatile("s_waitcnt vmcnt(0)" ::: "memory");
        } else {
            XB_SPIN(xb_ld(&bar[XB_XGEN(b.x)]) == gen, bar);
            __builtin_amdgcn_fence(__ATOMIC_ACQUIRE, "agent");
            asm volatile("s_waitcnt vmcnt(0)" ::: "memory");
        }
    }
    __syncthreads();
}


#if PROBE_MASK
#define TS_(i) ts_[i] = rtc()
#else
#define TS_(i) (void)ts_
#endif
__global__ void __launch_bounds__(512, 2) fwd_megakernel(Params p) {
    extern __shared__ __attribute__((aligned(16))) unsigned char lds_raw[];
    LAS unsigned char* lds = (LAS unsigned char*)lds_raw;
    unsigned long long ts_[11];
    cg::grid_group grid = cg::this_grid();
    const int G = gridDim.x, c = blockIdx.x;
    bf16_t* H = (bf16_t*)((unsigned char*)p.out + DO_H);
    bf16_t* WIN = (bf16_t*)((unsigned char*)p.out + DO_WIN);
    bf16_t* QKV = (bf16_t*)(p.ws + WS_QKV); bf16_t* RW = (bf16_t*)(p.ws + WS_RW);
    float* X1 = (float*)(p.ws + WS_X1); bf16_t* ACT = (bf16_t*)(p.ws + WS_ACT);

    {   volatile LAS unsigned* st_ = (volatile LAS unsigned*)(lds + LDS_BYTES - 64); if (threadIdx.x == 0) { st_[0] = 0u; st_[1] = 0u; } }
    __syncthreads();
    const XcdBarrier xbar = xcd_barrier_post((unsigned*)(p.ws + WS_CTL) + 1024, (volatile LAS unsigned*)(lds + LDS_BYTES - 64));
    if (p.ws == nullptr) grid.sync();
    TS_(0); phase0(p, lds);
    xcd_barrier(xbar); TS_(1);
    {
        pg8::Gemm g{H, D, WIN, MP, N1A, D}; pg8::StaticOrder S; S.init(MP, N1A, G, c);
        pg8::EpiSeg<0> E{QKV, QKVW, 3072, RW, RWW};
        pg8::gemm_phase<1024, 1024, GEMM_ALIGN>(lds, g, S, E);
    }
    xcd_barrier(xbar); TS_(2);
    unsigned long long tfirst[2] = {0ull, 0ull};
#if PROBE_ITEM_BLOCK >= 0
    tfirst[0] = rtc();
#endif
    phase_scan(p, lds, tfirst);
    xcd_barrier(xbar); TS_(3);
    {
        pg8::Gemm g{H, D, WIN + (size_t)N1A * D, MP, N1B, D}; pg8::StaticOrder S; S.init(MP, N1B, G, c);
        pg8::EpiSeg<0> E{QKV, QKVW, 2048, RW, RWW};
        pg8::gemm_phase<1024, 1024, GEMM_ALIGN>(lds, g, S, E);
        pg8::Gemm g2{(const bf16_t*)(p.ws + WS_GA), 128, (const bf16_t*)(p.ws + WS_WG2), MP, 1024, 128}; const int nw1 = (MP / 256) * (N1B / 256), rem1 = nw1 % G, G2 = (rem1 > 0 && rem1 < G / 2) ? G - rem1 : G, c2 = (G2 == G) ? c : c - rem1;
        pg8::StaticOrder S2; S2.init(MP, 1024, G2, c2 < 0 ? (1 << 28) : c2, 2);
        pg8::EpiSeg<0> E2{RW + 1024, RWW, 1 << 30, RW, RWW};
        pg8::gemm_phase<128, 128, GEMM_ALIGN>(lds, g2, S2, E2);
    }
    xcd_barrier(xbar); TS_(4);
    phase_merge(p);
    xcd_barrier(xbar); TS_(5);
    {
        pg8::Gemm g{H, D, (const bf16_t*)(p.ws + WS_WOUT), MP, D, D}; pg8::StaticOrder S; S.init(MP, D, G, c, 16, 1);
        pg8::EpiRes<0> E{X1, p.in[0], p.in[1], p.in[6], (float*)(p.ws + WS_PART), (bf16_t*)((unsigned char*)p.out + DO_X1B), (bf16_t*)(p.ws + WS_X1B2)};
        pg8::gemm_phase<1024, 1024, GEMM_ALIGN>(lds, g, S, E);
    }
    xcd_barrier(xbar); TS_(6);
    phase_norm2(p, lds);
    xcd_barrier(xbar); TS_(7);
    {
        pg8::Gemm g{H, D, (const bf16_t*)(p.ws + WS_WFF1), MP, FF, D}; pg8::StaticOrder S; S.init(MP, FF, G, c);
        pg8::EpiSeg<1> E{ACT, FF, 1 << 30, ACT, FF};
        pg8::gemm_phase<1024, 1024, GEMM_ALIGN>(lds, g, S, E);
    }
    xcd_barrier(xbar); TS_(8);
    {
        pg8::Gemm g{ACT, FF, (const bf16_t*)(p.ws + WS_WFF2), MP, D, FF}; pg8::StaticOrder S; S.init(MP, D, G, c, 64, 1);
        pg8::EpiRes<1> E{X1, nullptr, nullptr, nullptr, (float*)(p.ws + WS_PART), (bf16_t*)((unsigned char*)p.out + DO_X1B), (bf16_t*)(p.ws + WS_X1B2)};
        pg8::gemm_phase<4096, 4096, GEMM_ALIGN>(lds, g, S, E);
    }
    xcd_barrier(xbar); TS_(9);
    phase_final(p, lds);
    TS_(10);
#if PROBE_ITEM_BLOCK >= 0
    if (blockIdx.x == PROBE_ITEM_BLOCK && threadIdx.x == 0) { const unsigned long long t9 = rtc(); const unsigned long long d = tfirst[1] - tfirst[0]; while (rtc() - t9 < d) __builtin_amdgcn_s_sleep(8); }
#endif
#if PROBE_MASK
    if (blockIdx.x == 0 && threadIdx.x == 0) { unsigned long long d = 0;
#pragma unroll
        for (int i = 0; i < 10; ++i) if ((PROBE_MASK >> i) & 1) d += ts_[i + 1] - ts_[i];
        while (rtc() - ts_[10] < d) __builtin_amdgcn_s_sleep(8); }
#endif
}

extern "C" void kernel_launch(void* const* d_in, const int* in_sizes, int n_in, void* d_out, int out_size, void* d_ws, size_t ws_size, hipStream_t stream) {
    static int grid = 0;
    if (grid == 0) {
        int dev = 0, cus = 0, per_cu = 0;
        hipGetDevice(&dev);
        hipDeviceGetAttribute(&cus, hipDeviceAttributeMultiprocessorCount, dev);
        if (hipFuncSetAttribute((const void*)fwd_megakernel, hipFuncAttributeMaxDynamicSharedMemorySize, LDS_BYTES) != hipSuccess) fprintf(stderr, "hipFuncSetAttribute failed\n");
        hipOccupancyMaxActiveBlocksPerMultiprocessor(&per_cu, (const void*)fwd_megakernel, 512, LDS_BYTES);
        if (per_cu < 1) { fprintf(stderr, "occupancy query says %d blocks per CU\n", per_cu); per_cu = 1; }
        grid = cus;
        if (n_in != 29 || ws_size < 256 * MiB) fprintf(stderr, "unexpected n_in %d / ws %zu\n", n_in, ws_size);
    }
    hipMemsetAsync((char*)d_ws + WS_CTL, 0, 32768, stream);
    Params p{};
    for (int i = 0; i < 29; ++i) p.in[i] = (const float*)d_in[i];
    p.out = (float*)d_out; p.ws = (unsigned char*)d_ws;
    void* args[] = {&p};
    hipError_t e = hipLaunchCooperativeKernel((const void*)fwd_megakernel, dim3(grid), dim3(512), args, LDS_BYTES, stream);
    if (e != hipSuccess) fprintf(stderr, "cooperative launch failed: %s (grid %d)\n", hipGetErrorString(e), grid);
}
```
